# Optimizing an MI355X kernel written in HIP

```python
import math
import jax
import jax.numpy as jnp
from jax import lax
import numpy as np

D_MODEL = 1024
BATCH = 8
SEQ = 2048
DEPTH = 1

HEAD_DIM = 64
ATTN_HEADS = D_MODEL // 128
ATTN_WIDTH = ATTN_HEADS * HEAD_DIM
MOBA_BLOCK = 256
MOBA_TOP_K = 3
QUERY_CHUNK = 32
ROPE_THETA = 10000.0
SSM_GROUP_DIM = 16
SSM_GROUPS = D_MODEL // 32
SSM_WIDTH = SSM_GROUPS * SSM_GROUP_DIM
SSM_STATE = 64
DT_MIN = 1e-3
DT_MAX = 1e-1
MIX_WIDTH = ATTN_WIDTH + SSM_WIDTH
IN_PROJ_WIDTH = 4 * ATTN_WIDTH + 2 * SSM_WIDTH
NORM_EPS = 1e-6
NEG_INF = -1e30

kernel_name = "hymba_moba_s5_hybrid_layer"


def rms_norm(x, g):
    xf = x.astype(jnp.float32)
    y = xf * lax.rsqrt(jnp.mean(xf * xf, axis=-1, keepdims=True) + NORM_EPS)
    return (y * g.astype(jnp.float32)).astype(x.dtype)


def rotary(t):
    L, dh = t.shape[2], t.shape[3]
    half = dh // 2
    inv_freq = 1.0 / (ROPE_THETA ** (jnp.arange(half, dtype=jnp.float32) / half))
    ang = jnp.arange(L, dtype=jnp.float32)[:, None] * inv_freq[None, :]
    cos, sin = jnp.cos(ang), jnp.sin(ang)
    tf = t.astype(jnp.float32)
    t1, t2 = tf[..., :half], tf[..., half:]
    out = jnp.concatenate([t1 * cos - t2 * sin, t2 * cos + t1 * sin], axis=-1)
    return out.astype(t.dtype)


def moba_attention(q, k, v):
    Bsz, H, L, dh = q.shape
    nb = -(-L // MOBA_BLOCK)
    pad = nb * MOBA_BLOCK - L
    kb = jnp.pad(k, ((0, 0), (0, 0), (0, pad), (0, 0))).reshape(Bsz, H, nb, MOBA_BLOCK, dh)
    vb = jnp.pad(v, ((0, 0), (0, 0), (0, pad), (0, 0))).reshape(Bsz, H, nb, MOBA_BLOCK, dh)
    k_mean = jnp.mean(kb.astype(jnp.float32), axis=3)
    n_sel = min(MOBA_TOP_K, nb - 1)
    scale = 1.0 / math.sqrt(dh)
    n_chunks = L // QUERY_CHUNK
    q_chunks = q.reshape(Bsz, H, n_chunks, QUERY_CHUNK, dh).transpose(2, 0, 1, 3, 4)
    b_idx = jnp.arange(Bsz)[:, None, None, None]
    h_idx = jnp.arange(H)[None, :, None, None]

    def chunk_fn(args):
        ci, qc = args
        start = ci * QUERY_CHUNK
        q_pos = start + jnp.arange(QUERY_CHUNK)
        own = start // MOBA_BLOCK
        k_own = lax.dynamic_index_in_dim(kb, own, axis=2, keepdims=False)
        v_own = lax.dynamic_index_in_dim(vb, own, axis=2, keepdims=False)
        key_pos = own * MOBA_BLOCK + jnp.arange(MOBA_BLOCK)
        s_own = jnp.einsum('bhqd,bhkd->bhqk', qc, k_own).astype(jnp.float32) * scale
        s_own = jnp.where(key_pos[None, :] <= q_pos[:, None], s_own, NEG_INF)
        if n_sel == 0:
            p_own = jax.nn.softmax(s_own, axis=-1).astype(v.dtype)
            return jnp.einsum('bhqk,bhkd->bhqd', p_own, v_own)
        gate = jnp.einsum('bhqd,bhnd->bhqn', qc.astype(jnp.float32), k_mean)
        gate = jnp.where(jnp.arange(nb) < own, gate, NEG_INF)
        _, idx = lax.top_k(gate, n_sel)
        valid = jnp.arange(n_sel) < own
        k_sel = kb[b_idx, h_idx, idx]
        v_sel = vb[b_idx, h_idx, idx]
        s_sel = jnp.einsum('bhqd,bhqnkd->bhqnk', qc, k_sel).astype(jnp.float32) * scale
        s_sel = jnp.where(valid[:, None], s_sel, NEG_INF)
        s_all = jnp.concatenate([s_sel.reshape(Bsz, H, QUERY_CHUNK, n_sel * MOBA_BLOCK), s_own], axis=-1)
        p = jax.nn.softmax(s_all, axis=-1).astype(v.dtype)
        p_sel = p[..., : n_sel * MOBA_BLOCK].reshape(Bsz, H, QUERY_CHUNK, n_sel, MOBA_BLOCK)
        p_own = p[..., n_sel * MOBA_BLOCK:]
        return (jnp.einsum('bhqnk,bhqnkd->bhqd', p_sel, v_sel)
                + jnp.einsum('bhqk,bhkd->bhqd', p_own, v_own))

    out = lax.map(chunk_fn, (jnp.arange(n_chunks), q_chunks))
    return out.transpose(1, 2, 0, 3, 4).reshape(Bsz, H, L, dh)


def s5_branch(u, lam_re, lam_im, b_re, b_im, c_re, c_im, d_skip, log_dt, w_glu, b_glu):
    Bsz, L, _ = u.shape
    uf = u.astype(jnp.float32).reshape(Bsz, L, SSM_GROUPS, SSM_GROUP_DIM)
    lam = lax.complex(lam_re.astype(jnp.float32), lam_im.astype(jnp.float32))
    dt = jnp.exp(log_dt.astype(jnp.float32))[:, None]
    lam_bar = jnp.exp(lam * dt)
    b_mat = lax.complex(b_re.astype(jnp.float32), b_im.astype(jnp.float32))
    b_bar = ((lam_bar - 1.0) / lam)[..., None] * b_mat
    bu = jnp.einsum('blgh,gph->blgp', uf.astype(jnp.complex64), b_bar)
    a = jnp.broadcast_to(lam_bar, (L, SSM_GROUPS, SSM_STATE))[None]

    def combine(e1, e2):
        a1, s1 = e1
        a2, s2 = e2
        return a1 * a2, a2 * s1 + s2

    _, xs = lax.associative_scan(combine, (a, bu), axis=1)
    y = (jnp.einsum('blgp,ghp->blgh', jnp.real(xs), c_re.astype(jnp.float32))
         - jnp.einsum('blgp,ghp->blgh', jnp.imag(xs), c_im.astype(jnp.float32))
         + d_skip.astype(jnp.float32) * uf)
    y = jax.nn.gelu(y.reshape(Bsz, L, SSM_WIDTH))
    y = y * jax.nn.sigmoid(y @ w_glu.astype(jnp.float32) + b_glu.astype(jnp.float32))
    return y.astype(u.dtype)


def setup_inputs(seed: int = 0) -> dict:
    key = jax.random.key(seed)
    ks = jax.random.split(key, 16)
    f32 = jnp.float32
    G, P, Hg = SSM_GROUPS, SSM_STATE, SSM_GROUP_DIM
    x = jax.random.normal(ks[0], (BATCH, SEQ, D_MODEL), f32)
    norm_gain = 1.0 + 0.01 * jax.random.normal(ks[1], (DEPTH, D_MODEL), f32)
    w_in = jax.random.normal(ks[2], (DEPTH, D_MODEL, IN_PROJ_WIDTH), f32) * D_MODEL ** -0.5
    w_out = jax.random.normal(ks[3], (DEPTH, MIX_WIDTH, D_MODEL), f32) * MIX_WIDTH ** -0.5
    lam_re = -0.5 + 0.01 * jax.random.normal(ks[4], (DEPTH, G, P), f32)
    lam_im = (jnp.pi * jnp.arange(P, dtype=f32))[None, None, :] + 0.01 * jax.random.normal(ks[5], (DEPTH, G, P), f32)
    b_re = jax.random.normal(ks[6], (DEPTH, G, P, Hg), f32) * (2.0 * Hg) ** -0.5
    b_im = jax.random.normal(ks[7], (DEPTH, G, P, Hg), f32) * (2.0 * Hg) ** -0.5
    c_re = jax.random.normal(ks[8], (DEPTH, G, Hg, P), f32) * (2.0 * P) ** -0.5
    c_im = jax.random.normal(ks[9], (DEPTH, G, Hg, P), f32) * (2.0 * P) ** -0.5
    d_skip = jax.random.normal(ks[10], (DEPTH, G, Hg), f32)
    log_dt = jax.random.uniform(ks[11], (DEPTH, G), f32, minval=math.log(DT_MIN), maxval=math.log(DT_MAX))
    w_glu = jax.random.normal(ks[12], (DEPTH, SSM_WIDTH, SSM_WIDTH), f32) * SSM_WIDTH ** -0.5
    b_glu = 0.01 * jax.random.normal(ks[13], (DEPTH, SSM_WIDTH), f32)
    final_gain = 1.0 + 0.01 * jax.random.normal(ks[14], (D_MODEL,), f32)
    return {"x": x, "norm_gain": norm_gain, "w_in": w_in, "w_out": w_out,
            "lam_re": lam_re, "lam_im": lam_im, "b_re": b_re, "b_im": b_im,
            "c_re": c_re, "c_im": c_im, "d_skip": d_skip, "log_dt": log_dt,
            "w_glu": w_glu, "b_glu": b_glu, "final_gain": final_gain}


def reference(x, norm_gain, w_in, w_out, lam_re, lam_im, b_re, b_im, c_re, c_im,
              d_skip, log_dt, w_glu, b_glu, final_gain):
    Bsz, L, _ = x.shape
    A, S = ATTN_WIDTH, SSM_WIDTH

    def to_heads(t):
        return t.reshape(Bsz, L, ATTN_HEADS, HEAD_DIM).transpose(0, 2, 1, 3)

    for layer in range(DEPTH):
        h = rms_norm(x, norm_gain[layer])
        proj = jnp.einsum('bld,de->ble', h, w_in[layer])
        q, k, v, z_attn, u_ssm, z_ssm = jnp.split(
            proj, [A, 2 * A, 3 * A, 4 * A, 4 * A + S], axis=-1)
        o_attn = moba_attention(rotary(to_heads(q)), rotary(to_heads(k)), to_heads(v))
        o_attn = o_attn.transpose(0, 2, 1, 3).reshape(Bsz, L, A) * jax.nn.silu(z_attn)
        o_ssm = s5_branch(u_ssm, lam_re[layer], lam_im[layer], b_re[layer], b_im[layer],
                          c_re[layer], c_im[layer], d_skip[layer], log_dt[layer],
                          w_glu[layer], b_glu[layer]) * jax.nn.silu(z_ssm)
        mixed = jnp.concatenate([o_attn, o_ssm], axis=-1)
        x = x + jnp.einsum('ble,ed->bld', mixed, w_out[layer])
    return rms_norm(x, final_gain)
```

```cpp
#include <hip/hip_runtime.h>
#include <hip/hip_cooperative_groups.h>
#include <cstdio>
#include <cstdint>
namespace cg = cooperative_groups;

#ifndef ONLY_PH
#define ONLY_PH -1
#endif
#define PH_ON(x) (ONLY_PH < 0 || ONLY_PH == (x))
#ifndef N_LAUNCH
#define N_LAUNCH 1
#endif

#define LAS __attribute__((address_space(3)))
typedef unsigned short bf16_t;
typedef short bf16x8 __attribute__((ext_vector_type(8)));
typedef float f32x4 __attribute__((ext_vector_type(4)));
typedef float f32x16 __attribute__((ext_vector_type(16)));
typedef unsigned u32x2 __attribute__((ext_vector_type(2)));
typedef unsigned u32x4 __attribute__((ext_vector_type(4)));

constexpr int NTOK = 16384, DM = 1024, SEQ = 2048, NPROJ = 3072;
constexpr int NPH = 8;
constexpr size_t MBy = 1u << 20;
constexpr size_t WS_XB = 0;
constexpr size_t WS_WINT = 32 * MBy;
constexpr size_t WS_WOUTT = 38 * MBy;
constexpr size_t WS_WGLUT = 40 * MBy;
constexpr size_t WS_WST = 41 * MBy;
constexpr size_t WS_WCAT = 45 * MBy;
constexpr size_t WS_LAM16 = 51 * MBy;
constexpr size_t WS_RS = WS_LAM16 + 64 * 1024;
constexpr size_t WS_COS = WS_RS + 64 * 1024;
constexpr size_t WS_SIN = WS_COS + 256 * 1024;
constexpr size_t WS_KSUM = WS_SIN + 256 * 1024;
constexpr size_t WS_Q = 52 * MBy;
constexpr size_t WS_K = 68 * MBy;
constexpr size_t WS_VT = 84 * MBy;
constexpr size_t WS_SZA = 100 * MBy;
constexpr size_t WS_SZS = 116 * MBy;
constexpr size_t WS_XU = 132 * MBy;
constexpr size_t WS_SST = 156 * MBy;
constexpr size_t WS_YG = 172 * MBy;
constexpr size_t WS_SSQ = 188 * MBy;
constexpr size_t WS_BAR = 189 * MBy;
constexpr size_t WS_END = 190 * MBy;
constexpr int LDS_BYTES = 131072 + 16;

struct Params {
    const float *x, *norm_gain, *w_in, *w_out, *lam_re, *lam_im, *b_re, *b_im, *c_re, *c_im, *d_skip, *log_dt, *w_glu, *b_glu, *final_gain;
    float* out; unsigned char* ws;
    int ph_lo, ph_hi;
};

__device__ __forceinline__ unsigned pk2(float lo, float hi) { unsigned r; asm("v_cvt_pk_bf16_f32 %0, %1, %2" : "=v"(r) : "v"(lo), "v"(hi)); return r; }
__device__ __forceinline__ float bf2f(unsigned short b) { return __uint_as_float(((unsigned)b) << 16); }
__device__ __forceinline__ float bflo(unsigned w) { return __uint_as_float(w << 16); }
__device__ __forceinline__ float bfhi(unsigned w) { return __uint_as_float(w & 0xffff0000u); }
__device__ __forceinline__ float wave_sum(float v) {
#pragma unroll
    for (int o = 1; o < 64; o <<= 1) v += __shfl_xor(v, o);
    return v;
}
__device__ __forceinline__ float sigmoidf_(float v) { return __builtin_amdgcn_rcpf(1.f + __expf(-v)); }
__device__ __forceinline__ float siluf_(float v) { return v * sigmoidf_(v); }
__device__ __forceinline__ float gelu_tanh(float y) { const float t = 1.5957691216f * (y + 0.044715f * y * y * y); return y * sigmoidf_(t); }


#define XB_TMO      128
#define XB_XCNT(j)  (256  + 64 * (j))
#define XB_XSUB(j)  (1280 + 64 * (j))
#define XB_XGEN(j)  (2304 + 64 * (j))
#define XB_TOP      3328
#define XB_TOPGEN   3392
#define XCD_BAR_WORDS 3456
#define XB_SPIN_CAP (1u << 18)
__device__ __forceinline__ unsigned xb_ld(unsigned* p)              { return __hip_atomic_load(p, __ATOMIC_RELAXED, __HIP_MEMORY_SCOPE_AGENT); }
__device__ __forceinline__ unsigned xb_add(unsigned* p, unsigned v) { return __hip_atomic_fetch_add(p, v, __ATOMIC_RELAXED, __HIP_MEMORY_SCOPE_AGENT); }
__device__ __forceinline__ unsigned xb_xcc_id() { return (unsigned)__builtin_amdgcn_s_getreg((3 << 11) | 20) & 0xFu; }
#define XB_SPIN(cond, bar) do { unsigned _sp = 0; while (cond) { __builtin_amdgcn_s_sleep(1); \
    if ((++_sp & 255u) == 0u) { if (xb_ld(&(bar)[XB_TMO])) break; if (_sp > XB_SPIN_CAP) { atomicAdd(&(bar)[XB_TMO], 1u); break; } } } } while (0)
struct XcdBarrier { unsigned* bar; unsigned x; volatile LAS unsigned* st; };
__device__ __forceinline__ XcdBarrier xcd_barrier_post(unsigned* bar, volatile LAS unsigned* st) {
    XcdBarrier b; b.bar = bar; b.x = xb_xcc_id(); b.st = st;
    if (threadIdx.x == 0) (void)xb_add(&bar[XB_XCNT(b.x)], 1u);
    return b;
}
__device__ __forceinline__ void xcd_barrier_complete(unsigned* bar, unsigned x, unsigned& nloc, unsigned& nx) {
    const unsigned G = gridDim.x * gridDim.y * gridDim.z;
    unsigned sum, cnt, mine, sp = 0u;
    for (;;) {
        sum = 0u; cnt = 0u; mine = 0u;
#pragma unroll
        for (unsigned j = 0; j < 16; ++j) { const unsigned c = xb_ld(&bar[XB_XCNT(j)]); sum += c; cnt += (c > 0u) ? 1u : 0u; mine = (j == x) ? c : mine; }
        if (sum == G) break;
        __builtin_amdgcn_s_sleep(1);
        if ((++sp & 255u) == 0u) { if (xb_ld(&bar[XB_TMO])) break; if (sp > XB_SPIN_CAP) { atomicAdd(&bar[XB_TMO], 1u); break; } }
    }
    nloc = mine > 0u ? mine : 1u; nx = cnt > 0u ? cnt : 1u;
}
__device__ __forceinline__ void xcd_barrier(const XcdBarrier& b) {
    asm volatile("s_waitcnt vmcnt(0)" ::: "memory");
    __syncthreads();
    if (threadIdx.x == 0) {
        unsigned* bar = b.bar;
        __builtin_amdgcn_s_waitcnt(0);
        unsigned nloc = b.st[0], nx = b.st[1];
        if (nloc == 0u) { xcd_barrier_complete(bar, b.x, nloc, nx); b.st[0] = nloc; b.st[1] = nx; }
        const unsigned old = xb_add(&bar[XB_XSUB(b.x)], 1u);
        const unsigned gen = old / nloc;
        if (old + 1u == (gen + 1u) * nloc) {
            __builtin_amdgcn_fence(__ATOMIC_RELEASE, "agent");
            asm volatile("s_waitcnt vmcnt(0)" ::: "memory");
            const unsigned og = xb_add(&bar[XB_TOP], 1u);
            const unsigned tg = og / nx;
            if (og + 1u == (tg + 1u) * nx) xb_add(&bar[XB_TOPGEN], 1u);
            else XB_SPIN(xb_ld(&bar[XB_TOPGEN]) == tg, bar);
            __builtin_amdgcn_fence(__ATOMIC_ACQUIRE, "agent");
            xb_add(&bar[XB_XGEN(b.x)], 1u);
            asm volatile("s_waitcnt vmcnt(0)" ::: "memory");
        } else {
            XB_SPIN(xb_ld(&bar[XB_XGEN(b.x)]) == gen, bar);
            __builtin_amdgcn_fence(__ATOMIC_ACQUIRE, "agent");
            asm volatile("s_waitcnt vmcnt(0)" ::: "memory");
        }
    }
    __syncthreads();
}

namespace pg8 {
constexpr int BM = 256, BK = 64, HALF = 128, HTB = HALF * BK * 2, STAGE_BYTES = 8 * HTB, NXCD = 8, WGM = 8;
__device__ __forceinline__ int lds_byte(int r, int c) { const int st = (r >> 4) * 2 + (c >> 5), rr = r & 15, cc = c & 31, ob = rr * 64 + cc * 2; return st * 1024 + (ob ^ (((ob >> 9) & 1) << 5)); }
__device__ __forceinline__ void stage_rc(int b, int& R, int& C) { const int st = b / 1024, sb = b % 1024, swz = sb ^ (((sb >> 9) & 1) << 5); R = (st >> 1) * 16 + swz / 64; C = (st & 1) * 32 + (swz % 64) / 2; }
struct Unit { int pm, pn; };
struct Gemm { const bf16_t* A; const bf16_t* Bt; int lda, ldb, K; };

struct StaticOrder {
    int nM, nN, nwg, G, c;
    __device__ void init(int M, int N, int G_, int c_) { nM = M / BM; nN = N / BM; nwg = nM * nN; G = G_; c = c_; }
    __device__ bool next(int i, Unit& u) const {
        const long L = (long)i * G + c; if (L >= nwg) return false;
        int wgid = (int)L; { const int q = nwg / NXCD, r = nwg % NXCD, xcd = wgid % NXCD, off = wgid / NXCD; wgid = (xcd < r ? xcd * (q + 1) : r * (q + 1) + (xcd - r) * q) + off; }
        const int nig = WGM * nN, gid = wgid / nig, fm = gid * WGM, gsz = (nM - fm) < WGM ? (nM - fm) : WGM;
        u.pm = fm + ((wgid % nig) % gsz); u.pn = (wgid % nig) / gsz; return true;
    }
};
struct GroupOrder {
    int G, c;
    __device__ bool next(int i, Unit& u) const { const int L = i * G + c; if (L >= 128) return false; u.pm = L; u.pn = L >> 2; return true; }
};

struct OneUnit {
    int pm, pn;
    __device__ bool next(int i, Unit& u) const { if (i) return false; u.pm = pm; u.pn = pn; return true; }
};

template <bool AFTER = false, bool ALIGN_EPI = true, bool SP2 = true, class Epi, class Sched>
__device__ __forceinline__ void gemm_phase(LAS unsigned char* lds, const Gemm g, const Sched& S, const Epi& E) {
    const int tid = threadIdx.x, wid = __builtin_amdgcn_readfirstlane(tid >> 6), lane = tid & 63, wr = wid >> 2, wc = wid & 3, fr = lane & 15, fq = lane >> 4;
    const int K = g.K, nt = K / BK;
    unsigned voffA[2], voffB[2];
#pragma unroll
    for (int i = 0; i < 2; ++i) { int R, C; stage_rc(tid * 16 + i * 8192, R, C); voffA[i] = (unsigned)(R * g.lda + C) * 2u; voffB[i] = (unsigned)(R * g.ldb + C) * 2u; }
    const size_t kstep = (size_t)(BK * 2);
    const size_t hstepA = (size_t)HALF * g.lda * 2, hstepB = (size_t)HALF * g.ldb * 2;
    const size_t tstepA = 2 * hstepA, tstepB = 2 * hstepB;
    const unsigned ldsw = (unsigned)wid * 1024u;
    const int aoff = lds_byte(wr * 64 + fr, fq * 8), boff = lds_byte(wc * 32 + fr, fq * 8);
#define PG8_SA(b, h) (((b) * 2 + (h)) * HTB)
#define PG8_SB(b, h) ((4 + (b) * 2 + (h)) * HTB)
#define PG8_STAGE(bufoff, gbase, voff) do { _Pragma("unroll") for (int _i = 0; _i < 2; ++_i) \
        __builtin_amdgcn_global_load_lds((const unsigned*)((const char*)(gbase) + (voff)[_i]), (LAS unsigned*)(lds + (bufoff) + ldsw + _i * 8192), 16, 0, 0); } while (0)
#define PG8_LDA(dst, b, h) do { _Pragma("unroll") for (int m = 0; m < 4; ++m) _Pragma("unroll") for (int k = 0; k < 2; ++k) dst[m][k] = *(const LAS bf16x8*)(lds + PG8_SA(b, h) + aoff + m * 2048 + k * 1024); } while (0)
#define PG8_LDB(dst, b, h) do { _Pragma("unroll") for (int n = 0; n < 2; ++n) _Pragma("unroll") for (int k = 0; k < 2; ++k) dst[n][k] = *(const LAS bf16x8*)(lds + PG8_SB(b, h) + boff + n * 2048 + k * 1024); } while (0)
#define PG8_MMA(ai, bj, At, Bt) do { __builtin_amdgcn_s_setprio(1); _Pragma("unroll") for (int m = 0; m < 4; ++m) _Pragma("unroll") for (int n = 0; n < 2; ++n) _Pragma("unroll") for (int k = 0; k < 2; ++k) \
        acc[ai][bj][m][n] = __builtin_amdgcn_mfma_f32_16x16x32_bf16(Bt[n][k], At[m][k], acc[ai][bj][m][n], 0, 0, 0); __builtin_amdgcn_s_setprio(0); } while (0)
#define PG8_WAIT_V(n) asm volatile("s_waitcnt vmcnt(" #n ")" ::: "memory")
#define PG8_WAIT_L(n) asm volatile("s_waitcnt lgkmcnt(" #n ")" ::: "memory")
#define PG8_BAR __builtin_amdgcn_s_barrier()
#define PG8_SCHED __builtin_amdgcn_sched_barrier(0)
    Unit cur, nxt; int ui = 0;
    if (!S.next(0, cur)) return;
    f32x4 acc[2][2][4][2];
#pragma unroll
    for (int a = 0; a < 2; ++a)
#pragma unroll
        for (int b = 0; b < 2; ++b)
#pragma unroll
            for (int m = 0; m < 4; ++m)
#pragma unroll
                for (int n = 0; n < 2; ++n) acc[a][b][m][n] = (f32x4){0.f, 0.f, 0.f, 0.f};
    bf16x8 At[4][2], B0[2][2], B1[2][2];
    const char* cA = (const char*)g.A + (size_t)cur.pm * tstepA; const char* cB = (const char*)g.Bt + (size_t)cur.pn * tstepB;
    if constexpr (SP2) {
        PG8_STAGE(PG8_SB(0, 0), cB, voffB); PG8_STAGE(PG8_SB(0, 1), cB + hstepB, voffB); PG8_STAGE(PG8_SA(0, 0), cA, voffA); PG8_STAGE(PG8_SA(0, 1), cA + hstepA, voffA);
        if (wr == 1) PG8_BAR;
        PG8_WAIT_V(2); PG8_BAR;
        PG8_STAGE(PG8_SB(1, 0), cB + kstep, voffB); PG8_STAGE(PG8_SA(1, 0), cA + kstep, voffA); PG8_STAGE(PG8_SB(1, 1), cB + hstepB + kstep, voffB);
        PG8_WAIT_V(6); PG8_BAR;
    } else {
        PG8_STAGE(PG8_SB(0, 0), cB, voffB); PG8_STAGE(PG8_SA(0, 0), cA, voffA); PG8_STAGE(PG8_SB(0, 1), cB + hstepB, voffB); PG8_STAGE(PG8_SA(0, 1), cA + hstepA, voffA);
        if (wr == 1) PG8_BAR;
        PG8_WAIT_V(4); PG8_BAR;
        PG8_STAGE(PG8_SB(1, 0), cB + kstep, voffB); PG8_STAGE(PG8_SA(1, 0), cA + kstep, voffA); PG8_STAGE(PG8_SB(1, 1), cB + hstepB + kstep, voffB);
        PG8_WAIT_V(6); PG8_BAR;
    }
    for (;;) {
        const bool has_next = S.next(ui + 1, nxt);
        const char* nA = has_next ? (const char*)g.A + (size_t)nxt.pm * tstepA : cA; const char* nB = has_next ? (const char*)g.Bt + (size_t)nxt.pn * tstepB : cB;
        for (int t = 0; t < nt; t += 2) {
            const bool last = (t == nt - 2);
            const char* a1 = cA + (size_t)(t + 1) * kstep;
            const char* a2 = last ? nA : cA + (size_t)(t + 2) * kstep; const char* b2 = last ? nB : cB + (size_t)(t + 2) * kstep;
            const char* a3 = a2 + kstep; const char* b3 = b2 + kstep;
            if constexpr (SP2) {
            PG8_LDB(B0, 0, 0); PG8_LDB(B1, 0, 1); PG8_SCHED; PG8_LDA(At, 0, 0); PG8_STAGE(PG8_SA(1, 1), a1 + hstepA, voffA);
            PG8_WAIT_V(8); PG8_WAIT_L(0); PG8_BAR; PG8_MMA(0, 0, At, B0); PG8_MMA(0, 1, At, B1); PG8_BAR; PG8_SCHED;
            PG8_LDA(At, 0, 1); PG8_STAGE(PG8_SB(0, 0), b2, voffB); PG8_STAGE(PG8_SB(0, 1), b2 + hstepB, voffB); PG8_STAGE(PG8_SA(0, 0), a2, voffA);
            PG8_WAIT_V(8); PG8_WAIT_L(0); PG8_BAR; PG8_MMA(1, 0, At, B0); PG8_MMA(1, 1, At, B1); PG8_BAR; PG8_SCHED;
            PG8_LDB(B0, 1, 0); PG8_LDB(B1, 1, 1); PG8_SCHED; PG8_LDA(At, 1, 0); PG8_STAGE(PG8_SA(0, 1), a2 + hstepA, voffA);
            PG8_WAIT_V(8); PG8_WAIT_L(0); PG8_BAR; PG8_MMA(0, 0, At, B0); PG8_MMA(0, 1, At, B1); PG8_BAR; PG8_SCHED;
            PG8_LDA(At, 1, 1); PG8_STAGE(PG8_SB(1, 0), b3, voffB); PG8_STAGE(PG8_SB(1, 1), b3 + hstepB, voffB); PG8_STAGE(PG8_SA(1, 0), a3, voffA);
            PG8_WAIT_V(8); PG8_WAIT_L(0); PG8_BAR; PG8_MMA(1, 0, At, B0); PG8_MMA(1, 1, At, B1); PG8_BAR; PG8_SCHED;
            } else {
            PG8_LDB(B0, 0, 0); PG8_SCHED; PG8_LDA(At, 0, 0); PG8_STAGE(PG8_SA(1, 1), a1 + hstepA, voffA);
            PG8_WAIT_L(8); PG8_BAR; PG8_WAIT_L(0); PG8_MMA(0, 0, At, B0); PG8_BAR; PG8_SCHED;
            PG8_LDB(B1, 0, 1); PG8_STAGE(PG8_SB(0, 0), b2, voffB);
            PG8_BAR; PG8_WAIT_L(0); PG8_MMA(0, 1, At, B1); PG8_BAR;
            PG8_LDA(At, 0, 1); PG8_STAGE(PG8_SA(0, 0), a2, voffA);
            PG8_BAR; PG8_WAIT_L(0); PG8_MMA(1, 0, At, B0); PG8_BAR; PG8_SCHED;
            PG8_STAGE(PG8_SB(0, 1), b2 + hstepB, voffB);
            PG8_WAIT_V(6); PG8_BAR; PG8_MMA(1, 1, At, B1); PG8_BAR;
            PG8_LDB(B0, 1, 0); PG8_SCHED; PG8_LDA(At, 1, 0); PG8_STAGE(PG8_SA(0, 1), a2 + hstepA, voffA);
            PG8_WAIT_L(8); PG8_BAR; PG8_WAIT_L(0); PG8_MMA(0, 0, At, B0); PG8_BAR; PG8_SCHED;
            PG8_LDB(B1, 1, 1); PG8_STAGE(PG8_SB(1, 0), b3, voffB);
            PG8_BAR; PG8_WAIT_L(0); PG8_MMA(0, 1, At, B1); PG8_BAR;
            PG8_LDA(At, 1, 1); PG8_STAGE(PG8_SA(1, 0), a3, voffA);
            PG8_BAR; PG8_WAIT_L(0); PG8_MMA(1, 0, At, B0); PG8_BAR; PG8_SCHED;
            PG8_STAGE(PG8_SB(1, 1), b3 + hstepB, voffB);
            PG8_WAIT_V(6); PG8_BAR; PG8_MMA(1, 1, At, B1); PG8_BAR;
                    }
        }
        if constexpr (ALIGN_EPI) { if (wr == 0) PG8_BAR; }
        E(acc, cur, wr, wc, fr, fq);
        if (!has_next) break;
#pragma unroll
        for (int a = 0; a < 2; ++a)
#pragma unroll
            for (int b = 0; b < 2; ++b)
#pragma unroll
                for (int m = 0; m < 4; ++m)
#pragma unroll
                    for (int n = 0; n < 2; ++n) acc[a][b][m][n] = (f32x4){0.f, 0.f, 0.f, 0.f};
        cur = nxt; cA = nA; cB = nB; ++ui;
        if constexpr (ALIGN_EPI) { if (wr == 1) PG8_BAR; }
    }
    PG8_WAIT_V(0);
    if constexpr (!ALIGN_EPI) { if (wr == 0) PG8_BAR; }
    PG8_BAR;
    if constexpr (AFTER) E.after(acc, cur, wr, wc, fr, fq);
#undef PG8_SA
#undef PG8_SB
#undef PG8_STAGE
#undef PG8_LDA
#undef PG8_LDB
#undef PG8_MMA
#undef PG8_WAIT_V
#undef PG8_WAIT_L
#undef PG8_BAR
#undef PG8_SCHED
}
}
using pg8::Unit;


__device__ __forceinline__ int inproj_row(int e) {
    const int pn = e >> 8, o = e & 255;
    const int wc = o >> 6, bj = (o >> 5) & 1, fq = (o >> 3) & 3, n = (o >> 2) & 1, i = o & 3;
    return 256 * pn + 128 * bj + 32 * wc + 16 * n + 4 * fq + i;
}

struct EpiInProj {
    const float *rs, *cosT, *sinT;
    bf16_t *Q, *Kk, *VT, *SZA, *SZS, *XU; float* KSUM;
    __device__ __forceinline__ void operator()(const f32x4 (&acc)[2][2][4][2], const Unit& u, int wr, int wc, int fr, int fq) const {
        const int seg = u.pn >> 1, half = u.pn & 1;
        const int b = u.pm >> 3, blk = u.pm & 7;
        const int lbase = blk * 256 + wr * 64 + fr;
        if (seg <= 1) {
            bf16_t* dst = seg == 0 ? Q : Kk; const float qs = seg == 0 ? 0.18033688011112042f : 1.0f;
            const int head = 4 * half + wc;
            f32x4 cl[2], ch[2];
#pragma unroll
            for (int n = 0; n < 2; ++n) { cl[n] = (f32x4){0.f, 0.f, 0.f, 0.f}; ch[n] = (f32x4){0.f, 0.f, 0.f, 0.f}; }
            bf16_t* obase = dst + ((size_t)((b * 8 + head) * 2048)) * 64 + 8 * fq;
#pragma unroll
            for (int ai = 0; ai < 2; ++ai)
#pragma unroll
                for (int m = 0; m < 4; ++m) {
                    const int l = lbase + 128 * ai + 16 * m; const float rsv = rs[b * 2048 + l] * qs;
                    unsigned wl[4], wh[4];
#pragma unroll
                    for (int n = 0; n < 2; ++n) {
                        const f32x4 c4 = *(const f32x4*)(cosT + l * 32 + 8 * fq + 4 * n), s4 = *(const f32x4*)(sinT + l * 32 + 8 * fq + 4 * n);
                        const f32x4 t1 = acc[ai][0][m][n] * rsv, t2 = acc[ai][1][m][n] * rsv;
                        const f32x4 lo = t1 * c4 - t2 * s4, hi = t2 * c4 + t1 * s4;
                        wl[2 * n] = pk2(lo[0], lo[1]); wl[2 * n + 1] = pk2(lo[2], lo[3]); wh[2 * n] = pk2(hi[0], hi[1]); wh[2 * n + 1] = pk2(hi[2], hi[3]);
                        cl[n] += lo; ch[n] += hi;
                    }
                    bf16_t* o = obase + (unsigned)l * 64u;
                    *(u32x4*)o = (u32x4){wl[0], wl[1], wl[2], wl[3]};
                    *(u32x4*)(o + 32) = (u32x4){wh[0], wh[1], wh[2], wh[3]};
                }
            if (seg == 1) {
#pragma unroll
                for (int n = 0; n < 2; ++n)
#pragma unroll
                    for (int i = 0; i < 4; ++i) {
                        float v = cl[n][i], v2 = ch[n][i];
                        v += __shfl_xor(v, 1); v += __shfl_xor(v, 2); v += __shfl_xor(v, 4); v += __shfl_xor(v, 8);
                        v2 += __shfl_xor(v2, 1); v2 += __shfl_xor(v2, 2); v2 += __shfl_xor(v2, 4); v2 += __shfl_xor(v2, 8);
                        if (fr == 0) { float* kp = KSUM + ((b * 8 + head) * 8 + blk) * 64 + 8 * fq + 4 * n + i; atomicAdd(kp, v); atomicAdd(kp + 32, v2); }
                    }
            }
        } else if (seg == 2) {
            const int head = 4 * half + wc;
#pragma unroll
            for (int ai = 0; ai < 2; ++ai)
#pragma unroll
                for (int m = 0; m < 4; ++m) {
                    const int l = lbase + 128 * ai + 16 * m; const float rsv = rs[b * 2048 + l];
#pragma unroll
                    for (int bj = 0; bj < 2; ++bj)
#pragma unroll
                        for (int n = 0; n < 2; ++n) {
                            const int d0 = 32 * bj + 8 * fq + 4 * n;
                            const f32x4 v = acc[ai][bj][m][n] * rsv;
                            bf16_t* o = VT + ((size_t)((b * 8 + head) * 64 + d0)) * 2048 + l;
                            const unsigned p0 = pk2(v[0], v[1]), p1 = pk2(v[2], v[3]);
                            o[0] = (bf16_t)(p0 & 0xffffu); o[2048] = (bf16_t)(p0 >> 16); o[4096] = (bf16_t)(p1 & 0xffffu); o[6144] = (bf16_t)(p1 >> 16);
                        }
                }
        } else if (seg == 4) {
#pragma unroll
            for (int ai = 0; ai < 2; ++ai)
#pragma unroll
                for (int m = 0; m < 4; ++m) {
                    const int l = lbase + 128 * ai + 16 * m; const float rsv = rs[b * 2048 + l];
                    const int c = l >> 4, t = l & 15;
#pragma unroll
                    for (int bj = 0; bj < 2; ++bj) {
                        const int g = 16 * half + 4 * wc + 2 * bj + (fq >> 1);
                        const f32x4 v0 = acc[ai][bj][m][0] * rsv, v1 = acc[ai][bj][m][1] * rsv;
                        bf16_t* o = XU + ((size_t)(1024 * g + b * 128 + c)) * 384 + 128 + t * 16 + 8 * (fq & 1);
                        *(u32x4*)o = (u32x4){pk2(v0[0], v0[1]), pk2(v0[2], v0[3]), pk2(v1[0], v1[1]), pk2(v1[2], v1[3])};
                    }
                }
        } else {
            bf16_t* dst = seg == 3 ? SZA : SZS;
#pragma unroll
            for (int ai = 0; ai < 2; ++ai)
#pragma unroll
                for (int m = 0; m < 4; ++m) {
                    const int l = lbase + 128 * ai + 16 * m; const int row = b * 2048 + l; const float rsv = rs[row];
#pragma unroll
                    for (int bj = 0; bj < 2; ++bj) {
                        const int col = 256 * half + 64 * wc + 32 * bj + 8 * fq;
                        const f32x4 v0 = acc[ai][bj][m][0] * rsv, v1 = acc[ai][bj][m][1] * rsv;
                        *(u32x4*)(dst + (size_t)row * 512 + col) = (u32x4){pk2(siluf_(v0[0]), siluf_(v0[1])), pk2(siluf_(v0[2]), siluf_(v0[3])), pk2(siluf_(v1[0]), siluf_(v1[1])), pk2(siluf_(v1[2]), siluf_(v1[3]))};
                    }
                }
        }
    }
};

struct EpiS {
    float* SST;
    __device__ __forceinline__ void operator()(const f32x4 (&acc)[2][2][4][2], const Unit& u, int wr, int wc, int fr, int fq) const {
#pragma unroll
        for (int ai = 0; ai < 2; ++ai)
#pragma unroll
            for (int m = 0; m < 4; ++m) {
                const int R = 256 * u.pm + 128 * ai + 64 * wr + 16 * m + fr;
#pragma unroll
                for (int n = 0; n < 2; ++n) *(f32x4*)(SST + (size_t)R * 128 + 32 * wc + 16 * n + 4 * fq) = acc[ai][0][m][n];
            }
    }
};

struct EpiY {
    bf16_t* YG;
    __device__ __forceinline__ void operator()(const f32x4 (&acc)[2][2][4][2], const Unit& u, int wr, int wc, int fr, int fq) const {
        const int g = u.pn, t = 4 * wc + fq;
#pragma unroll
        for (int ai = 0; ai < 2; ++ai)
#pragma unroll
            for (int m = 0; m < 4; ++m) {
                const int rr = 256 * (u.pm & 3) + 128 * ai + 64 * wr + 16 * m + fr;
                const int b = rr >> 7, c = rr & 127; const int token = b * 2048 + 16 * c + t;
                bf16_t* ob = YG + (size_t)token * 512 + 16 * g;
#pragma unroll
                for (int bj = 0; bj < 2; ++bj) {
                    const f32x4 v0 = acc[ai][bj][m][0], v1 = acc[ai][bj][m][1];
                    *(u32x4*)(ob + 8 * bj) = (u32x4){pk2(gelu_tanh(v0[0]), gelu_tanh(v0[1])), pk2(gelu_tanh(v0[2]), gelu_tanh(v0[3])), pk2(gelu_tanh(v1[0]), gelu_tanh(v1[1])), pk2(gelu_tanh(v1[2]), gelu_tanh(v1[3]))};
                }
            }
    }
};

struct EpiGlu {
    const bf16_t *YG, *SZS; const float* bglu; bf16_t* MIXED;
    __device__ __forceinline__ void operator()(const f32x4 (&acc)[2][2][4][2], const Unit& u, int wr, int wc, int fr, int fq) const {
        f32x4 bias[2][2];
#pragma unroll
        for (int bj = 0; bj < 2; ++bj)
#pragma unroll
            for (int n = 0; n < 2; ++n) bias[bj][n] = *(const f32x4*)(bglu + 256 * u.pn + 64 * wc + 32 * bj + 8 * fq + 4 * n);
#pragma unroll
        for (int ai = 0; ai < 2; ++ai) {
            u32x4 y4[4][2], z4[4][2];
#pragma unroll
            for (int m = 0; m < 4; ++m) {
                const int row = 256 * u.pm + 128 * ai + 64 * wr + 16 * m + fr;
#pragma unroll
                for (int bj = 0; bj < 2; ++bj) {
                    const unsigned off = (unsigned)row * 512u + (unsigned)(256 * u.pn + 64 * wc + 32 * bj + 8 * fq);
                    y4[m][bj] = *(const u32x4*)(YG + off); z4[m][bj] = *(const u32x4*)(SZS + off);
                }
            }
#pragma unroll
            for (int m = 0; m < 4; ++m) {
                const int row = 256 * u.pm + 128 * ai + 64 * wr + 16 * m + fr;
#pragma unroll
                for (int bj = 0; bj < 2; ++bj) {
                    const int col = 256 * u.pn + 64 * wc + 32 * bj + 8 * fq;
                    unsigned w[4];
#pragma unroll
                    for (int n = 0; n < 2; ++n) {
                        const f32x4 a = acc[ai][bj][m][n] + bias[bj][n];
                        const unsigned ya = y4[m][bj][2 * n], yb = y4[m][bj][2 * n + 1], za = z4[m][bj][2 * n], zb = z4[m][bj][2 * n + 1];
                        const float o0 = bflo(ya) * sigmoidf_(a[0]) * bflo(za), o1 = bfhi(ya) * sigmoidf_(a[1]) * bfhi(za);
                        const float o2 = bflo(yb) * sigmoidf_(a[2]) * bflo(zb), o3 = bfhi(yb) * sigmoidf_(a[3]) * bfhi(zb);
                        w[2 * n] = pk2(o0, o1); w[2 * n + 1] = pk2(o2, o3);
                    }
                    *(u32x4*)(MIXED + (size_t)row * 1024 + 512 + col) = (u32x4){w[0], w[1], w[2], w[3]};
                }
            }
        }
    }
};

struct EpiOut {
    const float* x; float* out; float* SSQ;
    __device__ __forceinline__ void operator()(const f32x4 (&acc)[2][2][4][2], const Unit& u, int wr, int wc, int fr, int fq) const {
#pragma unroll
        for (int ai = 0; ai < 2; ++ai) {
            f32x4 xv[4][2][2];
#pragma unroll
            for (int m = 0; m < 4; ++m) {
                const int row = 256 * u.pm + 128 * ai + 64 * wr + 16 * m + fr;
#pragma unroll
                for (int bj = 0; bj < 2; ++bj)
#pragma unroll
                    for (int n = 0; n < 2; ++n) xv[m][bj][n] = *(const f32x4*)(x + (size_t)row * 1024 + 256 * u.pn + 64 * wc + 32 * bj + 8 * fq + 4 * n);
            }
#pragma unroll
            for (int m = 0; m < 4; ++m) {
                const int row = 256 * u.pm + 128 * ai + 64 * wr + 16 * m + fr;
                float ss = 0.f;
#pragma unroll
                for (int bj = 0; bj < 2; ++bj)
#pragma unroll
                    for (int n = 0; n < 2; ++n) {
                        const int col = 256 * u.pn + 64 * wc + 32 * bj + 8 * fq + 4 * n;
                        const f32x4 v = acc[ai][bj][m][n] + xv[m][bj][n];
                        *(f32x4*)(out + (size_t)row * 1024 + col) = v;
                        ss += (v[0] * v[0] + v[1] * v[1]) + (v[2] * v[2] + v[3] * v[3]);
                    }
                ss += __shfl_xor(ss, 16); ss += __shfl_xor(ss, 32);
                if (fq == 0) SSQ[row * 16 + 4 * u.pn + wc] = ss;
            }
        }
    }
};

struct EpiOutFused {
    const float* x; float* out; float* SSQ; const float* gain; XcdBarrier xbar;
    __device__ __forceinline__ void operator()(f32x4 (&acc)[2][2][4][2], const Unit& u, int wr, int wc, int fr, int fq) const {
#pragma unroll
        for (int ai = 0; ai < 2; ++ai) {
            f32x4 xv[4][2][2];
#pragma unroll
            for (int m = 0; m < 4; ++m) {
                const int row = 256 * u.pm + 128 * ai + 64 * wr + 16 * m + fr;
#pragma unroll
                for (int bj = 0; bj < 2; ++bj)
#pragma unroll
                    for (int n = 0; n < 2; ++n) xv[m][bj][n] = *(const f32x4*)(x + (size_t)row * 1024 + 256 * u.pn + 64 * wc + 32 * bj + 8 * fq + 4 * n);
            }
#pragma unroll
            for (int m = 0; m < 4; ++m) {
                const int row = 256 * u.pm + 128 * ai + 64 * wr + 16 * m + fr;
                float ss = 0.f;
#pragma unroll
                for (int bj = 0; bj < 2; ++bj)
#pragma unroll
                    for (int n = 0; n < 2; ++n) {
                        const f32x4 v = acc[ai][bj][m][n] + xv[m][bj][n];
                        acc[ai][bj][m][n] = v;
                        ss += (v[0] * v[0] + v[1] * v[1]) + (v[2] * v[2] + v[3] * v[3]);
                    }
                ss += __shfl_xor(ss, 16); ss += __shfl_xor(ss, 32);
                if (fq == 0) SSQ[row * 16 + 4 * u.pn + wc] = ss;
            }
        }
    }
    __device__ __forceinline__ void after(f32x4 (&acc)[2][2][4][2], const Unit& u, int wr, int wc, int fr, int fq) const {
        xcd_barrier(xbar);
        f32x4 gn[2][2];
#pragma unroll
        for (int bj = 0; bj < 2; ++bj)
#pragma unroll
            for (int n = 0; n < 2; ++n) gn[bj][n] = *(const f32x4*)(gain + 256 * u.pn + 64 * wc + 32 * bj + 8 * fq + 4 * n);
#pragma unroll
        for (int ai = 0; ai < 2; ++ai)
#pragma unroll
            for (int m = 0; m < 4; ++m) {
                const int row = 256 * u.pm + 128 * ai + 64 * wr + 16 * m + fr;
                const f32x4* sp = (const f32x4*)(SSQ + row * 16);
                const f32x4 s0 = sp[0], s1 = sp[1], s2 = sp[2], s3 = sp[3];
                const float tot = ((s0[0] + s0[1]) + (s0[2] + s0[3])) + ((s1[0] + s1[1]) + (s1[2] + s1[3])) + ((s2[0] + s2[1]) + (s2[2] + s2[3])) + ((s3[0] + s3[1]) + (s3[2] + s3[3]));
                const float rinv = 1.0f / sqrtf(tot * (1.f / DM) + 1e-6f);
#pragma unroll
                for (int bj = 0; bj < 2; ++bj)
#pragma unroll
                    for (int n = 0; n < 2; ++n) {
                        const int col = 256 * u.pn + 64 * wc + 32 * bj + 8 * fq + 4 * n;
                        *(f32x4*)(out + (size_t)row * 1024 + col) = acc[ai][bj][m][n] * rinv * gn[bj][n];
                    }
            }
    }
};

template <int MODE>
__device__ __forceinline__ void transpose_item(const float* W, int K, int N, bf16_t* WT, const float* gain, LAS float* scr, int item, int lane) {
    const int nblk = N / 32, kb = item / nblk, nb = item % nblk, k0 = 64 * kb, n0 = 32 * nb;
#pragma unroll 8
    for (int i = 0; i < 32; ++i) { const int kk = 2 * i + (lane >> 5); float w = W[(size_t)(k0 + kk) * N + n0 + (lane & 31)]; if (MODE == 0) w *= gain[k0 + kk]; scr[kk * 33 + (lane & 31)] = w; }
    const int c = lane & 7;
#pragma unroll
    for (int j = 0; j < 4; ++j) { const int n = (lane >> 3) + 8 * j; const LAS float* s = scr + (8 * c) * 33 + n;
        u32x4 o; o.x = pk2(s[0 * 33], s[1 * 33]); o.y = pk2(s[2 * 33], s[3 * 33]); o.z = pk2(s[4 * 33], s[5 * 33]); o.w = pk2(s[6 * 33], s[7 * 33]);
        const int drow = inproj_row(n0 + n);
        *(u32x4*)(WT + (size_t)drow * K + k0 + 8 * c) = o; }
}

__device__ __forceinline__ void ssm_group_prep(const Params& p, int item, LAS float* L) {
    LAS float* lkr = L; LAS float* lki = L + 1088; LAS float* bbr = L + 2176; LAS float* bbi = L + 3200; LAS float* cr = L + 4224; LAS float* ci = L + 5248; LAS float* Kt = L + 6272;
    const int tid = threadIdx.x, g = item >> 3, sub = item & 7;
    const float dt = expf(p.log_dt[g]);
    for (int t = tid; t < 17 * 64; t += 512) {
        const int pp = t & 63, k = t >> 6;
        const float a = p.lam_re[g * 64 + pp] * dt, th = p.lam_im[g * 64 + pp] * dt;
        const float mag = expf((float)k * a); float sn, cs; sincosf((float)k * th, &sn, &cs);
        lkr[k * 64 + pp] = mag * cs; lki[k * 64 + pp] = mag * sn;
    }
    for (int t = tid; t < 1024; t += 512) {
        const int pp = t >> 4, h = t & 15;
        const float lr = p.lam_re[g * 64 + pp], li = p.lam_im[g * 64 + pp];
        const float a = lr * dt, th = li * dt;
        float sn, cs; sincosf(th, &sn, &cs); const float sh = sinf(0.5f * th);
        const float em1 = expm1f(a), ea = em1 + 1.f;
        const float xr = em1 * cs - 2.f * sh * sh, xi = ea * sn;
        const float den = 1.f / (lr * lr + li * li);
        const float cfr = (xr * lr + xi * li) * den, cfi = (xi * lr - xr * li) * den;
        const float br = p.b_re[(g * 64 + pp) * 16 + h], bi = p.b_im[(g * 64 + pp) * 16 + h];
        bbr[pp * 16 + h] = cfr * br - cfi * bi; bbi[pp * 16 + h] = cfr * bi + cfi * br;
        cr[h * 64 + pp] = p.c_re[(g * 16 + h) * 64 + pp]; ci[h * 64 + pp] = p.c_im[(g * 16 + h) * 64 + pp];
    }
    __syncthreads();
    {
        const int k = tid >> 5, hl = (tid >> 4) & 1, h2 = tid & 15, h = 2 * sub + hl;
        float sacc = 0.f;
        for (int pp = 0; pp < 64; ++pp) {
            const float c_r = cr[h * 64 + pp], c_i = ci[h * 64 + pp], l_r = lkr[k * 64 + pp], l_i = lki[k * 64 + pp];
            const float er = c_r * l_r - c_i * l_i, ei = c_r * l_i + c_i * l_r;
            sacc += er * bbr[pp * 16 + h2] - ei * bbi[pp * 16 + h2];
        }
        if (k == 0 && h == h2) sacc += p.d_skip[g * 16 + h];
        Kt[tid] = sacc;
    }
    __syncthreads();
    bf16_t* WCAT = (bf16_t*)(p.ws + WS_WCAT) + (size_t)g * 256 * 384;
    bf16_t* WST = (bf16_t*)(p.ws + WS_WST) + (size_t)g * 256 * 256;
    for (int e = tid; e < 32 * 192; e += 512) {
        const int rl = e / 192, kk = (e - rl * 192) * 2;
        const int t = rl >> 1, hl = rl & 1, h = 2 * sub + hl;
        const int row = 128 * (h >> 3) + 32 * (t >> 2) + 16 * ((h >> 2) & 1) + 4 * (t & 3) + (h & 3);
        float v[2];
#pragma unroll
        for (int q = 0; q < 2; ++q) {
            const int k2 = kk + q;
            if (k2 < 128) { const int pp = k2 & 63; const float c_r = cr[h * 64 + pp], c_i = ci[h * 64 + pp], l_r = lkr[(t + 1) * 64 + pp], l_i = lki[(t + 1) * 64 + pp];
                v[q] = k2 < 64 ? (c_r * l_r - c_i * l_i) : -(c_r * l_i + c_i * l_r); }
            else { const int s2 = (k2 - 128) >> 4, h2 = (k2 - 128) & 15; v[q] = s2 <= t ? Kt[((t - s2) * 2 + hl) * 16 + h2] : 0.f; }
        }
        *(unsigned*)(WCAT + (size_t)row * 384 + kk) = pk2(v[0], v[1]);
    }
    for (int e = tid; e < 32 * 128; e += 512) {
        const int rl = e >> 7, kk = (e & 127) * 2;
        const int row = rl < 16 ? 16 * sub + rl : 128 + 16 * sub + (rl - 16);
        float v[2] = {0.f, 0.f};
        if (row < 128) {
            const int pp = row & 63;
#pragma unroll
            for (int q = 0; q < 2; ++q) { const int s2 = (kk + q) >> 4, h = (kk + q) & 15; const float l_r = lkr[(15 - s2) * 64 + pp], l_i = lki[(15 - s2) * 64 + pp], b_r = bbr[pp * 16 + h], b_i = bbi[pp * 16 + h];
                v[q] = row < 64 ? (l_r * b_r - l_i * b_i) : (l_r * b_i + l_i * b_r); }
        }
        *(unsigned*)(WST + (size_t)row * 256 + kk) = pk2(v[0], v[1]);
    }
    if (sub == 0 && tid < 64) { float* L16 = (float*)(p.ws + WS_LAM16) + (g * 64 + tid) * 2; L16[0] = lkr[16 * 64 + tid]; L16[1] = lki[16 * 64 + tid]; }
    __syncthreads();
}

__device__ __forceinline__ void phase_prep(const Params& p, LAS unsigned char* lds) {
    const int tid = threadIdx.x, lane = tid & 63, wave = tid >> 6, G = gridDim.x, bid = blockIdx.x;
    for (int item = bid; item < 256; item += G) ssm_group_prep(p, item, (LAS float*)lds);
    const int gw = bid * 8 + wave, NGW = G * 8;
    {
        bf16_t* XB = (bf16_t*)(p.ws + WS_XB); float* RS = (float*)(p.ws + WS_RS);
        for (int row = gw; row < NTOK; row += NGW) {
            const f32x4* xr = (const f32x4*)(p.x + (size_t)row * DM) + lane;
            f32x4 v[4]; float s = 0.f;
#pragma unroll
            for (int j = 0; j < 4; ++j) { v[j] = xr[64 * j]; s += (v[j][0] * v[j][0] + v[j][1] * v[j][1]) + (v[j][2] * v[j][2] + v[j][3] * v[j][3]); }
            s = wave_sum(s);
            if (lane == 0) RS[row] = 1.0f / sqrtf(s * (1.f / DM) + 1e-6f);
            u32x2* o = (u32x2*)(XB + (size_t)row * DM) + lane;
#pragma unroll
            for (int j = 0; j < 4; ++j) o[64 * j] = (u32x2){pk2(v[j][0], v[j][1]), pk2(v[j][2], v[j][3])};
        }
    }
    {
        LAS float* scr = (LAS float*)(lds + 49152) + wave * (64 * 33);
        constexpr int I_IN = (DM / 64) * (NPROJ / 32), I_OUT = (DM / 64) * (DM / 32), I_GLU = (512 / 64) * (512 / 32);
        for (int it = gw; it < I_IN + I_OUT + I_GLU; it += NGW) {
            int r = it;
            if (r < I_IN) { transpose_item<0>(p.w_in, DM, NPROJ, (bf16_t*)(p.ws + WS_WINT), p.norm_gain, scr, r, lane); continue; } r -= I_IN;
            if (r < I_OUT) { transpose_item<1>(p.w_out, DM, DM, (bf16_t*)(p.ws + WS_WOUTT), nullptr, scr, r, lane); continue; } r -= I_OUT;
            transpose_item<1>(p.w_glu, 512, 512, (bf16_t*)(p.ws + WS_WGLUT), nullptr, scr, r, lane);
        }
    }
    {
        float* COS = (float*)(p.ws + WS_COS); float* SIN = (float*)(p.ws + WS_SIN); float* KSUM = (float*)(p.ws + WS_KSUM);
        for (int i = bid * 512 + tid; i < SEQ * 32; i += G * 512) {
            const int pos = i >> 5, f = i & 31;
            const float inv = 1.0f / powf(10000.0f, (float)f * (1.f / 32.f));
            const float ang = (float)pos * inv; float sn, cs; sincosf(ang, &sn, &cs);
            COS[i] = cs; SIN[i] = sn;
        }
        for (int i = bid * 512 + tid; i < 4096; i += G * 512) KSUM[i] = 0.f;
    }
}

__device__ __forceinline__ int swap23(int r) { return (r & ~12) | ((r & 4) << 1) | ((r & 8) >> 1); }

typedef float f32x2 __attribute__((ext_vector_type(2)));
__device__ __forceinline__ float max3f(float a, float b, float c) { float r; asm("v_max3_f32 %0, %1, %2, %3" : "=v"(r) : "v"(a), "v"(b), "v"(c)); return r; }
template <bool DIAG>
__device__ __forceinline__ void attn_tile(LAS unsigned char* B, unsigned kf_off, unsigned vf_off, const bf16x8 (&qf)[4], f32x16& O0, f32x16& O1, float& mrun, float& lrun,
                                          bool on, int kpos0, int qpos, int hh) {
    constexpr int ROWB = 144;
    f32x16 st0, st1;
#pragma unroll
    for (int i = 0; i < 16; ++i) { st0[i] = 0.f; st1[i] = 0.f; }
#pragma unroll
    for (int s = 0; s < 4; ++s) {
        const bf16x8 k0 = *(const LAS bf16x8*)(B + kf_off + s * 32), k1 = *(const LAS bf16x8*)(B + kf_off + 32 * ROWB + s * 32);
        st0 = __builtin_amdgcn_mfma_f32_32x32x16_bf16(k0, qf[s], st0, 0, 0, 0);
        st1 = __builtin_amdgcn_mfma_f32_32x32x16_bf16(k1, qf[s], st1, 0, 0, 0);
    }
    if (DIAG) {
#pragma unroll
        for (int i = 0; i < 16; ++i) {
            const int key = kpos0 + (i & 7) + 8 * hh + 16 * (i >> 3);
            if (key > qpos) st0[i] = -1e30f;
            if (key + 32 > qpos) st1[i] = -1e30f;
        }
    }
    float mx = max3f(st0[0], st0[1], st0[2]);
#pragma unroll
    for (int i = 3; i < 15; i += 2) mx = max3f(mx, st0[i], st0[i + 1]);
    mx = max3f(mx, st0[15], st1[0]);
#pragma unroll
    for (int i = 1; i < 15; i += 2) mx = max3f(mx, st1[i], st1[i + 1]);
    mx = fmaxf(mx, st1[15]);
    mx = fmaxf(mx, __shfl_xor(mx, 32));
    const bool grow = on && (mx > mrun + 8.f);
    if (__ballot(grow) != 0ull) {
        const float mnew = grow ? mx : mrun;
        const float alpha = __builtin_amdgcn_exp2f(mrun - mnew);
        lrun *= alpha; mrun = mnew;
#pragma unroll
        for (int i = 0; i < 16; ++i) { O0[i] *= alpha; O1[i] *= alpha; }
    }
    const float msub = on ? mrun : 1e30f;
    f32x2 rs2 = (f32x2){0.f, 0.f};
    const f32x2 ms2 = (f32x2){msub, msub};
#pragma unroll
    for (int i = 0; i < 16; i += 2) {
        f32x2 a = (f32x2){st0[i], st0[i + 1]} - ms2, c = (f32x2){st1[i], st1[i + 1]} - ms2;
        a[0] = __builtin_amdgcn_exp2f(a[0]); a[1] = __builtin_amdgcn_exp2f(a[1]); c[0] = __builtin_amdgcn_exp2f(c[0]); c[1] = __builtin_amdgcn_exp2f(c[1]);
        st0[i] = a[0]; st0[i + 1] = a[1]; st1[i] = c[0]; st1[i + 1] = c[1];
        rs2 += a + c;
    }
    float rsum = rs2[0] + rs2[1];
    rsum += __shfl_xor(rsum, 32);
    lrun += rsum;
#pragma unroll
    for (int s4 = 0; s4 < 4; ++s4) {
        u32x4 t4;
        if (s4 < 2) t4 = (u32x4){pk2(st0[8 * s4], st0[8 * s4 + 1]), pk2(st0[8 * s4 + 2], st0[8 * s4 + 3]), pk2(st0[8 * s4 + 4], st0[8 * s4 + 5]), pk2(st0[8 * s4 + 6], st0[8 * s4 + 7])};
        else { const int s = s4 - 2; t4 = (u32x4){pk2(st1[8 * s], st1[8 * s + 1]), pk2(st1[8 * s + 2], st1[8 * s + 3]), pk2(st1[8 * s + 4], st1[8 * s + 5]), pk2(st1[8 * s + 6], st1[8 * s + 7])}; }
        const bf16x8 pf = __builtin_bit_cast(bf16x8, t4);
        const bf16x8 v0 = *(const LAS bf16x8*)(B + vf_off + s4 * 32), v1 = *(const LAS bf16x8*)(B + vf_off + 32 * ROWB + s4 * 32);
        O0 = __builtin_amdgcn_mfma_f32_32x32x16_bf16(v0, pf, O0, 0, 0, 0);
        O1 = __builtin_amdgcn_mfma_f32_32x32x16_bf16(v1, pf, O1, 0, 0, 0);
    }
}

__device__ __forceinline__ void phase_attn(const Params& p, LAS unsigned char* lds, unsigned* queue) {
    const int tid = threadIdx.x, lane = tid & 63, w = __builtin_amdgcn_readfirstlane(tid >> 6), r = lane & 31, hh = lane >> 5, G = gridDim.x;
    const bf16_t* Qg = (const bf16_t*)(p.ws + WS_Q); const bf16_t* Kg = (const bf16_t*)(p.ws + WS_K); const bf16_t* VTg = (const bf16_t*)(p.ws + WS_VT);
    const bf16_t* SZA = (const bf16_t*)(p.ws + WS_SZA); const float* KSUM = (const float*)(p.ws + WS_KSUM);
    bf16_t* MIXED = (bf16_t*)(p.ws + WS_XB);
    constexpr int ROWB = 144, TILEB = 64 * ROWB, BUFB = 2 * TILEB;
    const int srow = tid >> 3, sch = tid & 7;
    const unsigned st_off = (unsigned)(srow * ROWB + sch * 16);
    const unsigned kf_off = (unsigned)(swap23(r) * ROWB + hh * 16);
    const unsigned vf_off = (unsigned)(TILEB + r * ROWB + hh * 16);
    volatile LAS unsigned* tick = (volatile LAS unsigned*)(lds + 131072 + 8);
    for (;;) {
        if (tid == 0) *tick = __hip_atomic_fetch_add(queue, 1u, __ATOMIC_RELAXED, __HIP_MEMORY_SCOPE_AGENT);
        __syncthreads();
        const int idx = (int)*tick;
        if (idx >= 512) break;
        const int blk = 7 - (idx >> 6), bh = idx & 63, b = bh >> 3, h = bh & 7;
        const int qpos = blk * 256 + w * 32 + r;
        const bf16_t* Qp = Qg + ((size_t)bh * 2048 + qpos) * 64 + 8 * hh;
        bf16x8 qf[4];
#pragma unroll
        for (int s = 0; s < 4; ++s) qf[s] = *(const bf16x8*)(Qp + 16 * s);
        unsigned selmask;
        if (blk <= 3) selmask = (1u << blk) - 1u;
        else {
            float v1 = -3e38f, v2 = -3e38f, v3 = -3e38f; int i1 = 0, i2 = 0, i3 = 0;
#pragma unroll
            for (int j = 0; j < 7; ++j) {
                if (j < blk) {
                    const float* ks = KSUM + ((size_t)bh * 8 + j) * 64 + 8 * hh;
                    float gsum = 0.f;
#pragma unroll
                    for (int s = 0; s < 4; ++s) {
                        const f32x4 k0 = *(const f32x4*)(ks + 16 * s), k1 = *(const f32x4*)(ks + 16 * s + 4);
                        gsum += bf2f((unsigned short)qf[s][0]) * k0[0] + bf2f((unsigned short)qf[s][1]) * k0[1] + bf2f((unsigned short)qf[s][2]) * k0[2] + bf2f((unsigned short)qf[s][3]) * k0[3]
                              + bf2f((unsigned short)qf[s][4]) * k1[0] + bf2f((unsigned short)qf[s][5]) * k1[1] + bf2f((unsigned short)qf[s][6]) * k1[2] + bf2f((unsigned short)qf[s][7]) * k1[3];
                    }
                    gsum += __shfl_xor(gsum, 32);
                    if (gsum > v1) { v3 = v2; i3 = i2; v2 = v1; i2 = i1; v1 = gsum; i1 = j; }
                    else if (gsum > v2) { v3 = v2; i3 = i2; v2 = gsum; i2 = j; }
                    else if (gsum > v3) { v3 = gsum; i3 = j; }
                }
            }
            selmask = (1u << i1) | (1u << i2) | (1u << i3);
        }
        f32x16 O0, O1;
#pragma unroll
        for (int i = 0; i < 16; ++i) { O0[i] = 0.f; O1[i] = 0.f; }
        float mrun = -1e30f, lrun = 0.f;
        const int ntile = 4 + 4 * blk;
        const bf16_t* Kst = Kg + ((size_t)bh * 2048 + srow) * 64 + sch * 8;
        const bf16_t* Vst = VTg + ((size_t)bh * 64 + srow) * 2048 + sch * 8;
        u32x4 kreg[2], vreg[2];
#pragma unroll
        for (int q = 0; q < 2; ++q) { const int kp = blk * 256 + 64 * q; kreg[q] = *(const u32x4*)(Kst + (size_t)kp * 64); vreg[q] = *(const u32x4*)(Vst + kp); }
#pragma unroll
        for (int q = 0; q < 2; ++q) { *(LAS u32x4*)(lds + q * BUFB + st_off) = kreg[q]; *(LAS u32x4*)(lds + q * BUFB + TILEB + st_off) = vreg[q]; }
        __syncthreads();
        for (int n = 0; n < ntile; n += 2) {
            if (n + 2 < ntile) {
#pragma unroll
                for (int q = 0; q < 2; ++q) { const int m = n + 2 + q; const int kp = m < 4 ? blk * 256 + 64 * m : ((m - 4) >> 2) * 256 + 64 * ((m - 4) & 3);
                    kreg[q] = *(const u32x4*)(Kst + (size_t)kp * 64); vreg[q] = *(const u32x4*)(Vst + kp); }
            }
            LAS unsigned char* SB = lds + ((n >> 1) & 1) * (2 * BUFB);
#pragma unroll
            for (int q = 0; q < 2; ++q) {
                const int nn = n + q;
                const int kpos0 = nn < 4 ? blk * 256 + 64 * nn : ((nn - 4) >> 2) * 256 + 64 * ((nn - 4) & 3);
                LAS unsigned char* B = SB + q * BUFB;
                if (nn < 4) {
                    const int dt_ = w >> 1;
                    if (nn == dt_) attn_tile<true>(B, kf_off, vf_off, qf, O0, O1, mrun, lrun, true, kpos0, qpos, hh);
                    else if (nn < dt_) attn_tile<false>(B, kf_off, vf_off, qf, O0, O1, mrun, lrun, true, kpos0, qpos, hh);
                } else {
                    const bool on = (selmask >> ((nn - 4) >> 2)) & 1u;
                    if (__ballot(on) != 0ull) attn_tile<false>(B, kf_off, vf_off, qf, O0, O1, mrun, lrun, on, kpos0, qpos, hh);
                }
            }
            if (n + 2 < ntile) { LAS unsigned char* Bn = lds + (((n >> 1) + 1) & 1) * (2 * BUFB);
#pragma unroll
                for (int q = 0; q < 2; ++q) { *(LAS u32x4*)(Bn + q * BUFB + st_off) = kreg[q]; *(LAS u32x4*)(Bn + q * BUFB + TILEB + st_off) = vreg[q]; } }
            __syncthreads();
        }
        const float inv = 1.f / lrun;
        const size_t row = (size_t)b * 2048 + qpos;
#pragma unroll
        for (int dt = 0; dt < 2; ++dt)
#pragma unroll
            for (int g4 = 0; g4 < 4; ++g4) {
                const int d0 = 32 * dt + 8 * g4 + 4 * hh;
                const u32x2 z2 = *(const u32x2*)(SZA + row * 512 + h * 64 + d0);
                float o0, o1, o2, o3;
                if (dt == 0) { o0 = O0[4 * g4]; o1 = O0[4 * g4 + 1]; o2 = O0[4 * g4 + 2]; o3 = O0[4 * g4 + 3]; }
                else { o0 = O1[4 * g4]; o1 = O1[4 * g4 + 1]; o2 = O1[4 * g4 + 2]; o3 = O1[4 * g4 + 3]; }
                o0 *= inv * bflo(z2[0]); o1 *= inv * bfhi(z2[0]); o2 *= inv * bflo(z2[1]); o3 *= inv * bfhi(z2[1]);
                *(u32x2*)(MIXED + row * 1024 + h * 64 + d0) = (u32x2){pk2(o0, o1), pk2(o2, o3)};
            }
    }
}

__device__ __forceinline__ void scan_unit(const Params& p, LAS unsigned char* lds, int L) {
    const int tid = threadIdx.x, lane = tid & 63, wave = __builtin_amdgcn_readfirstlane(tid >> 6);
    float* SST = (float*)(p.ws + WS_SST); bf16_t* XU = (bf16_t*)(p.ws + WS_XU); const float* L16 = (const float*)(p.ws + WS_LAM16);
    LAS float* E = (LAS float*)lds;
    const int g = L >> 2;
    const float lr = L16[(g * 64 + lane) * 2], li = L16[(g * 64 + lane) * 2 + 1];
    float pr = lr, pi = li;
#pragma unroll
    for (int q = 0; q < 4; ++q) { const float nr = pr * pr - pi * pi, ni = 2.f * pr * pi; pr = nr; pi = ni; }
    for (int bb = 0; bb < 2; ++bb) {
        const size_t base = (size_t)256 * L + 128 * bb + 16 * wave;
        float sr[16], si[16];
#pragma unroll
        for (int c = 0; c < 16; ++c) { sr[c] = __hip_atomic_load(SST + (base + c) * 128 + lane, __ATOMIC_RELAXED, __HIP_MEMORY_SCOPE_AGENT); si[c] = __hip_atomic_load(SST + (base + c) * 128 + 64 + lane, __ATOMIC_RELAXED, __HIP_MEMORY_SCOPE_AGENT); }
        float er = 0.f, ei = 0.f;
#pragma unroll
        for (int c = 0; c < 16; ++c) { const float nr = lr * er - li * ei + sr[c], ni = lr * ei + li * er + si[c]; er = nr; ei = ni; }
        E[(wave * 2) * 64 + lane] = er; E[(wave * 2 + 1) * 64 + lane] = ei;
        __syncthreads();
        float Xr = 0.f, Xi = 0.f;
        for (int s2 = 0; s2 < wave; ++s2) { const float e_r = E[(s2 * 2) * 64 + lane], e_i = E[(s2 * 2 + 1) * 64 + lane]; const float nr = pr * Xr - pi * Xi + e_r, ni = pr * Xi + pi * Xr + e_i; Xr = nr; Xi = ni; }
#pragma unroll
        for (int c = 0; c < 16; ++c) {
            const size_t R = base + c;
            XU[R * 384 + lane] = (bf16_t)(pk2(Xr, 0.f) & 0xffffu); XU[R * 384 + 64 + lane] = (bf16_t)(pk2(Xi, 0.f) & 0xffffu);
            const float nr = lr * Xr - li * Xi + sr[c], ni = lr * Xi + li * Xr + si[c]; Xr = nr; Xi = ni;
        }
        __syncthreads();
    }
}

__device__ __forceinline__ void phase_norm(const Params& p) {
    const int tid = threadIdx.x, lane = tid & 63, wave = tid >> 6, G = gridDim.x;
    const float* SSQ = (const float*)(p.ws + WS_SSQ);
    f32x4 gn[4];
#pragma unroll
    for (int j = 0; j < 4; ++j) gn[j] = *((const f32x4*)p.final_gain + lane + 64 * j);
    for (int row = blockIdx.x * 8 + wave; row < NTOK; row += 8 * G) {
        float s = 0.f;
#pragma unroll
        for (int i = 0; i < 16; ++i) s += SSQ[row * 16 + i];
        const float rinv = 1.0f / sqrtf(s * (1.f / DM) + 1e-6f);
        f32x4* o = (f32x4*)(p.out + (size_t)row * DM) + lane;
#pragma unroll
        for (int j = 0; j < 4; ++j) { f32x4 v = o[64 * j]; v = v * rinv * gn[j]; o[64 * j] = v; }
    }
}

__global__ __launch_bounds__(512, 2) void hymba_fwd(Params p) {
    extern __shared__ __attribute__((aligned(16))) unsigned char shm_raw[];
    LAS unsigned char* lds = (LAS unsigned char*)shm_raw;
    cg::grid_group grid = cg::this_grid();
    const int G = gridDim.x, bid = blockIdx.x;
    unsigned char* ws = p.ws;
    const int lo = p.ph_lo, hi = p.ph_hi;
    if (threadIdx.x < 4) ((LAS unsigned*)(lds + 131072))[threadIdx.x] = 0u;
    __syncthreads();
    XcdBarrier xbar = xcd_barrier_post((unsigned*)(ws + WS_BAR), (volatile LAS unsigned*)(lds + 131072));
    if (hi > 1000) grid.sync();
#define IN(k) (PH_ON(k) && lo <= (k) && (k) < hi)
#define SEAM(k) do { if (lo <= (k) && (k) + 1 < hi) xcd_barrier(xbar); } while (0)
    if (IN(0)) { phase_prep(p, lds); }
    SEAM(0);
    if (IN(1)) {
        pg8::Gemm g{(const bf16_t*)(ws + WS_XB), (const bf16_t*)(ws + WS_WINT), DM, DM, DM};
        pg8::StaticOrder S; S.init(NTOK, NPROJ, G, bid);
        EpiInProj E{(const float*)(ws + WS_RS), (const float*)(ws + WS_COS), (const float*)(ws + WS_SIN),
                    (bf16_t*)(ws + WS_Q), (bf16_t*)(ws + WS_K), (bf16_t*)(ws + WS_VT), (bf16_t*)(ws + WS_SZA), (bf16_t*)(ws + WS_SZS), (bf16_t*)(ws + WS_XU), (float*)(ws + WS_KSUM)};
        pg8::gemm_phase(lds, g, S, E);
    }
    SEAM(1);
    if (IN(2)) {
        unsigned* cnt = (unsigned*)(ws + WS_BAR) + XCD_BAR_WORDS;
        if (bid < 128) {
            const int L = bid;
            {
                pg8::Gemm g{(const bf16_t*)(ws + WS_XU) + 128, (const bf16_t*)(ws + WS_WST), 384, 256, 256};
                pg8::OneUnit S{L, L >> 2};
                EpiS E{(float*)(ws + WS_SST)};
                pg8::gemm_phase<false, true, false>(lds, g, S, E);
            }
            asm volatile("s_waitcnt vmcnt(0)" ::: "memory");
            __syncthreads();
            scan_unit(p, lds, L);
            asm volatile("s_waitcnt vmcnt(0)" ::: "memory");
            __syncthreads();
            {
                pg8::Gemm g{(const bf16_t*)(ws + WS_XU), (const bf16_t*)(ws + WS_WCAT), 384, 384, 384};
                pg8::OneUnit S{L, L >> 2};
                EpiY E{(bf16_t*)(ws + WS_YG)};
                pg8::gemm_phase<false, true, false>(lds, g, S, E);
            }
            asm volatile("s_waitcnt vmcnt(0)" ::: "memory");
            __syncthreads();
            if (threadIdx.x == 0) {
                __builtin_amdgcn_fence(__ATOMIC_RELEASE, "agent");
                asm volatile("s_waitcnt vmcnt(0)" ::: "memory");
                __hip_atomic_fetch_add(cnt + 64 * (L & 3), 1u, __ATOMIC_RELAXED, __HIP_MEMORY_SCOPE_AGENT);
            }
        }
        if (bid < 128) {
            const int U = bid;
            const int pm = U >> 1, pn = U & 1;
            if (threadIdx.x == 0) {
                unsigned sp = 0;
                while (__hip_atomic_load(cnt + 64 * (pm >> 4), __ATOMIC_RELAXED, __HIP_MEMORY_SCOPE_AGENT) < 32u) { __builtin_amdgcn_s_sleep(2); if (++sp > (1u << 22)) break; }
                __builtin_amdgcn_fence(__ATOMIC_ACQUIRE, "agent");
                asm volatile("s_waitcnt vmcnt(0)" ::: "memory");
            }
            __syncthreads();
            pg8::Gemm g{(const bf16_t*)(ws + WS_YG), (const bf16_t*)(ws + WS_WGLUT), 512, 512, 512};
            pg8::OneUnit S{pm, pn};
            EpiGlu E{(const bf16_t*)(ws + WS_YG), (const bf16_t*)(ws + WS_SZS), p.b_glu, (bf16_t*)(ws + WS_XB)};
            pg8::gemm_phase<false, true, false>(lds, g, S, E);
        }
        phase_attn(p, lds, cnt + 256);
    }
    SEAM(2);
    if (G == 256) {
        if (IN(6)) {
            pg8::Gemm g{(const bf16_t*)(ws + WS_XB), (const bf16_t*)(ws + WS_WOUTT), DM, DM, DM};
            pg8::StaticOrder S; S.init(NTOK, DM, G, bid);
            EpiOutFused E{p.x, p.out, (float*)(ws + WS_SSQ), p.final_gain, xbar};
            pg8::gemm_phase<true, false, true>(lds, g, S, E);
        }
    } else {
        if (IN(6)) {
            pg8::Gemm g{(const bf16_t*)(ws + WS_XB), (const bf16_t*)(ws + WS_WOUTT), DM, DM, DM};
            pg8::StaticOrder S; S.init(NTOK, DM, G, bid);
            EpiOut E{p.x, p.out, (float*)(ws + WS_SSQ)};
            pg8::gemm_phase(lds, g, S, E);
        }
        SEAM(6);
        if (IN(7)) { phase_norm(p); }
    }
#undef IN
#undef SEAM
}

extern "C" void kernel_launch(void* const* d_in, const int* in_sizes, int n_in, void* d_out, int out_size, void* d_ws, size_t ws_size, hipStream_t stream) {
    static int grid = 0;
    if (grid == 0) {
        if (n_in != 15 || in_sizes[0] != NTOK * DM || out_size != NTOK * DM || ws_size < WS_END) { fprintf(stderr, "kernel_launch: unexpected shapes (n_in %d, in0 %d, out %d, ws %zu)\n", n_in, n_in > 0 ? in_sizes[0] : -1, out_size, ws_size); grid = -1; return; }
        int dev = 0, cus = 0, per_cu = 0;
        (void)hipGetDevice(&dev); (void)hipDeviceGetAttribute(&cus, hipDeviceAttributeMultiprocessorCount, dev);
        if (hipFuncSetAttribute((const void*)hymba_fwd, hipFuncAttributeMaxDynamicSharedMemorySize, LDS_BYTES) != hipSuccess) { fprintf(stderr, "kernel_launch: hipFuncSetAttribute failed\n"); grid = -1; return; }
        if (hipOccupancyMaxActiveBlocksPerMultiprocessor(&per_cu, (const void*)hymba_fwd, 512, LDS_BYTES) != hipSuccess || per_cu < 1) { fprintf(stderr, "kernel_launch: occupancy query says %d\n", per_cu); per_cu = 1; }
        (void)hipGetLastError();
        if (cus != 256) { fprintf(stderr, "kernel_launch: built for a 256-CU device (one workgroup per CU), found %d CUs; nothing launched\n", cus); grid = -1; return; }
        grid = 256;
    }
    if (grid < 0) return;
    if (hipMemsetAsync((char*)d_ws + WS_BAR, 0, (XCD_BAR_WORDS + 512) * 4, stream) != hipSuccess) { fprintf(stderr, "kernel_launch: memset of barrier words failed\n"); return; }
    Params p{};
    p.x = (const float*)d_in[0]; p.norm_gain = (const float*)d_in[1]; p.w_in = (const float*)d_in[2]; p.w_out = (const float*)d_in[3];
    p.lam_re = (const float*)d_in[4]; p.lam_im = (const float*)d_in[5]; p.b_re = (const float*)d_in[6]; p.b_im = (const float*)d_in[7];
    p.c_re = (const float*)d_in[8]; p.c_im = (const float*)d_in[9]; p.d_skip = (const float*)d_in[10]; p.log_dt = (const float*)d_in[11];
    p.w_glu = (const float*)d_in[12]; p.b_glu = (const float*)d_in[13]; p.final_gain = (const float*)d_in[14];
    p.out = (float*)d_out; p.ws = (unsigned char*)d_ws;
#if N_LAUNCH == 1
    p.ph_lo = 0; p.ph_hi = NPH;
    void* args[] = {&p};
    hipError_t e = hipLaunchCooperativeKernel((const void*)hymba_fwd, dim3(grid), dim3(512), args, LDS_BYTES, stream);
    if (e != hipSuccess) fprintf(stderr, "cooperative launch failed: %s (grid %d)\n", hipGetErrorString(e), grid);
#else
    for (int ph = 0; ph < NPH; ++ph) {
        p.ph_lo = ph; p.ph_hi = ph + 1;
        hipLaunchKernelGGL(hymba_fwd, dim3(grid), dim3(512), LDS_BYTES, stream, p);
    }
#endif
}
```

```cpp
#include <hip/hip_runtime.h>
#include <hip/hip_cooperative_groups.h>
#include <cstdio>
#include <cstdint>
namespace cg = cooperative_groups;

#ifndef ONLY_PH
#define ONLY_PH -1
#endif
#define PH_ON(x) (ONLY_PH < 0 || ONLY_PH == (x))
#ifndef N_LAUNCH
#define N_LAUNCH 1
#endif

#define LAS __attribute__((address_space(3)))
typedef unsigned short bf16_t;
typedef short bf16x8 __attribute__((ext_vector_type(8)));
typedef float f32x4 __attribute__((ext_vector_type(4)));
typedef float f32x16 __attribute__((ext_vector_type(16)));
typedef unsigned u32x2 __attribute__((ext_vector_type(2)));
typedef unsigned u32x4 __attribute__((ext_vector_type(4)));

constexpr int NTOK = 16384, DM = 1024, SEQ = 2048, NPROJ = 3072;
constexpr int NPH = 8;
constexpr size_t MBy = 1u << 20;
constexpr size_t WS_XB = 0;
constexpr size_t WS_WINT = 32 * MBy;
constexpr size_t WS_WOUTT = 38 * MBy;
constexpr size_t WS_WGLUT = 40 * MBy;
constexpr size_t WS_WST = 41 * MBy;
constexpr size_t WS_WCAT = 45 * MBy;
constexpr size_t WS_LAM16 = 51 * MBy;
constexpr size_t WS_RS = WS_LAM16 + 64 * 1024;
constexpr size_t WS_COS = WS_RS + 64 * 1024;
constexpr size_t WS_SIN = WS_COS + 256 * 1024;
constexpr size_t WS_KSUM = WS_SIN + 256 * 1024;
constexpr size_t WS_Q = 52 * MBy;
constexpr size_t WS_K = 68 * MBy;
constexpr size_t WS_VT = 84 * MBy;
constexpr size_t WS_SZA = 100 * MBy;
constexpr size_t WS_SZS = 116 * MBy;
constexpr size_t WS_XU = 132 * MBy;
constexpr size_t WS_SST = 156 * MBy;
constexpr size_t WS_YG = 172 * MBy;
constexpr size_t WS_SSQ = 188 * MBy;
constexpr size_t WS_BAR = 189 * MBy;
constexpr size_t WS_END = 190 * MBy;
constexpr int LDS_BYTES = 131072 + 16;

struct Params {
    const float *x, *norm_gain, *w_in, *w_out, *lam_re, *lam_im, *b_re, *b_im, *c_re, *c_im, *d_skip, *log_dt, *w_glu, *b_glu, *final_gain;
    float* out; unsigned char* ws;
    int ph_lo, ph_hi;
};

__device__ __forceinline__ unsigned pk2(float lo, float hi) { unsigned r; asm("v_cvt_pk_bf16_f32 %0, %1, %2" : "=v"(r) : "v"(lo), "v"(hi)); return r; }
__device__ __forceinline__ float bf2f(unsigned short b) { return __uint_as_float(((unsigned)b) << 16); }
__device__ __forceinline__ float bflo(unsigned w) { return __uint_as_float(w << 16); }
__device__ __forceinline__ float bfhi(unsigned w) { return __uint_as_float(w & 0xffff0000u); }
__device__ __forceinline__ float wave_sum(float v) {
#pragma unroll
    for (int o = 1; o < 64; o <<= 1) v += __shfl_xor(v, o);
    return v;
}
__device__ __forceinline__ float sigmoidf_(float v) { return __builtin_amdgcn_rcpf(1.f + __expf(-v)); }
__device__ __forceinline__ float siluf_(float v) { return v * sigmoidf_(v); }
__device__ __forceinline__ float gelu_tanh(float y) { const float t = 1.5957691216f * (y + 0.044715f * y * y * y); return y * sigmoidf_(t); }


#define XB_TMO      128
#define XB_XCNT(j)  (256  + 64 * (j))
#define XB_XSUB(j)  (1280 + 64 * (j))
#define XB_XGEN(j)  (2304 + 64 * (j))
#define XB_TOP      3328
#define XB_TOPGEN   3392
#define XCD_BAR_WORDS 3456
#define XB_SPIN_CAP (1u << 18)
__device__ __forceinline__ unsigned xb_ld(unsigned* p)              { return __hip_atomic_load(p, __ATOMIC_RELAXED, __HIP_MEMORY_SCOPE_AGENT); }
__device__ __forceinline__ unsigned xb_add(unsigned* p, unsigned v) { return __hip_atomic_fetch_add(p, v, __ATOMIC_RELAXED, __HIP_MEMORY_SCOPE_AGENT); }
__device__ __forceinline__ unsigned xb_xcc_id() { return (unsigned)__builtin_amdgcn_s_getreg((3 << 11) | 20) & 0xFu; }
#define XB_SPIN(cond, bar) do { unsigned _sp = 0; while (cond) { __builtin_amdgcn_s_sleep(1); \
    if ((++_sp & 255u) == 0u) { if (xb_ld(&(bar)[XB_TMO])) break; if (_sp > XB_SPIN_CAP) { atomicAdd(&(bar)[XB_TMO], 1u); break; } } } } while (0)
struct XcdBarrier { unsigned* bar; unsigned x; volatile LAS unsigned* st; };
__device__ __forceinline__ XcdBarrier xcd_barrier_post(unsigned* bar, volatile LAS unsigned* st) {
    XcdBarrier b; b.bar = bar; b.x = xb_xcc_id(); b.st = st;
    if (threadIdx.x == 0) (void)xb_add(&bar[XB_XCNT(b.x)], 1u);
    return b;
}
__device__ __forceinline__ void xcd_barrier_complete(unsigned* bar, unsigned x, unsigned& nloc, unsigned& nx) {
    const unsigned G = 256u;
    unsigned sum, cnt, mine, sp = 0u;
    for (;;) {
        sum = 0u; cnt = 0u; mine = 0u;
#pragma unroll
        for (unsigned j = 0; j < 16; ++j) { const unsigned c = xb_ld(&bar[XB_XCNT(j)]); sum += c; cnt += (c > 0u) ? 1u : 0u; mine = (j == x) ? c : mine; }
        if (sum == G) break;
        __builtin_amdgcn_s_sleep(1);
        if ((++sp & 255u) == 0u) { if (xb_ld(&bar[XB_TMO])) break; if (sp > XB_SPIN_CAP) { atomicAdd(&bar[XB_TMO], 1u); break; } }
    }
    nloc = mine > 0u ? mine : 1u; nx = cnt > 0u ? cnt : 1u;
}
__device__ __forceinline__ void xcd_barrier(const XcdBarrier& b) {
    asm volatile("s_waitcnt vmcnt(0)" ::: "memory");
    __syncthreads();
    if (threadIdx.x == 0) {
        unsigned* bar = b.bar;
        __builtin_amdgcn_s_waitcnt(0);
        unsigned nloc = b.st[0], nx = b.st[1];
        if (nloc == 0u) { xcd_barrier_complete(bar, b.x, nloc, nx); b.st[0] = nloc; b.st[1] = nx; }
        const unsigned old = xb_add(&bar[XB_XSUB(b.x)], 1u);
        const unsigned gen = old / nloc;
        if (old + 1u == (gen + 1u) * nloc) {
            __builtin_amdgcn_fence(__ATOMIC_RELEASE, "agent");
            asm volatile("s_waitcnt vmcnt(0)" ::: "memory");
            const unsigned og = xb_add(&bar[XB_TOP], 1u);
            const unsigned tg = og / nx;
            if (og + 1u == (tg + 1u) * nx) xb_add(&bar[XB_TOPGEN], 1u);
            else XB_SPIN(xb_ld(&bar[XB_TOPGEN]) == tg, bar);
            __builtin_amdgcn_fence(__ATOMIC_ACQUIRE, "agent");
            xb_add(&bar[XB_XGEN(b.x)], 1u);
            asm volatile("s_waitcnt vmcnt(0)" ::: "memory");
        } else {
            XB_SPIN(xb_ld(&bar[XB_XGEN(b.x)]) == gen, bar);
            __builtin_amdgcn_fence(__ATOMIC_ACQUIRE, "agent");
            asm volatile("s_waitcnt vmcnt(0)" ::: "memory");
        }
    }
    __syncthreads();
}

namespace pg8 {
constexpr int BM = 256, BK = 64, HALF = 128, HTB = HALF * BK * 2, STAGE_BYTES = 8 * HTB, NXCD = 8, WGM = 8;
__device__ __forceinline__ int lds_byte(int r, int c) { const int st = (r >> 4) * 2 + (c >> 5), rr = r & 15, cc = c & 31, ob = rr * 64 + cc * 2; return st * 1024 + (ob ^ (((ob >> 9) & 1) << 5)); }
__device__ __forceinline__ void stage_rc(int b, int& R, int& C) { const int st = b / 1024, sb = b % 1024, swz = sb ^ (((sb >> 9) & 1) << 5); R = (st >> 1) * 16 + swz / 64; C = (st & 1) * 32 + (swz % 64) / 2; }
struct Unit { int pm, pn; };
struct Gemm { const bf16_t* A; const bf16_t* Bt; int lda, ldb, K; };

struct StaticOrder {
    int nM, nN, nwg, G, c;
    __device__ void init(int M, int N, int G_, int c_) { nM = M / BM; nN = N / BM; nwg = nM * nN; G = G_; c = c_; }
    __device__ bool next(int i, Unit& u) const {
        const long L = (long)i * G + c; if (L >= nwg) return false;
        int wgid = (int)L; { const int q = nwg / NXCD, r = nwg % NXCD, xcd = wgid % NXCD, off = wgid / NXCD; wgid = (xcd < r ? xcd * (q + 1) : r * (q + 1) + (xcd - r) * q) + off; }
        const int nig = WGM * nN, gid = wgid / nig, fm = gid * WGM, gsz = (nM - fm) < WGM ? (nM - fm) : WGM;
        u.pm = fm + ((wgid % nig) % gsz); u.pn = (wgid % nig) / gsz; return true;
    }
};
struct GroupOrder {
    int G, c;
    __device__ bool next(int i, Unit& u) const { const int L = i * G + c; if (L >= 128) return false; u.pm = L; u.pn = L >> 2; return true; }
};

struct OneUnit {
    int pm, pn;
    __device__ bool next(int i, Unit& u) const { if (i) return false; u.pm = pm; u.pn = pn; return true; }
};

template <bool AFTER = false, bool ALIGN_EPI = true, bool SP2 = true, class Epi, class Sched>
__device__ __forceinline__ void gemm_phase(LAS unsigned char* lds, const Gemm g, const Sched& S, const Epi& E) {
    const int tid = threadIdx.x, wid = __builtin_amdgcn_readfirstlane(tid >> 6), lane = tid & 63, wr = wid >> 2, wc = wid & 3, fr = lane & 15, fq = lane >> 4;
    const int K = g.K, nt = K / BK;
    unsigned voffA[2], voffB[2];
#pragma unroll
    for (int i = 0; i < 2; ++i) { int R, C; stage_rc(tid * 16 + i * 8192, R, C); voffA[i] = (unsigned)(R * g.lda + C) * 2u; voffB[i] = (unsigned)(R * g.ldb + C) * 2u; }
    const size_t kstep = (size_t)(BK * 2);
    const size_t hstepA = (size_t)HALF * g.lda * 2, hstepB = (size_t)HALF * g.ldb * 2;
    const size_t tstepA = 2 * hstepA, tstepB = 2 * hstepB;
    const unsigned ldsw = (unsigned)wid * 1024u;
    const int aoff = lds_byte(wr * 64 + fr, fq * 8), boff = lds_byte(wc * 32 + fr, fq * 8);
#define PG8_SA(b, h) (((b) * 2 + (h)) * HTB)
#define PG8_SB(b, h) ((4 + (b) * 2 + (h)) * HTB)
#define PG8_STAGE(bufoff, gbase, voff) do { _Pragma("unroll") for (int _i = 0; _i < 2; ++_i) \
        __builtin_amdgcn_global_load_lds((const unsigned*)((const char*)(gbase) + (voff)[_i]), (LAS unsigned*)(lds + (bufoff) + ldsw + _i * 8192), 16, 0, 0); } while (0)
#define PG8_LDA(dst, b, h) do { _Pragma("unroll") for (int m = 0; m < 4; ++m) _Pragma("unroll") for (int k = 0; k < 2; ++k) dst[m][k] = *(const LAS bf16x8*)(lds + PG8_SA(b, h) + aoff + m * 2048 + k * 1024); } while (0)
#define PG8_LDB(dst, b, h) do { _Pragma("unroll") for (int n = 0; n < 2; ++n) _Pragma("unroll") for (int k = 0; k < 2; ++k) dst[n][k] = *(const LAS bf16x8*)(lds + PG8_SB(b, h) + boff + n * 2048 + k * 1024); } while (0)
#define PG8_MMA(ai, bj, At, Bt) do { __builtin_amdgcn_s_setprio(1); _Pragma("unroll") for (int m = 0; m < 4; ++m) _Pragma("unroll") for (int n = 0; n < 2; ++n) _Pragma("unroll") for (int k = 0; k < 2; ++k) \
        acc[ai][bj][m][n] = __builtin_amdgcn_mfma_f32_16x16x32_bf16(Bt[n][k], At[m][k], acc[ai][bj][m][n], 0, 0, 0); __builtin_amdgcn_s_setprio(0); } while (0)
#define PG8_WAIT_V(n) asm volatile("s_waitcnt vmcnt(" #n ")" ::: "memory")
#define PG8_WAIT_L(n) asm volatile("s_waitcnt lgkmcnt(" #n ")" ::: "memory")
#define PG8_BAR __builtin_amdgcn_s_barrier()
#define PG8_SCHED __builtin_amdgcn_sched_barrier(0)
    Unit cur, nxt; int ui = 0;
    if (!S.next(0, cur)) return;
    f32x4 acc[2][2][4][2];
#pragma unroll
    for (int a = 0; a < 2; ++a)
#pragma unroll
        for (int b = 0; b < 2; ++b)
#pragma unroll
            for (int m = 0; m < 4; ++m)
#pragma unroll
                for (int n = 0; n < 2; ++n) acc[a][b][m][n] = (f32x4){0.f, 0.f, 0.f, 0.f};
    bf16x8 At[4][2], B0[2][2], B1[2][2];
    const char* cA = (const char*)g.A + (size_t)cur.pm * tstepA; const char* cB = (const char*)g.Bt + (size_t)cur.pn * tstepB;
    if constexpr (SP2) {
        PG8_STAGE(PG8_SB(0, 0), cB, voffB); PG8_STAGE(PG8_SB(0, 1), cB + hstepB, voffB); PG8_STAGE(PG8_SA(0, 0), cA, voffA); PG8_STAGE(PG8_SA(0, 1), cA + hstepA, voffA);
        if (wr == 1) PG8_BAR;
        PG8_WAIT_V(2); PG8_BAR;
        PG8_STAGE(PG8_SB(1, 0), cB + kstep, voffB); PG8_STAGE(PG8_SA(1, 0), cA + kstep, voffA); PG8_STAGE(PG8_SB(1, 1), cB + hstepB + kstep, voffB);
        PG8_WAIT_V(6); PG8_BAR;
    } else {
        PG8_STAGE(PG8_SB(0, 0), cB, voffB); PG8_STAGE(PG8_SA(0, 0), cA, voffA); PG8_STAGE(PG8_SB(0, 1), cB + hstepB, voffB); PG8_STAGE(PG8_SA(0, 1), cA + hstepA, voffA);
        if (wr == 1) PG8_BAR;
        PG8_WAIT_V(4); PG8_BAR;
        PG8_STAGE(PG8_SB(1, 0), cB + kstep, voffB); PG8_STAGE(PG8_SA(1, 0), cA + kstep, voffA); PG8_STAGE(PG8_SB(1, 1), cB + hstepB + kstep, voffB);
        PG8_WAIT_V(6); PG8_BAR;
    }
    for (;;) {
        const bool has_next = S.next(ui + 1, nxt);
        const char* nA = has_next ? (const char*)g.A + (size_t)nxt.pm * tstepA : cA; const char* nB = has_next ? (const char*)g.Bt + (size_t)nxt.pn * tstepB : cB;
        for (int t = 0; t < nt; t += 2) {
            const bool last = (t == nt - 2);
            const char* a1 = cA + (size_t)(t + 1) * kstep;
            const char* a2 = last ? nA : cA + (size_t)(t + 2) * kstep; const char* b2 = last ? nB : cB + (size_t)(t + 2) * kstep;
            const char* a3 = a2 + kstep; const char* b3 = b2 + kstep;
            if constexpr (SP2) {
            PG8_LDB(B0, 0, 0); PG8_LDB(B1, 0, 1); PG8_SCHED; PG8_LDA(At, 0, 0); PG8_STAGE(PG8_SA(1, 1), a1 + hstepA, voffA);
            PG8_WAIT_V(8); PG8_WAIT_L(0); PG8_BAR; PG8_MMA(0, 0, At, B0); PG8_MMA(0, 1, At, B1); PG8_BAR; PG8_SCHED;
            PG8_LDA(At, 0, 1); PG8_STAGE(PG8_SB(0, 0), b2, voffB); PG8_STAGE(PG8_SB(0, 1), b2 + hstepB, voffB); PG8_STAGE(PG8_SA(0, 0), a2, voffA);
            PG8_WAIT_V(8); PG8_WAIT_L(0); PG8_BAR; PG8_MMA(1, 0, At, B0); PG8_MMA(1, 1, At, B1); PG8_BAR; PG8_SCHED;
            PG8_LDB(B0, 1, 0); PG8_LDB(B1, 1, 1); PG8_SCHED; PG8_LDA(At, 1, 0); PG8_STAGE(PG8_SA(0, 1), a2 + hstepA, voffA);
            PG8_WAIT_V(8); PG8_WAIT_L(0); PG8_BAR; PG8_MMA(0, 0, At, B0); PG8_MMA(0, 1, At, B1); PG8_BAR; PG8_SCHED;
            PG8_LDA(At, 1, 1); PG8_STAGE(PG8_SB(1, 0), b3, voffB); PG8_STAGE(PG8_SB(1, 1), b3 + hstepB, voffB); PG8_STAGE(PG8_SA(1, 0), a3, voffA);
            PG8_WAIT_V(8); PG8_WAIT_L(0); PG8_BAR; PG8_MMA(1, 0, At, B0); PG8_MMA(1, 1, At, B1); PG8_BAR; PG8_SCHED;
            } else {
            PG8_LDB(B0, 0, 0); PG8_SCHED; PG8_LDA(At, 0, 0); PG8_STAGE(PG8_SA(1, 1), a1 + hstepA, voffA);
            PG8_WAIT_L(8); PG8_BAR; PG8_WAIT_L(0); PG8_MMA(0, 0, At, B0); PG8_BAR; PG8_SCHED;
            PG8_LDB(B1, 0, 1); PG8_STAGE(PG8_SB(0, 0), b2, voffB);
            PG8_BAR; PG8_WAIT_L(0); PG8_MMA(0, 1, At, B1); PG8_BAR;
            PG8_LDA(At, 0, 1); PG8_STAGE(PG8_SA(0, 0), a2, voffA);
            PG8_BAR; PG8_WAIT_L(0); PG8_MMA(1, 0, At, B0); PG8_BAR; PG8_SCHED;
            PG8_STAGE(PG8_SB(0, 1), b2 + hstepB, voffB);
            PG8_WAIT_V(6); PG8_BAR; PG8_MMA(1, 1, At, B1); PG8_BAR;
            PG8_LDB(B0, 1, 0); PG8_SCHED; PG8_LDA(At, 1, 0); PG8_STAGE(PG8_SA(0, 1), a2 + hstepA, voffA);
            PG8_WAIT_L(8); PG8_BAR; PG8_WAIT_L(0); PG8_MMA(0, 0, At, B0); PG8_BAR; PG8_SCHED;
            PG8_LDB(B1, 1, 1); PG8_STAGE(PG8_SB(1, 0), b3, voffB);
            PG8_BAR; PG8_WAIT_L(0); PG8_MMA(0, 1, At, B1); PG8_BAR;
            PG8_LDA(At, 1, 1); PG8_STAGE(PG8_SA(1, 0), a3, voffA);
            PG8_BAR; PG8_WAIT_L(0); PG8_MMA(1, 0, At, B0); PG8_BAR; PG8_SCHED;
            PG8_STAGE(PG8_SB(1, 1), b3 + hstepB, voffB);
            PG8_WAIT_V(6); PG8_BAR; PG8_MMA(1, 1, At, B1); PG8_BAR;
                    }
        }
        if constexpr (ALIGN_EPI) { if (wr == 0) PG8_BAR; }
        E(acc, cur, wr, wc, fr, fq);
        if (!has_next) break;
#pragma unroll
        for (int a = 0; a < 2; ++a)
#pragma unroll
            for (int b = 0; b < 2; ++b)
#pragma unroll
                for (int m = 0; m < 4; ++m)
#pragma unroll
                    for (int n = 0; n < 2; ++n) acc[a][b][m][n] = (f32x4){0.f, 0.f, 0.f, 0.f};
        cur = nxt; cA = nA; cB = nB; ++ui;
        if constexpr (ALIGN_EPI) { if (wr == 1) PG8_BAR; }
    }
    PG8_WAIT_V(0);
    if constexpr (!ALIGN_EPI) { if (wr == 0) PG8_BAR; }
    PG8_BAR;
    if constexpr (AFTER) E.after(acc, cur, wr, wc, fr, fq);
#undef PG8_SA
#undef PG8_SB
#undef PG8_STAGE
#undef PG8_LDA
#undef PG8_LDB
#undef PG8_MMA
#undef PG8_WAIT_V
#undef PG8_WAIT_L
#undef PG8_BAR
#undef PG8_SCHED
}
}
using pg8::Unit;


__device__ __forceinline__ int inproj_row(int e) {
    const int pn = e >> 8, o = e & 255;
    const int wc = o >> 6, bj = (o >> 5) & 1, fq = (o >> 3) & 3, n = (o >> 2) & 1, i = o & 3;
    return 256 * pn + 128 * bj + 32 * wc + 16 * n + 4 * fq + i;
}

struct EpiInProj {
    const float *rs, *cosT, *sinT;
    bf16_t *Q, *Kk, *VT, *SZA, *SZS, *XU; float* KSUM;
    __device__ __forceinline__ void operator()(const f32x4 (&acc)[2][2][4][2], const Unit& u, int wr, int wc, int fr, int fq) const {
        const int seg = u.pn >> 1, half = u.pn & 1;
        const int b = u.pm >> 3, blk = u.pm & 7;
        const int lbase = blk * 256 + wr * 64 + fr;
        if (seg <= 1) {
            bf16_t* dst = seg == 0 ? Q : Kk; const float qs = seg == 0 ? 0.18033688011112042f : 1.0f;
            const int head = 4 * half + wc;
            f32x4 cl[2], ch[2];
#pragma unroll
            for (int n = 0; n < 2; ++n) { cl[n] = (f32x4){0.f, 0.f, 0.f, 0.f}; ch[n] = (f32x4){0.f, 0.f, 0.f, 0.f}; }
            bf16_t* obase = dst + ((size_t)((b * 8 + head) * 2048)) * 64 + 8 * fq;
#pragma unroll
            for (int ai = 0; ai < 2; ++ai)
#pragma unroll
                for (int m = 0; m < 4; ++m) {
                    const int l = lbase + 128 * ai + 16 * m; const float rsv = rs[b * 2048 + l] * qs;
                    unsigned wl[4], wh[4];
#pragma unroll
                    for (int n = 0; n < 2; ++n) {
                        const f32x4 c4 = *(const f32x4*)(cosT + l * 32 + 8 * fq + 4 * n), s4 = *(const f32x4*)(sinT + l * 32 + 8 * fq + 4 * n);
                        const f32x4 t1 = acc[ai][0][m][n] * rsv, t2 = acc[ai][1][m][n] * rsv;
                        const f32x4 lo = t1 * c4 - t2 * s4, hi = t2 * c4 + t1 * s4;
                        wl[2 * n] = pk2(lo[0], lo[1]); wl[2 * n + 1] = pk2(lo[2], lo[3]); wh[2 * n] = pk2(hi[0], hi[1]); wh[2 * n + 1] = pk2(hi[2], hi[3]);
                        cl[n] += lo; ch[n] += hi;
                    }
                    bf16_t* o = obase + (unsigned)l * 64u;
                    *(u32x4*)o = (u32x4){wl[0], wl[1], wl[2], wl[3]};
                    *(u32x4*)(o + 32) = (u32x4){wh[0], wh[1], wh[2], wh[3]};
                }
            if (seg == 1) {
#pragma unroll
                for (int n = 0; n < 2; ++n)
#pragma unroll
                    for (int i = 0; i < 4; ++i) {
                        float v = cl[n][i], v2 = ch[n][i];
                        v += __shfl_xor(v, 1); v += __shfl_xor(v, 2); v += __shfl_xor(v, 4); v += __shfl_xor(v, 8);
                        v2 += __shfl_xor(v2, 1); v2 += __shfl_xor(v2, 2); v2 += __shfl_xor(v2, 4); v2 += __shfl_xor(v2, 8);
                        if (fr == 0) { float* kp = KSUM + ((b * 8 + head) * 8 + blk) * 64 + 8 * fq + 4 * n + i; atomicAdd(kp, v); atomicAdd(kp + 32, v2); }
                    }
            }
        } else if (seg == 2) {
            const int head = 4 * half + wc;
#pragma unroll
            for (int ai = 0; ai < 2; ++ai)
#pragma unroll
                for (int m = 0; m < 4; ++m) {
                    const int l = lbase + 128 * ai + 16 * m; const float rsv = rs[b * 2048 + l];
#pragma unroll
                    for (int bj = 0; bj < 2; ++bj)
#pragma unroll
                        for (int n = 0; n < 2; ++n) {
                            const int d0 = 32 * bj + 8 * fq + 4 * n;
                            const f32x4 v = acc[ai][bj][m][n] * rsv;
                            bf16_t* o = VT + ((size_t)((b * 8 + head) * 64 + d0)) * 2048 + l;
                            const unsigned p0 = pk2(v[0], v[1]), p1 = pk2(v[2], v[3]);
                            o[0] = (bf16_t)(p0 & 0xffffu); o[2048] = (bf16_t)(p0 >> 16); o[4096] = (bf16_t)(p1 & 0xffffu); o[6144] = (bf16_t)(p1 >> 16);
                        }
                }
        } else if (seg == 4) {
#pragma unroll
            for (int ai = 0; ai < 2; ++ai)
#pragma unroll
                for (int m = 0; m < 4; ++m) {
                    const int l = lbase + 128 * ai + 16 * m; const float rsv = rs[b * 2048 + l];
                    const int c = l >> 4, t = l & 15;
#pragma unroll
                    for (int bj = 0; bj < 2; ++bj) {
                        const int g = 16 * half + 4 * wc + 2 * bj + (fq >> 1);
                        const f32x4 v0 = acc[ai][bj][m][0] * rsv, v1 = acc[ai][bj][m][1] * rsv;
                        bf16_t* o = XU + ((size_t)(1024 * g + b * 128 + c)) * 384 + 128 + t * 16 + 8 * (fq & 1);
                        *(u32x4*)o = (u32x4){pk2(v0[0], v0[1]), pk2(v0[2], v0[3]), pk2(v1[0], v1[1]), pk2(v1[2], v1[3])};
                    }
                }
        } else {
            bf16_t* dst = seg == 3 ? SZA : SZS;
#pragma unroll
            for (int ai = 0; ai < 2; ++ai)
#pragma unroll
                for (int m = 0; m < 4; ++m) {
                    const int l = lbase + 128 * ai + 16 * m; const int row = b * 2048 + l; const float rsv = rs[row];
#pragma unroll
                    for (int bj = 0; bj < 2; ++bj) {
                        const int col = 256 * half + 64 * wc + 32 * bj + 8 * fq;
                        const f32x4 v0 = acc[ai][bj][m][0] * rsv, v1 = acc[ai][bj][m][1] * rsv;
                        *(u32x4*)(dst + (size_t)row * 512 + col) = (u32x4){pk2(siluf_(v0[0]), siluf_(v0[1])), pk2(siluf_(v0[2]), siluf_(v0[3])), pk2(siluf_(v1[0]), siluf_(v1[1])), pk2(siluf_(v1[2]), siluf_(v1[3]))};
                    }
                }
        }
    }
};

struct EpiS {
    float* SST;
    __device__ __forceinline__ void operator()(const f32x4 (&acc)[2][2][4][2], const Unit& u, int wr, int wc, int fr, int fq) const {
#pragma unroll
        for (int ai = 0; ai < 2; ++ai)
#pragma unroll
            for (int m = 0; m < 4; ++m) {
                const int R = 256 * u.pm + 128 * ai + 64 * wr + 16 * m + fr;
#pragma unroll
                for (int n = 0; n < 2; ++n) *(f32x4*)(SST + (size_t)R * 128 + 32 * wc + 16 * n + 4 * fq) = acc[ai][0][m][n];
            }
    }
};

struct EpiY {
    bf16_t* YG;
    __device__ __forceinline__ void operator()(const f32x4 (&acc)[2][2][4][2], const Unit& u, int wr, int wc, int fr, int fq) const {
        const int g = u.pn, t = 4 * wc + fq;
#pragma unroll
        for (int ai = 0; ai < 2; ++ai)
#pragma unroll
            for (int m = 0; m < 4; ++m) {
                const int rr = 256 * (u.pm & 3) + 128 * ai + 64 * wr + 16 * m + fr;
                const int b = rr >> 7, c = rr & 127; const int token = b * 2048 + 16 * c + t;
                bf16_t* ob = YG + (size_t)token * 512 + 16 * g;
#pragma unroll
                for (int bj = 0; bj < 2; ++bj) {
                    const f32x4 v0 = acc[ai][bj][m][0], v1 = acc[ai][bj][m][1];
                    *(u32x4*)(ob + 8 * bj) = (u32x4){pk2(gelu_tanh(v0[0]), gelu_tanh(v0[1])), pk2(gelu_tanh(v0[2]), gelu_tanh(v0[3])), pk2(gelu_tanh(v1[0]), gelu_tanh(v1[1])), pk2(gelu_tanh(v1[2]), gelu_tanh(v1[3]))};
                }
            }
    }
};

struct EpiGlu {
    const bf16_t *YG, *SZS; const float* bglu; bf16_t* MIXED;
    __device__ __forceinline__ void operator()(const f32x4 (&acc)[2][2][4][2], const Unit& u, int wr, int wc, int fr, int fq) const {
        f32x4 bias[2][2];
#pragma unroll
        for (int bj = 0; bj < 2; ++bj)
#pragma unroll
            for (int n = 0; n < 2; ++n) bias[bj][n] = *(const f32x4*)(bglu + 256 * u.pn + 64 * wc + 32 * bj + 8 * fq + 4 * n);
#pragma unroll
        for (int ai = 0; ai < 2; ++ai) {
            u32x4 y4[4][2], z4[4][2];
#pragma unroll
            for (int m = 0; m < 4; ++m) {
                const int row = 256 * u.pm + 128 * ai + 64 * wr + 16 * m + fr;
#pragma unroll
                for (int bj = 0; bj < 2; ++bj) {
                    const unsigned off = (unsigned)row * 512u + (unsigned)(256 * u.pn + 64 * wc + 32 * bj + 8 * fq);
                    y4[m][bj] = *(const u32x4*)(YG + off); z4[m][bj] = *(const u32x4*)(SZS + off);
                }
            }
#pragma unroll
            for (int m = 0; m < 4; ++m) {
                const int row = 256 * u.pm + 128 * ai + 64 * wr + 16 * m + fr;
#pragma unroll
                for (int bj = 0; bj < 2; ++bj) {
                    const int col = 256 * u.pn + 64 * wc + 32 * bj + 8 * fq;
                    unsigned w[4];
#pragma unroll
                    for (int n = 0; n < 2; ++n) {
                        const f32x4 a = acc[ai][bj][m][n] + bias[bj][n];
                        const unsigned ya = y4[m][bj][2 * n], yb = y4[m][bj][2 * n + 1], za = z4[m][bj][2 * n], zb = z4[m][bj][2 * n + 1];
                        const float o0 = bflo(ya) * sigmoidf_(a[0]) * bflo(za), o1 = bfhi(ya) * sigmoidf_(a[1]) * bfhi(za);
                        const float o2 = bflo(yb) * sigmoidf_(a[2]) * bflo(zb), o3 = bfhi(yb) * sigmoidf_(a[3]) * bfhi(zb);
                        w[2 * n] = pk2(o0, o1); w[2 * n + 1] = pk2(o2, o3);
                    }
                    *(u32x4*)(MIXED + (size_t)row * 1024 + 512 + col) = (u32x4){w[0], w[1], w[2], w[3]};
                }
            }
        }
    }
};

struct EpiOut {
    const float* x; float* out; float* SSQ;
    __device__ __forceinline__ void operator()(const f32x4 (&acc)[2][2][4][2], const Unit& u, int wr, int wc, int fr, int fq) const {
#pragma unroll
        for (int ai = 0; ai < 2; ++ai) {
            f32x4 xv[4][2][2];
#pragma unroll
            for (int m = 0; m < 4; ++m) {
                const int row = 256 * u.pm + 128 * ai + 64 * wr + 16 * m + fr;
#pragma unroll
                for (int bj = 0; bj < 2; ++bj)
#pragma unroll
                    for (int n = 0; n < 2; ++n) xv[m][bj][n] = *(const f32x4*)(x + (size_t)row * 1024 + 256 * u.pn + 64 * wc + 32 * bj + 8 * fq + 4 * n);
            }
#pragma unroll
            for (int m = 0; m < 4; ++m) {
                const int row = 256 * u.pm + 128 * ai + 64 * wr + 16 * m + fr;
                float ss = 0.f;
#pragma unroll
                for (int bj = 0; bj < 2; ++bj)
#pragma unroll
                    for (int n = 0; n < 2; ++n) {
                        const int col = 256 * u.pn + 64 * wc + 32 * bj + 8 * fq + 4 * n;
                        const f32x4 v = acc[ai][bj][m][n] + xv[m][bj][n];
                        *(f32x4*)(out + (size_t)row * 1024 + col) = v;
                        ss += (v[0] * v[0] + v[1] * v[1]) + (v[2] * v[2] + v[3] * v[3]);
                    }
                ss += __shfl_xor(ss, 16); ss += __shfl_xor(ss, 32);
                if (fq == 0) SSQ[row * 16 + 4 * u.pn + wc] = ss;
            }
        }
    }
};

struct EpiOutFused {
    const float* x; float* out; float* SSQ; const float* gain; XcdBarrier xbar;
    __device__ __forceinline__ void operator()(f32x4 (&acc)[2][2][4][2], const Unit& u, int wr, int wc, int fr, int fq) const {
#pragma unroll
        for (int ai = 0; ai < 2; ++ai) {
            f32x4 xv[4][2][2];
#pragma unroll
            for (int m = 0; m < 4; ++m) {
                const int row = 256 * u.pm + 128 * ai + 64 * wr + 16 * m + fr;
#pragma unroll
                for (int bj = 0; bj < 2; ++bj)
#pragma unroll
                    for (int n = 0; n < 2; ++n) xv[m][bj][n] = *(const f32x4*)(x + (size_t)row * 1024 + 256 * u.pn + 64 * wc + 32 * bj + 8 * fq + 4 * n);
            }
#pragma unroll
            for (int m = 0; m < 4; ++m) {
                const int row = 256 * u.pm + 128 * ai + 64 * wr + 16 * m + fr;
                float ss = 0.f;
#pragma unroll
                for (int bj = 0; bj < 2; ++bj)
#pragma unroll
                    for (int n = 0; n < 2; ++n) {
                        const f32x4 v = acc[ai][bj][m][n] + xv[m][bj][n];
                        acc[ai][bj][m][n] = v;
                        ss += (v[0] * v[0] + v[1] * v[1]) + (v[2] * v[2] + v[3] * v[3]);
                    }
                ss += __shfl_xor(ss, 16); ss += __shfl_xor(ss, 32);
                if (fq == 0) SSQ[row * 16 + 4 * u.pn + wc] = ss;
            }
        }
    }
    __device__ __forceinline__ void after(f32x4 (&acc)[2][2][4][2], const Unit& u, int wr, int wc, int fr, int fq) const {
        xcd_barrier(xbar);
        f32x4 gn[2][2];
#pragma unroll
        for (int bj = 0; bj < 2; ++bj)
#pragma unroll
            for (int n = 0; n < 2; ++n) gn[bj][n] = *(const f32x4*)(gain + 256 * u.pn + 64 * wc + 32 * bj + 8 * fq + 4 * n);
#pragma unroll
        for (int ai = 0; ai < 2; ++ai)
#pragma unroll
            for (int m = 0; m < 4; ++m) {
                const int row = 256 * u.pm + 128 * ai + 64 * wr + 16 * m + fr;
                const f32x4* sp = (const f32x4*)(SSQ + row * 16);
                const f32x4 s0 = sp[0], s1 = sp[1], s2 = sp[2], s3 = sp[3];
                const float tot = ((s0[0] + s0[1]) + (s0[2] + s0[3])) + ((s1[0] + s1[1]) + (s1[2] + s1[3])) + ((s2[0] + s2[1]) + (s2[2] + s2[3])) + ((s3[0] + s3[1]) + (s3[2] + s3[3]));
                const float rinv = 1.0f / sqrtf(tot * (1.f / DM) + 1e-6f);
#pragma unroll
                for (int bj = 0; bj < 2; ++bj)
#pragma unroll
                    for (int n = 0; n < 2; ++n) {
                        const int col = 256 * u.pn + 64 * wc + 32 * bj + 8 * fq + 4 * n;
                        *(f32x4*)(out + (size_t)row * 1024 + col) = acc[ai][bj][m][n] * rinv * gn[bj][n];
                    }
            }
    }
};

template <int MODE>
__device__ __forceinline__ void transpose_item(const float* W, int K, int N, bf16_t* WT, const float* gain, LAS float* scr, int item, int lane) {
    const int nblk = N / 32, kb = item / nblk, nb = item % nblk, k0 = 64 * kb, n0 = 32 * nb;
#pragma unroll 8
    for (int i = 0; i < 32; ++i) { const int kk = 2 * i + (lane >> 5); float w = W[(size_t)(k0 + kk) * N + n0 + (lane & 31)]; if (MODE == 0) w *= gain[k0 + kk]; scr[kk * 33 + (lane & 31)] = w; }
    const int c = lane & 7;
#pragma unroll
    for (int j = 0; j < 4; ++j) { const int n = (lane >> 3) + 8 * j; const LAS float* s = scr + (8 * c) * 33 + n;
        u32x4 o; o.x = pk2(s[0 * 33], s[1 * 33]); o.y = pk2(s[2 * 33], s[3 * 33]); o.z = pk2(s[4 * 33], s[5 * 33]); o.w = pk2(s[6 * 33], s[7 * 33]);
        const int drow = inproj_row(n0 + n);
        *(u32x4*)(WT + (size_t)drow * K + k0 + 8 * c) = o; }
}

__device__ __forceinline__ void ssm_group_prep(const Params& p, int item, LAS float* L) {
    LAS float* lkr = L; LAS float* lki = L + 1088; LAS float* bbr = L + 2176; LAS float* bbi = L + 3200; LAS float* cr = L + 4224; LAS float* ci = L + 5248; LAS float* Kt = L + 6272;
    const int tid = threadIdx.x, g = item >> 3, sub = item & 7;
    const float dt = expf(p.log_dt[g]);
    for (int t = tid; t < 17 * 64; t += 512) {
        const int pp = t & 63, k = t >> 6;
        const float a = p.lam_re[g * 64 + pp] * dt, th = p.lam_im[g * 64 + pp] * dt;
        const float mag = expf((float)k * a); float sn, cs; sincosf((float)k * th, &sn, &cs);
        lkr[k * 64 + pp] = mag * cs; lki[k * 64 + pp] = mag * sn;
    }
    for (int t = tid; t < 1024; t += 512) {
        const int pp = t >> 4, h = t & 15;
        const float lr = p.lam_re[g * 64 + pp], li = p.lam_im[g * 64 + pp];
        const float a = lr * dt, th = li * dt;
        float sn, cs; sincosf(th, &sn, &cs); const float sh = sinf(0.5f * th);
        const float em1 = expm1f(a), ea = em1 + 1.f;
        const float xr = em1 * cs - 2.f * sh * sh, xi = ea * sn;
        const float den = 1.f / (lr * lr + li * li);
        const float cfr = (xr * lr + xi * li) * den, cfi = (xi * lr - xr * li) * den;
        const float br = p.b_re[(g * 64 + pp) * 16 + h], bi = p.b_im[(g * 64 + pp) * 16 + h];
        bbr[pp * 16 + h] = cfr * br - cfi * bi; bbi[pp * 16 + h] = cfr * bi + cfi * br;
        cr[h * 64 + pp] = p.c_re[(g * 16 + h) * 64 + pp]; ci[h * 64 + pp] = p.c_im[(g * 16 + h) * 64 + pp];
    }
    __syncthreads();
    {
        const int k = tid >> 5, hl = (tid >> 4) & 1, h2 = tid & 15, h = 2 * sub + hl;
        float sacc = 0.f;
        for (int pp = 0; pp < 64; ++pp) {
            const float c_r = cr[h * 64 + pp], c_i = ci[h * 64 + pp], l_r = lkr[k * 64 + pp], l_i = lki[k * 64 + pp];
            const float er = c_r * l_r - c_i * l_i, ei = c_r * l_i + c_i * l_r;
            sacc += er * bbr[pp * 16 + h2] - ei * bbi[pp * 16 + h2];
        }
        if (k == 0 && h == h2) sacc += p.d_skip[g * 16 + h];
        Kt[tid] = sacc;
    }
    __syncthreads();
    bf16_t* WCAT = (bf16_t*)(p.ws + WS_WCAT) + (size_t)g * 256 * 384;
    bf16_t* WST = (bf16_t*)(p.ws + WS_WST) + (size_t)g * 256 * 256;
    for (int e = tid; e < 32 * 192; e += 512) {
        const int rl = e / 192, kk = (e - rl * 192) * 2;
        const int t = rl >> 1, hl = rl & 1, h = 2 * sub + hl;
        const int row = 128 * (h >> 3) + 32 * (t >> 2) + 16 * ((h >> 2) & 1) + 4 * (t & 3) + (h & 3);
        float v[2];
#pragma unroll
        for (int q = 0; q < 2; ++q) {
            const int k2 = kk + q;
            if (k2 < 128) { const int pp = k2 & 63; const float c_r = cr[h * 64 + pp], c_i = ci[h * 64 + pp], l_r = lkr[(t + 1) * 64 + pp], l_i = lki[(t + 1) * 64 + pp];
                v[q] = k2 < 64 ? (c_r * l_r - c_i * l_i) : -(c_r * l_i + c_i * l_r); }
            else { const int s2 = (k2 - 128) >> 4, h2 = (k2 - 128) & 15; v[q] = s2 <= t ? Kt[((t - s2) * 2 + hl) * 16 + h2] : 0.f; }
        }
        *(unsigned*)(WCAT + (size_t)row * 384 + kk) = pk2(v[0], v[1]);
    }
    for (int e = tid; e < 32 * 128; e += 512) {
        const int rl = e >> 7, kk = (e & 127) * 2;
        const int row = rl < 16 ? 16 * sub + rl : 128 + 16 * sub + (rl - 16);
        float v[2] = {0.f, 0.f};
        if (row < 128) {
            const int pp = row & 63;
#pragma unroll
            for (int q = 0; q < 2; ++q) { const int s2 = (kk + q) >> 4, h = (kk + q) & 15; const float l_r = lkr[(15 - s2) * 64 + pp], l_i = lki[(15 - s2) * 64 + pp], b_r = bbr[pp * 16 + h], b_i = bbi[pp * 16 + h];
                v[q] = row < 64 ? (l_r * b_r - l_i * b_i) : (l_r * b_i + l_i * b_r); }
        }
        *(unsigned*)(WST + (size_t)row * 256 + kk) = pk2(v[0], v[1]);
    }
    if (sub == 0 && tid < 64) { float* L16 = (float*)(p.ws + WS_LAM16) + (g * 64 + tid) * 2; L16[0] = lkr[16 * 64 + tid]; L16[1] = lki[16 * 64 + tid]; }
    __syncthreads();
}

__device__ __forceinline__ void phase_prep(const Params& p, LAS unsigned char* lds) {
    const int tid = threadIdx.x, lane = tid & 63, wave = tid >> 6, G = 256, bid = blockIdx.x;
    for (int item = bid; item < 256; item += G) ssm_group_prep(p, item, (LAS float*)lds);
    const int gw = bid * 8 + wave, NGW = G * 8;
    {
        bf16_t* XB = (bf16_t*)(p.ws + WS_XB); float* RS = (float*)(p.ws + WS_RS);
        for (int row = gw; row < NTOK; row += NGW) {
            const f32x4* xr = (const f32x4*)(p.x + (size_t)row * DM) + lane;
            f32x4 v[4]; float s = 0.f;
#pragma unroll
            for (int j = 0; j < 4; ++j) { v[j] = xr[64 * j]; s += (v[j][0] * v[j][0] + v[j][1] * v[j][1]) + (v[j][2] * v[j][2] + v[j][3] * v[j][3]); }
            s = wave_sum(s);
            if (lane == 0) RS[row] = 1.0f / sqrtf(s * (1.f / DM) + 1e-6f);
            u32x2* o = (u32x2*)(XB + (size_t)row * DM) + lane;
#pragma unroll
            for (int j = 0; j < 4; ++j) o[64 * j] = (u32x2){pk2(v[j][0], v[j][1]), pk2(v[j][2], v[j][3])};
        }
    }
    {
        LAS float* scr = (LAS float*)(lds + 49152) + wave * (64 * 33);
        constexpr int I_IN = (DM / 64) * (NPROJ / 32), I_OUT = (DM / 64) * (DM / 32), I_GLU = (512 / 64) * (512 / 32);
        for (int it = gw; it < I_IN + I_OUT + I_GLU; it += NGW) {
            int r = it;
            if (r < I_IN) { transpose_item<0>(p.w_in, DM, NPROJ, (bf16_t*)(p.ws + WS_WINT), p.norm_gain, scr, r, lane); continue; } r -= I_IN;
            if (r < I_OUT) { transpose_item<1>(p.w_out, DM, DM, (bf16_t*)(p.ws + WS_WOUTT), nullptr, scr, r, lane); continue; } r -= I_OUT;
            transpose_item<1>(p.w_glu, 512, 512, (bf16_t*)(p.ws + WS_WGLUT), nullptr, scr, r, lane);
        }
    }
    {
        float* COS = (float*)(p.ws + WS_COS); float* SIN = (float*)(p.ws + WS_SIN); float* KSUM = (float*)(p.ws + WS_KSUM);
        for (int i = bid * 512 + tid; i < SEQ * 32; i += G * 512) {
            const int pos = i >> 5, f = i & 31;
            const float inv = 1.0f / powf(10000.0f, (float)f * (1.f / 32.f));
            const float ang = (float)pos * inv; float sn, cs; sincosf(ang, &sn, &cs);
            COS[i] = cs; SIN[i] = sn;
        }
        for (int i = bid * 512 + tid; i < 4096; i += G * 512) KSUM[i] = 0.f;
    }
}

__device__ __forceinline__ int swap23(int r) { return (r & ~12) | ((r & 4) << 1) | ((r & 8) >> 1); }

typedef float f32x2 __attribute__((ext_vector_type(2)));
__device__ __forceinline__ float max3f(float a, float b, float c) { float r; asm("v_max3_f32 %0, %1, %2, %3" : "=v"(r) : "v"(a), "v"(b), "v"(c)); return r; }
template <bool DIAG>
__device__ __forceinline__ void attn_tile(LAS unsigned char* B, unsigned kf_off, unsigned vf_off, const bf16x8 (&qf)[4], f32x16& O0, f32x16& O1, float& mrun, float& lrun,
                                          bool on, int kpos0, int qpos, int hh) {
    constexpr int ROWB = 144;
    f32x16 st0, st1;
#pragma unroll
    for (int i = 0; i < 16; ++i) { st0[i] = 0.f; st1[i] = 0.f; }
#pragma unroll
    for (int s = 0; s < 4; ++s) {
        const bf16x8 k0 = *(const LAS bf16x8*)(B + kf_off + s * 32), k1 = *(const LAS bf16x8*)(B + kf_off + 32 * ROWB + s * 32);
        st0 = __builtin_amdgcn_mfma_f32_32x32x16_bf16(k0, qf[s], st0, 0, 0, 0);
        st1 = __builtin_amdgcn_mfma_f32_32x32x16_bf16(k1, qf[s], st1, 0, 0, 0);
    }
    if (DIAG) {
#pragma unroll
        for (int i = 0; i < 16; ++i) {
            const int key = kpos0 + (i & 7) + 8 * hh + 16 * (i >> 3);
            if (key > qpos) st0[i] = -1e30f;
            if (key + 32 > qpos) st1[i] = -1e30f;
        }
    }
    float mx = max3f(st0[0], st0[1], st0[2]);
#pragma unroll
    for (int i = 3; i < 15; i += 2) mx = max3f(mx, st0[i], st0[i + 1]);
    mx = max3f(mx, st0[15], st1[0]);
#pragma unroll
    for (int i = 1; i < 15; i += 2) mx = max3f(mx, st1[i], st1[i + 1]);
    mx = fmaxf(mx, st1[15]);
    mx = fmaxf(mx, __shfl_xor(mx, 32));
    const bool grow = on && (mx > mrun + 8.f);
    if (__ballot(grow) != 0ull) {
        const float mnew = grow ? mx : mrun;
        const float alpha = __builtin_amdgcn_exp2f(mrun - mnew);
        lrun *= alpha; mrun = mnew;
#pragma unroll
        for (int i = 0; i < 16; ++i) { O0[i] *= alpha; O1[i] *= alpha; }
    }
    const float msub = on ? mrun : 1e30f;
    f32x2 rs2 = (f32x2){0.f, 0.f};
    const f32x2 ms2 = (f32x2){msub, msub};
#pragma unroll
    for (int i = 0; i < 16; i += 2) {
        f32x2 a = (f32x2){st0[i], st0[i + 1]} - ms2, c = (f32x2){st1[i], st1[i + 1]} - ms2;
        a[0] = __builtin_amdgcn_exp2f(a[0]); a[1] = __builtin_amdgcn_exp2f(a[1]); c[0] = __builtin_amdgcn_exp2f(c[0]); c[1] = __builtin_amdgcn_exp2f(c[1]);
        st0[i] = a[0]; st0[i + 1] = a[1]; st1[i] = c[0]; st1[i + 1] = c[1];
        rs2 += a + c;
    }
    float rsum = rs2[0] + rs2[1];
    rsum += __shfl_xor(rsum, 32);
    lrun += rsum;
#pragma unroll
    for (int s4 = 0; s4 < 4; ++s4) {
        u32x4 t4;
        if (s4 < 2) t4 = (u32x4){pk2(st0[8 * s4], st0[8 * s4 + 1]), pk2(st0[8 * s4 + 2], st0[8 * s4 + 3]), pk2(st0[8 * s4 + 4], st0[8 * s4 + 5]), pk2(st0[8 * s4 + 6], st0[8 * s4 + 7])};
        else { const int s = s4 - 2; t4 = (u32x4){pk2(st1[8 * s], st1[8 * s + 1]), pk2(st1[8 * s + 2], st1[8 * s + 3]), pk2(st1[8 * s + 4], st1[8 * s + 5]), pk2(st1[8 * s + 6], st1[8 * s + 7])}; }
        const bf16x8 pf = __builtin_bit_cast(bf16x8, t4);
        const bf16x8 v0 = *(const LAS bf16x8*)(B + vf_off + s4 * 32), v1 = *(const LAS bf16x8*)(B + vf_off + 32 * ROWB + s4 * 32);
        O0 = __builtin_amdgcn_mfma_f32_32x32x16_bf16(v0, pf, O0, 0, 0, 0);
        O1 = __builtin_amdgcn_mfma_f32_32x32x16_bf16(v1, pf, O1, 0, 0, 0);
    }
}

__device__ __forceinline__ void phase_attn(const Params& p, LAS unsigned char* lds, unsigned* queue) {
    const int tid = threadIdx.x, lane = tid & 63, w = __builtin_amdgcn_readfirstlane(tid >> 6), r = lane & 31, hh = lane >> 5;
    const bf16_t* Qg = (const bf16_t*)(p.ws + WS_Q); const bf16_t* Kg = (const bf16_t*)(p.ws + WS_K); const bf16_t* VTg = (const bf16_t*)(p.ws + WS_VT);
    const bf16_t* SZA = (const bf16_t*)(p.ws + WS_SZA); const float* KSUM = (const float*)(p.ws + WS_KSUM);
    bf16_t* MIXED = (bf16_t*)(p.ws + WS_XB);
    constexpr int ROWB = 144, TILEB = 64 * ROWB, BUFB = 2 * TILEB;
    const int srow = tid >> 3, sch = tid & 7;
    const unsigned st_off = (unsigned)(srow * ROWB + sch * 16);
    const unsigned kf_off = (unsigned)(swap23(r) * ROWB + hh * 16);
    const unsigned vf_off = (unsigned)(TILEB + r * ROWB + hh * 16);
    volatile LAS unsigned* tick = (volatile LAS unsigned*)(lds + 131072 + 8);
    for (;;) {
        if (tid == 0) *tick = __hip_atomic_fetch_add(queue, 1u, __ATOMIC_RELAXED, __HIP_MEMORY_SCOPE_AGENT);
        __syncthreads();
        const int idx = (int)*tick;
        if (idx >= 512) break;
        const int blk = 7 - (idx >> 6), bh = idx & 63, b = bh >> 3, h = bh & 7;
        const int qpos = blk * 256 + w * 32 + r;
        const bf16_t* Qp = Qg + ((size_t)bh * 2048 + qpos) * 64 + 8 * hh;
        bf16x8 qf[4];
#pragma unroll
        for (int s = 0; s < 4; ++s) qf[s] = *(const bf16x8*)(Qp + 16 * s);
        unsigned selmask;
        if (blk <= 3) selmask = (1u << blk) - 1u;
        else {
            float v1 = -3e38f, v2 = -3e38f, v3 = -3e38f; int i1 = 0, i2 = 0, i3 = 0;
#pragma unroll
            for (int j = 0; j < 7; ++j) {
                if (j < blk) {
                    const float* ks = KSUM + ((size_t)bh * 8 + j) * 64 + 8 * hh;
                    float gsum = 0.f;
#pragma unroll
                    for (int s = 0; s < 4; ++s) {
                        const f32x4 k0 = *(const f32x4*)(ks + 16 * s), k1 = *(const f32x4*)(ks + 16 * s + 4);
                        gsum += bf2f((unsigned short)qf[s][0]) * k0[0] + bf2f((unsigned short)qf[s][1]) * k0[1] + bf2f((unsigned short)qf[s][2]) * k0[2] + bf2f((unsigned short)qf[s][3]) * k0[3]
                              + bf2f((unsigned short)qf[s][4]) * k1[0] + bf2f((unsigned short)qf[s][5]) * k1[1] + bf2f((unsigned short)qf[s][6]) * k1[2] + bf2f((unsigned short)qf[s][7]) * k1[3];
                    }
                    gsum += __shfl_xor(gsum, 32);
                    if (gsum > v1) { v3 = v2; i3 = i2; v2 = v1; i2 = i1; v1 = gsum; i1 = j; }
                    else if (gsum > v2) { v3 = v2; i3 = i2; v2 = gsum; i2 = j; }
                    else if (gsum > v3) { v3 = gsum; i3 = j; }
                }
            }
            selmask = (1u << i1) | (1u << i2) | (1u << i3);
        }
        f32x16 O0, O1;
#pragma unroll
        for (int i = 0; i < 16; ++i) { O0[i] = 0.f; O1[i] = 0.f; }
        float mrun = -1e30f, lrun = 0.f;
        const int ntile = 4 + 4 * blk;
        const bf16_t* Kst = Kg + ((size_t)bh * 2048 + srow) * 64 + sch * 8;
        const bf16_t* Vst = VTg + ((size_t)bh * 64 + srow) * 2048 + sch * 8;
        u32x4 kreg[2], vreg[2];
#pragma unroll
        for (int q = 0; q < 2; ++q) { const int kp = blk * 256 + 64 * q; kreg[q] = *(const u32x4*)(Kst + (size_t)kp * 64); vreg[q] = *(const u32x4*)(Vst + kp); }
#pragma unroll
        for (int q = 0; q < 2; ++q) { *(LAS u32x4*)(lds + q * BUFB + st_off) = kreg[q]; *(LAS u32x4*)(lds + q * BUFB + TILEB + st_off) = vreg[q]; }
        __syncthreads();
        for (int n = 0; n < ntile; n += 2) {
            if (n + 2 < ntile) {
#pragma unroll
                for (int q = 0; q < 2; ++q) { const int m = n + 2 + q; const int kp = m < 4 ? blk * 256 + 64 * m : ((m - 4) >> 2) * 256 + 64 * ((m - 4) & 3);
                    kreg[q] = *(const u32x4*)(Kst + (size_t)kp * 64); vreg[q] = *(const u32x4*)(Vst + kp); }
            }
            LAS unsigned char* SB = lds + ((n >> 1) & 1) * (2 * BUFB);
#pragma unroll
            for (int q = 0; q < 2; ++q) {
                const int nn = n + q;
                const int kpos0 = nn < 4 ? blk * 256 + 64 * nn : ((nn - 4) >> 2) * 256 + 64 * ((nn - 4) & 3);
                LAS unsigned char* B = SB + q * BUFB;
                if (nn < 4) {
                    const int dt_ = w >> 1;
                    if (nn == dt_) attn_tile<true>(B, kf_off, vf_off, qf, O0, O1, mrun, lrun, true, kpos0, qpos, hh);
                    else if (nn < dt_) attn_tile<false>(B, kf_off, vf_off, qf, O0, O1, mrun, lrun, true, kpos0, qpos, hh);
                } else {
                    const bool on = (selmask >> ((nn - 4) >> 2)) & 1u;
                    if (__ballot(on) != 0ull) attn_tile<false>(B, kf_off, vf_off, qf, O0, O1, mrun, lrun, on, kpos0, qpos, hh);
                }
            }
            if (n + 2 < ntile) { LAS unsigned char* Bn = lds + (((n >> 1) + 1) & 1) * (2 * BUFB);
#pragma unroll
                for (int q = 0; q < 2; ++q) { *(LAS u32x4*)(Bn + q * BUFB + st_off) = kreg[q]; *(LAS u32x4*)(Bn + q * BUFB + TILEB + st_off) = vreg[q]; } }
            __syncthreads();
        }
        const float inv = 1.f / lrun;
        const size_t row = (size_t)b * 2048 + qpos;
#pragma unroll
        for (int dt = 0; dt < 2; ++dt)
#pragma unroll
            for (int g4 = 0; g4 < 4; ++g4) {
                const int d0 = 32 * dt + 8 * g4 + 4 * hh;
                const u32x2 z2 = *(const u32x2*)(SZA + row * 512 + h * 64 + d0);
                float o0, o1, o2, o3;
                if (dt == 0) { o0 = O0[4 * g4]; o1 = O0[4 * g4 + 1]; o2 = O0[4 * g4 + 2]; o3 = O0[4 * g4 + 3]; }
                else { o0 = O1[4 * g4]; o1 = O1[4 * g4 + 1]; o2 = O1[4 * g4 + 2]; o3 = O1[4 * g4 + 3]; }
                o0 *= inv * bflo(z2[0]); o1 *= inv * bfhi(z2[0]); o2 *= inv * bflo(z2[1]); o3 *= inv * bfhi(z2[1]);
                *(u32x2*)(MIXED + row * 1024 + h * 64 + d0) = (u32x2){pk2(o0, o1), pk2(o2, o3)};
            }
    }
}

__device__ __forceinline__ void scan_unit(const Params& p, LAS unsigned char* lds, int L) {
    const int tid = threadIdx.x, lane = tid & 63, wave = __builtin_amdgcn_readfirstlane(tid >> 6);
    float* SST = (float*)(p.ws + WS_SST); bf16_t* XU = (bf16_t*)(p.ws + WS_XU); const float* L16 = (const float*)(p.ws + WS_LAM16);
    LAS float* E = (LAS float*)lds;
    const int g = L >> 2;
    const float lr = L16[(g * 64 + lane) * 2], li = L16[(g * 64 + lane) * 2 + 1];
    float pr = lr, pi = li;
#pragma unroll
    for (int q = 0; q < 4; ++q) { const float nr = pr * pr - pi * pi, ni = 2.f * pr * pi; pr = nr; pi = ni; }
    for (int bb = 0; bb < 2; ++bb) {
        const size_t base = (size_t)256 * L + 128 * bb + 16 * wave;
        float sr[16], si[16];
#pragma unroll
        for (int c = 0; c < 16; ++c) { sr[c] = __hip_atomic_load(SST + (base + c) * 128 + lane, __ATOMIC_RELAXED, __HIP_MEMORY_SCOPE_AGENT); si[c] = __hip_atomic_load(SST + (base + c) * 128 + 64 + lane, __ATOMIC_RELAXED, __HIP_MEMORY_SCOPE_AGENT); }
        float er = 0.f, ei = 0.f;
#pragma unroll
        for (int c = 0; c < 16; ++c) { const float nr = lr * er - li * ei + sr[c], ni = lr * ei + li * er + si[c]; er = nr; ei = ni; }
        E[(wave * 2) * 64 + lane] = er; E[(wave * 2 + 1) * 64 + lane] = ei;
        __syncthreads();
        float Xr = 0.f, Xi = 0.f;
        for (int s2 = 0; s2 < wave; ++s2) { const float e_r = E[(s2 * 2) * 64 + lane], e_i = E[(s2 * 2 + 1) * 64 + lane]; const float nr = pr * Xr - pi * Xi + e_r, ni = pr * Xi + pi * Xr + e_i; Xr = nr; Xi = ni; }
#pragma unroll
        for (int c = 0; c < 16; ++c) {
            const size_t R = base + c;
            XU[R * 384 + lane] = (bf16_t)(pk2(Xr, 0.f) & 0xffffu); XU[R * 384 + 64 + lane] = (bf16_t)(pk2(Xi, 0.f) & 0xffffu);
            const float nr = lr * Xr - li * Xi + sr[c], ni = lr * Xi + li * Xr + si[c]; Xr = nr; Xi = ni;
        }
        __syncthreads();
    }
}

__device__ __forceinline__ void phase_norm(const Params& p) {
    const int tid = threadIdx.x, lane = tid & 63, wave = tid >> 6, G = gridDim.x;
    const float* SSQ = (const float*)(p.ws + WS_SSQ);
    f32x4 gn[4];
#pragma unroll
    for (int j = 0; j < 4; ++j) gn[j] = *((const f32x4*)p.final_gain + lane + 64 * j);
    for (int row = blockIdx.x * 8 + wave; row < NTOK; row += 8 * G) {
        float s = 0.f;
#pragma unroll
        for (int i = 0; i < 16; ++i) s += SSQ[row * 16 + i];
        const float rinv = 1.0f / sqrtf(s * (1.f / DM) + 1e-6f);
        f32x4* o = (f32x4*)(p.out + (size_t)row * DM) + lane;
#pragma unroll
        for (int j = 0; j < 4; ++j) { f32x4 v = o[64 * j]; v = v * rinv * gn[j]; o[64 * j] = v; }
    }
}

__global__ __launch_bounds__(512, 2) void hymba_fwd(Params p) {
    extern __shared__ __attribute__((aligned(16))) unsigned char shm_raw[];
    LAS unsigned char* lds = (LAS unsigned char*)shm_raw;
    cg::grid_group grid = cg::this_grid();
    constexpr int G = 256;
    const int bid = blockIdx.x;
    unsigned char* ws = p.ws;
#if N_LAUNCH == 1
    constexpr int lo = 0, hi = NPH;
#else
    const int lo = p.ph_lo, hi = p.ph_hi;
#endif
    if (threadIdx.x < 4) ((LAS unsigned*)(lds + 131072))[threadIdx.x] = 0u;
    __syncthreads();
    XcdBarrier xbar = xcd_barrier_post((unsigned*)(ws + WS_BAR), (volatile LAS unsigned*)(lds + 131072));
    if (hi > 1000) grid.sync();
#define IN(k) (PH_ON(k) && lo <= (k) && (k) < hi)
#define SEAM(k) do { if (lo <= (k) && (k) + 1 < hi) xcd_barrier(xbar); } while (0)
    if (IN(0)) { phase_prep(p, lds); }
    SEAM(0);
    if (IN(1)) {
        pg8::Gemm g{(const bf16_t*)(ws + WS_XB), (const bf16_t*)(ws + WS_WINT), DM, DM, DM};
        pg8::StaticOrder S; S.init(NTOK, NPROJ, G, bid);
        EpiInProj E{(const float*)(ws + WS_RS), (const float*)(ws + WS_COS), (const float*)(ws + WS_SIN),
                    (bf16_t*)(ws + WS_Q), (bf16_t*)(ws + WS_K), (bf16_t*)(ws + WS_VT), (bf16_t*)(ws + WS_SZA), (bf16_t*)(ws + WS_SZS), (bf16_t*)(ws + WS_XU), (float*)(ws + WS_KSUM)};
        pg8::gemm_phase(lds, g, S, E);
    }
    SEAM(1);
    if (IN(2)) {
        unsigned* cnt = (unsigned*)(ws + WS_BAR) + XCD_BAR_WORDS;
        if (bid < 128) {
            const int L = bid;
            {
                pg8::Gemm g{(const bf16_t*)(ws + WS_XU) + 128, (const bf16_t*)(ws + WS_WST), 384, 256, 256};
                pg8::OneUnit S{L, L >> 2};
                EpiS E{(float*)(ws + WS_SST)};
                pg8::gemm_phase<false, true, false>(lds, g, S, E);
            }
            asm volatile("s_waitcnt vmcnt(0)" ::: "memory");
            __syncthreads();
            scan_unit(p, lds, L);
            asm volatile("s_waitcnt vmcnt(0)" ::: "memory");
            __syncthreads();
            {
                pg8::Gemm g{(const bf16_t*)(ws + WS_XU), (const bf16_t*)(ws + WS_WCAT), 384, 384, 384};
                pg8::OneUnit S{L, L >> 2};
                EpiY E{(bf16_t*)(ws + WS_YG)};
                pg8::gemm_phase<false, true, false>(lds, g, S, E);
            }
            asm volatile("s_waitcnt vmcnt(0)" ::: "memory");
            __syncthreads();
            if (threadIdx.x == 0) {
                __builtin_amdgcn_fence(__ATOMIC_RELEASE, "agent");
                asm volatile("s_waitcnt vmcnt(0)" ::: "memory");
                __hip_atomic_fetch_add(cnt + 64 * (L & 3), 1u, __ATOMIC_RELAXED, __HIP_MEMORY_SCOPE_AGENT);
            }
        }
        if (bid < 128) {
            const int U = bid;
            const int pm = U >> 1, pn = U & 1;
            if (threadIdx.x == 0) {
                unsigned sp = 0;
                while (__hip_atomic_load(cnt + 64 * (pm >> 4), __ATOMIC_RELAXED, __HIP_MEMORY_SCOPE_AGENT) < 32u) { __builtin_amdgcn_s_sleep(2); if (++sp > (1u << 22)) break; }
                __builtin_amdgcn_fence(__ATOMIC_ACQUIRE, "agent");
                asm volatile("s_waitcnt vmcnt(0)" ::: "memory");
            }
            __syncthreads();
            pg8::Gemm g{(const bf16_t*)(ws + WS_YG), (const bf16_t*)(ws + WS_WGLUT), 512, 512, 512};
            pg8::OneUnit S{pm, pn};
            EpiGlu E{(const bf16_t*)(ws + WS_YG), (const bf16_t*)(ws + WS_SZS), p.b_glu, (bf16_t*)(ws + WS_XB)};
            pg8::gemm_phase<false, true, false>(lds, g, S, E);
        }
        phase_attn(p, lds, cnt + 256);
    }
    SEAM(2);
    if (G == 256) {
        if (IN(6)) {
            pg8::Gemm g{(const bf16_t*)(ws + WS_XB), (const bf16_t*)(ws + WS_WOUTT), DM, DM, DM};
            pg8::StaticOrder S; S.init(NTOK, DM, G, bid);
            EpiOutFused E{p.x, p.out, (float*)(ws + WS_SSQ), p.final_gain, xbar};
            pg8::gemm_phase<true, false, true>(lds, g, S, E);
        }
    } else {
        if (IN(6)) {
            pg8::Gemm g{(const bf16_t*)(ws + WS_XB), (const bf16_t*)(ws + WS_WOUTT), DM, DM, DM};
            pg8::StaticOrder S; S.init(NTOK, DM, G, bid);
            EpiOut E{p.x, p.out, (float*)(ws + WS_SSQ)};
            pg8::gemm_phase(lds, g, S, E);
        }
        SEAM(6);
        if (IN(7)) { phase_norm(p); }
    }
#undef IN
#undef SEAM
}

extern "C" void kernel_launch(void* const* d_in, const int* in_sizes, int n_in, void* d_out, int out_size, void* d_ws, size_t ws_size, hipStream_t stream) {
    static int grid = 0;
    if (grid == 0) {
        if (n_in != 15 || in_sizes[0] != NTOK * DM || out_size != NTOK * DM || ws_size < WS_END) { fprintf(stderr, "kernel_launch: unexpected shapes (n_in %d, in0 %d, out %d, ws %zu)\n", n_in, n_in > 0 ? in_sizes[0] : -1, out_size, ws_size); grid = -1; return; }
        int dev = 0, cus = 0, per_cu = 0;
        (void)hipGetDevice(&dev); (void)hipDeviceGetAttribute(&cus, hipDeviceAttributeMultiprocessorCount, dev);
        if (hipFuncSetAttribute((const void*)hymba_fwd, hipFuncAttributeMaxDynamicSharedMemorySize, LDS_BYTES) != hipSuccess) { fprintf(stderr, "kernel_launch: hipFuncSetAttribute failed\n"); grid = -1; return; }
        if (hipOccupancyMaxActiveBlocksPerMultiprocessor(&per_cu, (const void*)hymba_fwd, 512, LDS_BYTES) != hipSuccess || per_cu < 1) { fprintf(stderr, "kernel_launch: occupancy query says %d\n", per_cu); per_cu = 1; }
        (void)hipGetLastError();
        if (cus != 256) { fprintf(stderr, "kernel_launch: built for a 256-CU device (one workgroup per CU), found %d CUs; nothing launched\n", cus); grid = -1; return; }
        grid = 256;
    }
    if (grid < 0) return;
    if (hipMemsetAsync((char*)d_ws + WS_BAR, 0, (XCD_BAR_WORDS + 512) * 4, stream) != hipSuccess) { fprintf(stderr, "kernel_launch: memset of barrier words failed\n"); return; }
    Params p{};
    p.x = (const float*)d_in[0]; p.norm_gain = (const float*)d_in[1]; p.w_in = (const float*)d_in[2]; p.w_out = (const float*)d_in[3];
    p.lam_re = (const float*)d_in[4]; p.lam_im = (const float*)d_in[5]; p.b_re = (const float*)d_in[6]; p.b_im = (const float*)d_in[7];
    p.c_re = (const float*)d_in[8]; p.c_im = (const float*)d_in[9]; p.d_skip = (const float*)d_in[10]; p.log_dt = (const float*)d_in[11];
    p.w_glu = (const float*)d_in[12]; p.b_glu = (const float*)d_in[13]; p.final_gain = (const float*)d_in[14];
    p.out = (float*)d_out; p.ws = (unsigned char*)d_ws;
#if N_LAUNCH == 1
    p.ph_lo = 0; p.ph_hi = NPH;
    void* args[] = {&p};
    hipError_t e = hipLaunchCooperativeKernel((const void*)hymba_fwd, dim3(grid), dim3(512), args, LDS_BYTES, stream);
    if (e != hipSuccess) fprintf(stderr, "cooperative launch failed: %s (grid %d)\n", hipGetErrorString(e), grid);
#else
    for (int ph = 0; ph < NPH; ++ph) {
        p.ph_lo = ph; p.ph_hi = ph + 1;
        hipLaunchKernelGGL(hymba_fwd, dim3(grid), dim3(512), LDS_BYTES, stream, p);
    }
#endif
}
```

```cpp
#include <hip/hip_runtime.h>
#include <hip/hip_cooperative_groups.h>
#include <cstdio>
#include <cstdint>
namespace cg = cooperative_groups;

#ifndef ONLY_PH
#define ONLY_PH -1
#endif
#define PH_ON(x) (ONLY_PH < 0 || ONLY_PH == (x))
#ifndef N_LAUNCH
#define N_LAUNCH 1
#endif

#define LAS __attribute__((address_space(3)))
typedef unsigned short bf16_t;
typedef short bf16x8 __attribute__((ext_vector_type(8)));
typedef float f32x4 __attribute__((ext_vector_type(4)));
typedef float f32x16 __attribute__((ext_vector_type(16)));
typedef unsigned u32x2 __attribute__((ext_vector_type(2)));
typedef unsigned u32x4 __attribute__((ext_vector_type(4)));

constexpr int NTOK = 16384, DM = 1024, SEQ = 2048, NPROJ = 3072;
constexpr int NPH = 8;
constexpr size_t MBy = 1u << 20;
constexpr size_t WS_XB = 0;
constexpr size_t WS_WINT = 32 * MBy;
constexpr size_t WS_WOUTT = 38 * MBy;
constexpr size_t WS_WGLUT = 40 * MBy;
constexpr size_t WS_WST = 41 * MBy;
constexpr size_t WS_WCAT = 45 * MBy;
constexpr size_t WS_LAM16 = 51 * MBy;
constexpr size_t WS_RS = WS_LAM16 + 64 * 1024;
constexpr size_t WS_COS = WS_RS + 64 * 1024;
constexpr size_t WS_SIN = WS_COS + 256 * 1024;
constexpr size_t WS_KSUM = WS_SIN + 256 * 1024;
constexpr size_t WS_Q = 52 * MBy;
constexpr size_t WS_K = 68 * MBy;
constexpr size_t WS_VT = 84 * MBy;
constexpr size_t WS_SZA = 100 * MBy;
constexpr size_t WS_SZS = 116 * MBy;
constexpr size_t WS_XU = 132 * MBy;
constexpr size_t WS_SST = 156 * MBy;
constexpr size_t WS_YG = 172 * MBy;
constexpr size_t WS_SSQ = 188 * MBy;
constexpr size_t WS_BAR = 189 * MBy;
constexpr size_t WS_END = 190 * MBy;
constexpr int LDS_BYTES = 131072 + 16;

struct Params {
    const float *x, *norm_gain, *w_in, *w_out, *lam_re, *lam_im, *b_re, *b_im, *c_re, *c_im, *d_skip, *log_dt, *w_glu, *b_glu, *final_gain;
    float* out; unsigned char* ws;
    int ph_lo, ph_hi;
};

__device__ __forceinline__ unsigned pk2(float lo, float hi) { unsigned r; asm("v_cvt_pk_bf16_f32 %0, %1, %2" : "=v"(r) : "v"(lo), "v"(hi)); return r; }
__device__ __forceinline__ float bf2f(unsigned short b) { return __uint_as_float(((unsigned)b) << 16); }
__device__ __forceinline__ float bflo(unsigned w) { return __uint_as_float(w << 16); }
__device__ __forceinline__ float bfhi(unsigned w) { return __uint_as_float(w & 0xffff0000u); }
__device__ __forceinline__ float wave_sum(float v) {
#pragma unroll
    for (int o = 1; o < 64; o <<= 1) v += __shfl_xor(v, o);
    return v;
}
__device__ __forceinline__ float sigmoidf_(float v) { return __builtin_amdgcn_rcpf(1.f + __expf(-v)); }
__device__ __forceinline__ float siluf_(float v) { return v * sigmoidf_(v); }
__device__ __forceinline__ float gelu_tanh(float y) { const float t = 1.5957691216f * (y + 0.044715f * y * y * y); return y * sigmoidf_(t); }


#define XB_TMO      128
#define XB_XCNT(j)  (256  + 64 * (j))
#define XB_XSUB(j)  (1280 + 64 * (j))
#define XB_XGEN(j)  (2304 + 64 * (j))
#define XB_TOP      3328
#define XB_TOPGEN   3392
#define XCD_BAR_WORDS 3456
#define XB_SPIN_CAP (1u << 18)
__device__ __forceinline__ unsigned xb_ld(unsigned* p)              { return __hip_atomic_load(p, __ATOMIC_RELAXED, __HIP_MEMORY_SCOPE_AGENT); }
__device__ __forceinline__ unsigned xb_add(unsigned* p, unsigned v) { return __hip_atomic_fetch_add(p, v, __ATOMIC_RELAXED, __HIP_MEMORY_SCOPE_AGENT); }
__device__ __forceinline__ unsigned xb_xcc_id() { return (unsigned)__builtin_amdgcn_s_getreg((3 << 11) | 20) & 0xFu; }
#define XB_SPIN(cond, bar) do { unsigned _sp = 0; while (cond) { __builtin_amdgcn_s_sleep(1); \
    if ((++_sp & 255u) == 0u) { if (xb_ld(&(bar)[XB_TMO])) break; if (_sp > XB_SPIN_CAP) { atomicAdd(&(bar)[XB_TMO], 1u); break; } } } } while (0)
struct XcdBarrier { unsigned* bar; unsigned x; volatile LAS unsigned* st; };
__device__ __forceinline__ XcdBarrier xcd_barrier_post(unsigned* bar, volatile LAS unsigned* st) {
    XcdBarrier b; b.bar = bar; b.x = xb_xcc_id(); b.st = st;
    if (threadIdx.x == 0) (void)xb_add(&bar[XB_XCNT(b.x)], 1u);
    return b;
}
__device__ __forceinline__ void xcd_barrier_complete(unsigned* bar, unsigned x, unsigned& nloc, unsigned& nx) {
    const unsigned G = 256u;
    unsigned sum, cnt, mine, sp = 0u;
    for (;;) {
        sum = 0u; cnt = 0u; mine = 0u;
#pragma unroll
        for (unsigned j = 0; j < 16; ++j) { const unsigned c = xb_ld(&bar[XB_XCNT(j)]); sum += c; cnt += (c > 0u) ? 1u : 0u; mine = (j == x) ? c : mine; }
        if (sum == G) break;
        __builtin_amdgcn_s_sleep(1);
        if ((++sp & 255u) == 0u) { if (xb_ld(&bar[XB_TMO])) break; if (sp > XB_SPIN_CAP) { atomicAdd(&bar[XB_TMO], 1u); break; } }
    }
    nloc = mine > 0u ? mine : 1u; nx = cnt > 0u ? cnt : 1u;
}
__device__ __forceinline__ void xcd_barrier(const XcdBarrier& b) {
    asm volatile("s_waitcnt vmcnt(0)" ::: "memory");
    __syncthreads();
    if (threadIdx.x == 0) {
        unsigned* bar = b.bar;
        __builtin_amdgcn_s_waitcnt(0);
        unsigned nloc = b.st[0], nx = b.st[1];
        if (nloc == 0u) { xcd_barrier_complete(bar, b.x, nloc, nx); b.st[0] = nloc; b.st[1] = nx; }
        const unsigned old = xb_add(&bar[XB_XSUB(b.x)], 1u);
        const unsigned gen = old / nloc;
        if (old + 1u == (gen + 1u) * nloc) {
            __builtin_amdgcn_fence(__ATOMIC_RELEASE, "agent");
            asm volatile("s_waitcnt vmcnt(0)" ::: "memory");
            const unsigned og = xb_add(&bar[XB_TOP], 1u);
            const unsigned tg = og / nx;
            if (og + 1u == (tg + 1u) * nx) xb_add(&bar[XB_TOPGEN], 1u);
            else XB_SPIN(xb_ld(&bar[XB_TOPGEN]) == tg, bar);
            __builtin_amdgcn_fence(__ATOMIC_ACQUIRE, "agent");
            xb_add(&bar[XB_XGEN(b.x)], 1u);
            asm volatile("s_waitcnt vmcnt(0)" ::: "memory");
        } else {
            XB_SPIN(xb_ld(&bar[XB_XGEN(b.x)]) == gen, bar);
            __builtin_amdgcn_fence(__ATOMIC_ACQUIRE, "agent");
            asm volatile("s_waitcnt vmcnt(0)" ::: "memory");
        }
    }
    __syncthreads();
}

namespace pg8 {
constexpr int BM = 256, BK = 64, HALF = 128, HTB = HALF * BK * 2, STAGE_BYTES = 8 * HTB, NXCD = 8, WGM = 8;
__device__ __forceinline__ int lds_byte(int r, int c) { const int st = (r >> 4) * 2 + (c >> 5), rr = r & 15, cc = c & 31, ob = rr * 64 + cc * 2; return st * 1024 + (ob ^ (((ob >> 9) & 1) << 5)); }
__device__ __forceinline__ void stage_rc(int b, int& R, int& C) { const int st = b / 1024, sb = b % 1024, swz = sb ^ (((sb >> 9) & 1) << 5); R = (st >> 1) * 16 + swz / 64; C = (st & 1) * 32 + (swz % 64) / 2; }
struct Unit { int pm, pn; };
struct Gemm { const bf16_t* A; const bf16_t* Bt; };

template <int M, int N>
struct StaticOrder {
    static constexpr int nM = M / BM, nN = N / BM, nwg = nM * nN, G = 256;
    int c;
    __device__ bool next(int i, Unit& u) const {
        const int L = i * G + c; if (L >= nwg) return false;
        int wgid = L; { constexpr int q = nwg / NXCD, r = nwg % NXCD; const int xcd = wgid % NXCD, off = wgid / NXCD; wgid = (xcd < r ? xcd * (q + 1) : r * (q + 1) + (xcd - r) * q) + off; }
        constexpr int nig = WGM * nN; const int gid = wgid / nig, fm = gid * WGM, gsz = (nM - fm) < WGM ? (nM - fm) : WGM;
        u.pm = fm + ((wgid % nig) % gsz); u.pn = (wgid % nig) / gsz; return true;
    }
};
struct GroupOrder {
    int G, c;
    __device__ bool next(int i, Unit& u) const { const int L = i * G + c; if (L >= 128) return false; u.pm = L; u.pn = L >> 2; return true; }
};

struct OneUnit {
    int pm, pn;
    __device__ bool next(int i, Unit& u) const { if (i) return false; u.pm = pm; u.pn = pn; return true; }
};

template <int LDA, int LDB, int KK, bool AFTER = false, bool ALIGN_EPI = true, bool SP2 = true, class Epi, class Sched>
__device__ __forceinline__ void gemm_phase(LAS unsigned char* lds, const Gemm g, const Sched& S, const Epi& E) {
    const int tid = threadIdx.x, wid = __builtin_amdgcn_readfirstlane(tid >> 6), lane = tid & 63, wr = wid >> 2, wc = wid & 3, fr = lane & 15, fq = lane >> 4;
    constexpr int K = KK, nt = K / BK;
    unsigned voffA[2], voffB[2];
#pragma unroll
    for (int i = 0; i < 2; ++i) { int R, C; stage_rc(tid * 16 + i * 8192, R, C); voffA[i] = (unsigned)(R * LDA + C) * 2u; voffB[i] = (unsigned)(R * LDB + C) * 2u; }
    constexpr size_t kstep = (size_t)(BK * 2);
    constexpr size_t hstepA = (size_t)HALF * LDA * 2, hstepB = (size_t)HALF * LDB * 2;
    constexpr size_t tstepA = 2 * hstepA, tstepB = 2 * hstepB;
    const unsigned ldsw = (unsigned)wid * 1024u;
    const int aoff = lds_byte(wr * 64 + fr, fq * 8), boff = lds_byte(wc * 32 + fr, fq * 8);
#define PG8_SA(b, h) (((b) * 2 + (h)) * HTB)
#define PG8_SB(b, h) ((4 + (b) * 2 + (h)) * HTB)
#define PG8_STAGE(bufoff, gbase, voff) do { _Pragma("unroll") for (int _i = 0; _i < 2; ++_i) \
        __builtin_amdgcn_global_load_lds((const unsigned*)((const char*)(gbase) + (voff)[_i]), (LAS unsigned*)(lds + (bufoff) + ldsw + _i * 8192), 16, 0, 0); } while (0)
#define PG8_LDA(dst, b, h) do { _Pragma("unroll") for (int m = 0; m < 4; ++m) _Pragma("unroll") for (int k = 0; k < 2; ++k) dst[m][k] = *(const LAS bf16x8*)(lds + PG8_SA(b, h) + aoff + m * 2048 + k * 1024); } while (0)
#define PG8_LDB(dst, b, h) do { _Pragma("unroll") for (int n = 0; n < 2; ++n) _Pragma("unroll") for (int k = 0; k < 2; ++k) dst[n][k] = *(const LAS bf16x8*)(lds + PG8_SB(b, h) + boff + n * 2048 + k * 1024); } while (0)
#define PG8_MMA(ai, bj, At, Bt) do { __builtin_amdgcn_s_setprio(1); _Pragma("unroll") for (int m = 0; m < 4; ++m) _Pragma("unroll") for (int n = 0; n < 2; ++n) _Pragma("unroll") for (int k = 0; k < 2; ++k) \
        acc[ai][bj][m][n] = __builtin_amdgcn_mfma_f32_16x16x32_bf16(Bt[n][k], At[m][k], acc[ai][bj][m][n], 0, 0, 0); __builtin_amdgcn_s_setprio(0); } while (0)
#define PG8_WAIT_V(n) asm volatile("s_waitcnt vmcnt(" #n ")" ::: "memory")
#define PG8_WAIT_L(n) asm volatile("s_waitcnt lgkmcnt(" #n ")" ::: "memory")
#define PG8_BAR __builtin_amdgcn_s_barrier()
#define PG8_SCHED __builtin_amdgcn_sched_barrier(0)
    Unit cur, nxt; int ui = 0;
    if (!S.next(0, cur)) return;
    f32x4 acc[2][2][4][2];
#pragma unroll
    for (int a = 0; a < 2; ++a)
#pragma unroll
        for (int b = 0; b < 2; ++b)
#pragma unroll
            for (int m = 0; m < 4; ++m)
#pragma unroll
                for (int n = 0; n < 2; ++n) acc[a][b][m][n] = (f32x4){0.f, 0.f, 0.f, 0.f};
    bf16x8 At[4][2], B0[2][2], B1[2][2];
    const char* cA = (const char*)g.A + (size_t)cur.pm * tstepA; const char* cB = (const char*)g.Bt + (size_t)cur.pn * tstepB;
    if constexpr (SP2) {
        PG8_STAGE(PG8_SB(0, 0), cB, voffB); PG8_STAGE(PG8_SB(0, 1), cB + hstepB, voffB); PG8_STAGE(PG8_SA(0, 0), cA, voffA); PG8_STAGE(PG8_SA(0, 1), cA + hstepA, voffA);
        if (wr == 1) PG8_BAR;
        PG8_WAIT_V(2); PG8_BAR;
        PG8_STAGE(PG8_SB(1, 0), cB + kstep, voffB); PG8_STAGE(PG8_SA(1, 0), cA + kstep, voffA); PG8_STAGE(PG8_SB(1, 1), cB + hstepB + kstep, voffB);
        PG8_WAIT_V(6); PG8_BAR;
    } else {
        PG8_STAGE(PG8_SB(0, 0), cB, voffB); PG8_STAGE(PG8_SA(0, 0), cA, voffA); PG8_STAGE(PG8_SB(0, 1), cB + hstepB, voffB); PG8_STAGE(PG8_SA(0, 1), cA + hstepA, voffA);
        if (wr == 1) PG8_BAR;
        PG8_WAIT_V(4); PG8_BAR;
        PG8_STAGE(PG8_SB(1, 0), cB + kstep, voffB); PG8_STAGE(PG8_SA(1, 0), cA + kstep, voffA); PG8_STAGE(PG8_SB(1, 1), cB + hstepB + kstep, voffB);
        PG8_WAIT_V(6); PG8_BAR;
    }
    for (;;) {
        const bool has_next = S.next(ui + 1, nxt);
        const char* nA = has_next ? (const char*)g.A + (size_t)nxt.pm * tstepA : cA; const char* nB = has_next ? (const char*)g.Bt + (size_t)nxt.pn * tstepB : cB;
        for (int t = 0; t < nt; t += 2) {
            const bool last = (t == nt - 2);
            const char* a1 = cA + (size_t)(t + 1) * kstep;
            const char* a2 = last ? nA : cA + (size_t)(t + 2) * kstep; const char* b2 = last ? nB : cB + (size_t)(t + 2) * kstep;
            const char* a3 = a2 + kstep; const char* b3 = b2 + kstep;
            if constexpr (SP2) {
            PG8_LDB(B0, 0, 0); PG8_LDB(B1, 0, 1); PG8_SCHED; PG8_LDA(At, 0, 0); PG8_STAGE(PG8_SA(1, 1), a1 + hstepA, voffA);
            PG8_WAIT_V(8); PG8_WAIT_L(0); PG8_BAR; PG8_MMA(0, 0, At, B0); PG8_MMA(0, 1, At, B1); PG8_BAR; PG8_SCHED;
            PG8_LDA(At, 0, 1); PG8_STAGE(PG8_SB(0, 0), b2, voffB); PG8_STAGE(PG8_SB(0, 1), b2 + hstepB, voffB); PG8_STAGE(PG8_SA(0, 0), a2, voffA);
            PG8_WAIT_V(8); PG8_WAIT_L(0); PG8_BAR; PG8_MMA(1, 0, At, B0); PG8_MMA(1, 1, At, B1); PG8_BAR; PG8_SCHED;
            PG8_LDB(B0, 1, 0); PG8_LDB(B1, 1, 1); PG8_SCHED; PG8_LDA(At, 1, 0); PG8_STAGE(PG8_SA(0, 1), a2 + hstepA, voffA);
            PG8_WAIT_V(8); PG8_WAIT_L(0); PG8_BAR; PG8_MMA(0, 0, At, B0); PG8_MMA(0, 1, At, B1); PG8_BAR; PG8_SCHED;
            PG8_LDA(At, 1, 1); PG8_STAGE(PG8_SB(1, 0), b3, voffB); PG8_STAGE(PG8_SB(1, 1), b3 + hstepB, voffB); PG8_STAGE(PG8_SA(1, 0), a3, voffA);
            PG8_WAIT_V(8); PG8_WAIT_L(0); PG8_BAR; PG8_MMA(1, 0, At, B0); PG8_MMA(1, 1, At, B1); PG8_BAR; PG8_SCHED;
            } else {
            PG8_LDB(B0, 0, 0); PG8_SCHED; PG8_LDA(At, 0, 0); PG8_STAGE(PG8_SA(1, 1), a1 + hstepA, voffA);
            PG8_WAIT_L(8); PG8_BAR; PG8_WAIT_L(0); PG8_MMA(0, 0, At, B0); PG8_BAR; PG8_SCHED;
            PG8_LDB(B1, 0, 1); PG8_STAGE(PG8_SB(0, 0), b2, voffB);
            PG8_BAR; PG8_WAIT_L(0); PG8_MMA(0, 1, At, B1); PG8_BAR;
            PG8_LDA(At, 0, 1); PG8_STAGE(PG8_SA(0, 0), a2, voffA);
            PG8_BAR; PG8_WAIT_L(0); PG8_MMA(1, 0, At, B0); PG8_BAR; PG8_SCHED;
            PG8_STAGE(PG8_SB(0, 1), b2 + hstepB, voffB);
            PG8_WAIT_V(6); PG8_BAR; PG8_MMA(1, 1, At, B1); PG8_BAR;
            PG8_LDB(B0, 1, 0); PG8_SCHED; PG8_LDA(At, 1, 0); PG8_STAGE(PG8_SA(0, 1), a2 + hstepA, voffA);
            PG8_WAIT_L(8); PG8_BAR; PG8_WAIT_L(0); PG8_MMA(0, 0, At, B0); PG8_BAR; PG8_SCHED;
            PG8_LDB(B1, 1, 1); PG8_STAGE(PG8_SB(1, 0), b3, voffB);
            PG8_BAR; PG8_WAIT_L(0); PG8_MMA(0, 1, At, B1); PG8_BAR;
            PG8_LDA(At, 1, 1); PG8_STAGE(PG8_SA(1, 0), a3, voffA);
            PG8_BAR; PG8_WAIT_L(0); PG8_MMA(1, 0, At, B0); PG8_BAR; PG8_SCHED;
            PG8_STAGE(PG8_SB(1, 1), b3 + hstepB, voffB);
            PG8_WAIT_V(6); PG8_BAR; PG8_MMA(1, 1, At, B1); PG8_BAR;
                    }
        }
        if constexpr (ALIGN_EPI) { if (wr == 0) PG8_BAR; }
        E(acc, cur, wr, wc, fr, fq);
        if (!has_next) break;
#pragma unroll
        for (int a = 0; a < 2; ++a)
#pragma unroll
            for (int b = 0; b < 2; ++b)
#pragma unroll
                for (int m = 0; m < 4; ++m)
#pragma unroll
                    for (int n = 0; n < 2; ++n) acc[a][b][m][n] = (f32x4){0.f, 0.f, 0.f, 0.f};
        cur = nxt; cA = nA; cB = nB; ++ui;
        if constexpr (ALIGN_EPI) { if (wr == 1) PG8_BAR; }
    }
    PG8_WAIT_V(0);
    if constexpr (!ALIGN_EPI) { if (wr == 0) PG8_BAR; }
    PG8_BAR;
    if constexpr (AFTER) E.after(acc, cur, wr, wc, fr, fq);
#undef PG8_SA
#undef PG8_SB
#undef PG8_STAGE
#undef PG8_LDA
#undef PG8_LDB
#undef PG8_MMA
#undef PG8_WAIT_V
#undef PG8_WAIT_L
#undef PG8_BAR
#undef PG8_SCHED
}
}
using pg8::Unit;


__device__ __forceinline__ int inproj_row(int e) {
    const int pn = e >> 8, o = e & 255;
    const int wc = o >> 6, bj = (o >> 5) & 1, fq = (o >> 3) & 3, n = (o >> 2) & 1, i = o & 3;
    return 256 * pn + 128 * bj + 32 * wc + 16 * n + 4 * fq + i;
}

struct EpiInProj {
    const float *rs, *cosT, *sinT;
    bf16_t *Q, *Kk, *VT, *SZA, *SZS, *XU; float* KSUM;
    __device__ __forceinline__ void operator()(const f32x4 (&acc)[2][2][4][2], const Unit& u, int wr, int wc, int fr, int fq) const {
        const int seg = u.pn >> 1, half = u.pn & 1;
        const int b = u.pm >> 3, blk = u.pm & 7;
        const int lbase = blk * 256 + wr * 64 + fr;
        if (seg <= 1) {
            bf16_t* dst = seg == 0 ? Q : Kk; const float qs = seg == 0 ? 0.18033688011112042f : 1.0f;
            const int head = 4 * half + wc;
            f32x4 cl[2], ch[2];
#pragma unroll
            for (int n = 0; n < 2; ++n) { cl[n] = (f32x4){0.f, 0.f, 0.f, 0.f}; ch[n] = (f32x4){0.f, 0.f, 0.f, 0.f}; }
            bf16_t* obase = dst + ((size_t)((b * 8 + head) * 2048)) * 64 + 8 * fq;
#pragma unroll
            for (int ai = 0; ai < 2; ++ai)
#pragma unroll
                for (int m = 0; m < 4; ++m) {
                    const int l = lbase + 128 * ai + 16 * m; const float rsv = rs[b * 2048 + l] * qs;
                    unsigned wl[4], wh[4];
#pragma unroll
                    for (int n = 0; n < 2; ++n) {
                        const f32x4 c4 = *(const f32x4*)(cosT + l * 32 + 8 * fq + 4 * n), s4 = *(const f32x4*)(sinT + l * 32 + 8 * fq + 4 * n);
                        const f32x4 t1 = acc[ai][0][m][n] * rsv, t2 = acc[ai][1][m][n] * rsv;
                        const f32x4 lo = t1 * c4 - t2 * s4, hi = t2 * c4 + t1 * s4;
                        wl[2 * n] = pk2(lo[0], lo[1]); wl[2 * n + 1] = pk2(lo[2], lo[3]); wh[2 * n] = pk2(hi[0], hi[1]); wh[2 * n + 1] = pk2(hi[2], hi[3]);
                        cl[n] += lo; ch[n] += hi;
                    }
                    bf16_t* o = obase + (unsigned)l * 64u;
                    *(u32x4*)o = (u32x4){wl[0], wl[1], wl[2], wl[3]};
                    *(u32x4*)(o + 32) = (u32x4){wh[0], wh[1], wh[2], wh[3]};
                }
            if (seg == 1) {
#pragma unroll
                for (int n = 0; n < 2; ++n)
#pragma unroll
                    for (int i = 0; i < 4; ++i) {
                        float v = cl[n][i], v2 = ch[n][i];
                        v += __shfl_xor(v, 1); v += __shfl_xor(v, 2); v += __shfl_xor(v, 4); v += __shfl_xor(v, 8);
                        v2 += __shfl_xor(v2, 1); v2 += __shfl_xor(v2, 2); v2 += __shfl_xor(v2, 4); v2 += __shfl_xor(v2, 8);
                        if (fr == 0) { float* kp = KSUM + ((b * 8 + head) * 8 + blk) * 64 + 8 * fq + 4 * n + i; atomicAdd(kp, v); atomicAdd(kp + 32, v2); }
                    }
            }
        } else if (seg == 2) {
            const int head = 4 * half + wc;
#pragma unroll
            for (int ai = 0; ai < 2; ++ai)
#pragma unroll
                for (int m = 0; m < 4; ++m) {
                    const int l = lbase + 128 * ai + 16 * m; const float rsv = rs[b * 2048 + l];
#pragma unroll
                    for (int bj = 0; bj < 2; ++bj)
#pragma unroll
                        for (int n = 0; n < 2; ++n) {
                            const int d0 = 32 * bj + 8 * fq + 4 * n;
                            const f32x4 v = acc[ai][bj][m][n] * rsv;
                            bf16_t* o = VT + ((size_t)((b * 8 + head) * 64 + d0)) * 2048 + l;
                            const unsigned p0 = pk2(v[0], v[1]), p1 = pk2(v[2], v[3]);
                            o[0] = (bf16_t)(p0 & 0xffffu); o[2048] = (bf16_t)(p0 >> 16); o[4096] = (bf16_t)(p1 & 0xffffu); o[6144] = (bf16_t)(p1 >> 16);
                        }
                }
        } else if (seg == 4) {
#pragma unroll
            for (int ai = 0; ai < 2; ++ai)
#pragma unroll
                for (int m = 0; m < 4; ++m) {
                    const int l = lbase + 128 * ai + 16 * m; const float rsv = rs[b * 2048 + l];
                    const int c = l >> 4, t = l & 15;
#pragma unroll
                    for (int bj = 0; bj < 2; ++bj) {
                        const int g = 16 * half + 4 * wc + 2 * bj + (fq >> 1);
                        const f32x4 v0 = acc[ai][bj][m][0] * rsv, v1 = acc[ai][bj][m][1] * rsv;
                        bf16_t* o = XU + ((size_t)(1024 * g + b * 128 + c)) * 384 + 128 + t * 16 + 8 * (fq & 1);
                        *(u32x4*)o = (u32x4){pk2(v0[0], v0[1]), pk2(v0[2], v0[3]), pk2(v1[0], v1[1]), pk2(v1[2], v1[3])};
                    }
                }
        } else {
            bf16_t* dst = seg == 3 ? SZA : SZS;
#pragma unroll
            for (int ai = 0; ai < 2; ++ai)
#pragma unroll
                for (int m = 0; m < 4; ++m) {
                    const int l = lbase + 128 * ai + 16 * m; const int row = b * 2048 + l; const float rsv = rs[row];
#pragma unroll
                    for (int bj = 0; bj < 2; ++bj) {
                        const int col = 256 * half + 64 * wc + 32 * bj + 8 * fq;
                        const f32x4 v0 = acc[ai][bj][m][0] * rsv, v1 = acc[ai][bj][m][1] * rsv;
                        *(u32x4*)(dst + (size_t)row * 512 + col) = (u32x4){pk2(siluf_(v0[0]), siluf_(v0[1])), pk2(siluf_(v0[2]), siluf_(v0[3])), pk2(siluf_(v1[0]), siluf_(v1[1])), pk2(siluf_(v1[2]), siluf_(v1[3]))};
                    }
                }
        }
    }
};

struct EpiS {
    float* SST;
    __device__ __forceinline__ void operator()(const f32x4 (&acc)[2][2][4][2], const Unit& u, int wr, int wc, int fr, int fq) const {
#pragma unroll
        for (int ai = 0; ai < 2; ++ai)
#pragma unroll
            for (int m = 0; m < 4; ++m) {
                const int R = 256 * u.pm + 128 * ai + 64 * wr + 16 * m + fr;
#pragma unroll
                for (int n = 0; n < 2; ++n) *(f32x4*)(SST + (size_t)R * 128 + 32 * wc + 16 * n + 4 * fq) = acc[ai][0][m][n];
            }
    }
};

struct EpiY {
    bf16_t* YG;
    __device__ __forceinline__ void operator()(const f32x4 (&acc)[2][2][4][2], const Unit& u, int wr, int wc, int fr, int fq) const {
        const int g = u.pn, t = 4 * wc + fq;
#pragma unroll
        for (int ai = 0; ai < 2; ++ai)
#pragma unroll
            for (int m = 0; m < 4; ++m) {
                const int rr = 256 * (u.pm & 3) + 128 * ai + 64 * wr + 16 * m + fr;
                const int b = rr >> 7, c = rr & 127; const int token = b * 2048 + 16 * c + t;
                bf16_t* ob = YG + (size_t)token * 512 + 16 * g;
#pragma unroll
                for (int bj = 0; bj < 2; ++bj) {
                    const f32x4 v0 = acc[ai][bj][m][0], v1 = acc[ai][bj][m][1];
                    *(u32x4*)(ob + 8 * bj) = (u32x4){pk2(gelu_tanh(v0[0]), gelu_tanh(v0[1])), pk2(gelu_tanh(v0[2]), gelu_tanh(v0[3])), pk2(gelu_tanh(v1[0]), gelu_tanh(v1[1])), pk2(gelu_tanh(v1[2]), gelu_tanh(v1[3]))};
                }
            }
    }
};

struct EpiGlu {
    const bf16_t *YG, *SZS; const float* bglu; bf16_t* MIXED;
    __device__ __forceinline__ void operator()(const f32x4 (&acc)[2][2][4][2], const Unit& u, int wr, int wc, int fr, int fq) const {
        f32x4 bias[2][2];
#pragma unroll
        for (int bj = 0; bj < 2; ++bj)
#pragma unroll
            for (int n = 0; n < 2; ++n) bias[bj][n] = *(const f32x4*)(bglu + 256 * u.pn + 64 * wc + 32 * bj + 8 * fq + 4 * n);
#pragma unroll
        for (int ai = 0; ai < 2; ++ai) {
            u32x4 y4[4][2], z4[4][2];
#pragma unroll
            for (int m = 0; m < 4; ++m) {
                const int row = 256 * u.pm + 128 * ai + 64 * wr + 16 * m + fr;
#pragma unroll
                for (int bj = 0; bj < 2; ++bj) {
                    const unsigned off = (unsigned)row * 512u + (unsigned)(256 * u.pn + 64 * wc + 32 * bj + 8 * fq);
                    y4[m][bj] = *(const u32x4*)(YG + off); z4[m][bj] = *(const u32x4*)(SZS + off);
                }
            }
#pragma unroll
            for (int m = 0; m < 4; ++m) {
                const int row = 256 * u.pm + 128 * ai + 64 * wr + 16 * m + fr;
#pragma unroll
                for (int bj = 0; bj < 2; ++bj) {
                    const int col = 256 * u.pn + 64 * wc + 32 * bj + 8 * fq;
                    unsigned w[4];
#pragma unroll
                    for (int n = 0; n < 2; ++n) {
                        const f32x4 a = acc[ai][bj][m][n] + bias[bj][n];
                        const unsigned ya = y4[m][bj][2 * n], yb = y4[m][bj][2 * n + 1], za = z4[m][bj][2 * n], zb = z4[m][bj][2 * n + 1];
                        const float o0 = bflo(ya) * sigmoidf_(a[0]) * bflo(za), o1 = bfhi(ya) * sigmoidf_(a[1]) * bfhi(za);
                        const float o2 = bflo(yb) * sigmoidf_(a[2]) * bflo(zb), o3 = bfhi(yb) * sigmoidf_(a[3]) * bfhi(zb);
                        w[2 * n] = pk2(o0, o1); w[2 * n + 1] = pk2(o2, o3);
                    }
                    *(u32x4*)(MIXED + (size_t)row * 1024 + 512 + col) = (u32x4){w[0], w[1], w[2], w[3]};
                }
            }
        }
    }
};

struct EpiOut {
    const float* x; float* out; float* SSQ;
    __device__ __forceinline__ void operator()(const f32x4 (&acc)[2][2][4][2], const Unit& u, int wr, int wc, int fr, int fq) const {
#pragma unroll
        for (int ai = 0; ai < 2; ++ai) {
            f32x4 xv[4][2][2];
#pragma unroll
            for (int m = 0; m < 4; ++m) {
                const int row = 256 * u.pm + 128 * ai + 64 * wr + 16 * m + fr;
#pragma unroll
                for (int bj = 0; bj < 2; ++bj)
#pragma unroll
                    for (int n = 0; n < 2; ++n) xv[m][bj][n] = *(const f32x4*)(x + (size_t)row * 1024 + 256 * u.pn + 64 * wc + 32 * bj + 8 * fq + 4 * n);
            }
#pragma unroll
            for (int m = 0; m < 4; ++m) {
                const int row = 256 * u.pm + 128 * ai + 64 * wr + 16 * m + fr;
                float ss = 0.f;
#pragma unroll
                for (int bj = 0; bj < 2; ++bj)
#pragma unroll
                    for (int n = 0; n < 2; ++n) {
                        const int col = 256 * u.pn + 64 * wc + 32 * bj + 8 * fq + 4 * n;
                        const f32x4 v = acc[ai][bj][m][n] + xv[m][bj][n];
                        *(f32x4*)(out + (size_t)row * 1024 + col) = v;
                        ss += (v[0] * v[0] + v[1] * v[1]) + (v[2] * v[2] + v[3] * v[3]);
                    }
                ss += __shfl_xor(ss, 16); ss += __shfl_xor(ss, 32);
                if (fq == 0) SSQ[row * 16 + 4 * u.pn + wc] = ss;
            }
        }
    }
};

struct EpiOutFused {
    const float* x; float* out; float* SSQ; const float* gain; XcdBarrier xbar;
    __device__ __forceinline__ void operator()(f32x4 (&acc)[2][2][4][2], const Unit& u, int wr, int wc, int fr, int fq) const {
#pragma unroll
        for (int ai = 0; ai < 2; ++ai) {
            f32x4 xv[4][2][2];
#pragma unroll
            for (int m = 0; m < 4; ++m) {
                const int row = 256 * u.pm + 128 * ai + 64 * wr + 16 * m + fr;
#pragma unroll
                for (int bj = 0; bj < 2; ++bj)
#pragma unroll
                    for (int n = 0; n < 2; ++n) xv[m][bj][n] = *(const f32x4*)(x + (size_t)row * 1024 + 256 * u.pn + 64 * wc + 32 * bj + 8 * fq + 4 * n);
            }
#pragma unroll
            for (int m = 0; m < 4; ++m) {
                const int row = 256 * u.pm + 128 * ai + 64 * wr + 16 * m + fr;
                float ss = 0.f;
#pragma unroll
                for (int bj = 0; bj < 2; ++bj)
#pragma unroll
                    for (int n = 0; n < 2; ++n) {
                        const f32x4 v = acc[ai][bj][m][n] + xv[m][bj][n];
                        acc[ai][bj][m][n] = v;
                        ss += (v[0] * v[0] + v[1] * v[1]) + (v[2] * v[2] + v[3] * v[3]);
                    }
                ss += __shfl_xor(ss, 16); ss += __shfl_xor(ss, 32);
                if (fq == 0) SSQ[row * 16 + 4 * u.pn + wc] = ss;
            }
        }
    }
    __device__ __forceinline__ void after(f32x4 (&acc)[2][2][4][2], const Unit& u, int wr, int wc, int fr, int fq) const {
        xcd_barrier(xbar);
        f32x4 gn[2][2];
#pragma unroll
        for (int bj = 0; bj < 2; ++bj)
#pragma unroll
            for (int n = 0; n < 2; ++n) gn[bj][n] = *(const f32x4*)(gain + 256 * u.pn + 64 * wc + 32 * bj + 8 * fq + 4 * n);
#pragma unroll
        for (int ai = 0; ai < 2; ++ai)
#pragma unroll
            for (int m = 0; m < 4; ++m) {
                const int row = 256 * u.pm + 128 * ai + 64 * wr + 16 * m + fr;
                const f32x4* sp = (const f32x4*)(SSQ + row * 16);
                const f32x4 s0 = sp[0], s1 = sp[1], s2 = sp[2], s3 = sp[3];
                const float tot = ((s0[0] + s0[1]) + (s0[2] + s0[3])) + ((s1[0] + s1[1]) + (s1[2] + s1[3])) + ((s2[0] + s2[1]) + (s2[2] + s2[3])) + ((s3[0] + s3[1]) + (s3[2] + s3[3]));
                const float rinv = 1.0f / sqrtf(tot * (1.f / DM) + 1e-6f);
#pragma unroll
                for (int bj = 0; bj < 2; ++bj)
#pragma unroll
                    for (int n = 0; n < 2; ++n) {
                        const int col = 256 * u.pn + 64 * wc + 32 * bj + 8 * fq + 4 * n;
                        *(f32x4*)(out + (size_t)row * 1024 + col) = acc[ai][bj][m][n] * rinv * gn[bj][n];
                    }
            }
    }
};

template <int MODE>
__device__ __forceinline__ void transpose_item(const float* W, int K, int N, bf16_t* WT, const float* gain, LAS float* scr, int item, int lane) {
    const int nblk = N / 32, kb = item / nblk, nb = item % nblk, k0 = 64 * kb, n0 = 32 * nb;
#pragma unroll 8
    for (int i = 0; i < 32; ++i) { const int kk = 2 * i + (lane >> 5); float w = W[(size_t)(k0 + kk) * N + n0 + (lane & 31)]; if (MODE == 0) w *= gain[k0 + kk]; scr[kk * 33 + (lane & 31)] = w; }
    const int c = lane & 7;
#pragma unroll
    for (int j = 0; j < 4; ++j) { const int n = (lane >> 3) + 8 * j; const LAS float* s = scr + (8 * c) * 33 + n;
        u32x4 o; o.x = pk2(s[0 * 33], s[1 * 33]); o.y = pk2(s[2 * 33], s[3 * 33]); o.z = pk2(s[4 * 33], s[5 * 33]); o.w = pk2(s[6 * 33], s[7 * 33]);
        const int drow = inproj_row(n0 + n);
        *(u32x4*)(WT + (size_t)drow * K + k0 + 8 * c) = o; }
}

__device__ __forceinline__ void ssm_group_prep(const Params& p, int item, LAS float* L) {
    LAS float* lkr = L; LAS float* lki = L + 1088; LAS float* bbr = L + 2176; LAS float* bbi = L + 3200; LAS float* cr = L + 4224; LAS float* ci = L + 5248; LAS float* Kt = L + 6272;
    const int tid = threadIdx.x, g = item >> 3, sub = item & 7;
    const float dt = expf(p.log_dt[g]);
    for (int t = tid; t < 17 * 64; t += 512) {
        const int pp = t & 63, k = t >> 6;
        const float a = p.lam_re[g * 64 + pp] * dt, th = p.lam_im[g * 64 + pp] * dt;
        const float mag = expf((float)k * a); float sn, cs; sincosf((float)k * th, &sn, &cs);
        lkr[k * 64 + pp] = mag * cs; lki[k * 64 + pp] = mag * sn;
    }
    for (int t = tid; t < 1024; t += 512) {
        const int pp = t >> 4, h = t & 15;
        const float lr = p.lam_re[g * 64 + pp], li = p.lam_im[g * 64 + pp];
        const float a = lr * dt, th = li * dt;
        float sn, cs; sincosf(th, &sn, &cs); const float sh = sinf(0.5f * th);
        const float em1 = expm1f(a), ea = em1 + 1.f;
        const float xr = em1 * cs - 2.f * sh * sh, xi = ea * sn;
        const float den = 1.f / (lr * lr + li * li);
        const float cfr = (xr * lr + xi * li) * den, cfi = (xi * lr - xr * li) * den;
        const float br = p.b_re[(g * 64 + pp) * 16 + h], bi = p.b_im[(g * 64 + pp) * 16 + h];
        bbr[pp * 16 + h] = cfr * br - cfi * bi; bbi[pp * 16 + h] = cfr * bi + cfi * br;
        cr[h * 64 + pp] = p.c_re[(g * 16 + h) * 64 + pp]; ci[h * 64 + pp] = p.c_im[(g * 16 + h) * 64 + pp];
    }
    __syncthreads();
    {
        const int k = tid >> 5, hl = (tid >> 4) & 1, h2 = tid & 15, h = 2 * sub + hl;
        float sacc = 0.f;
        for (int pp = 0; pp < 64; ++pp) {
            const float c_r = cr[h * 64 + pp], c_i = ci[h * 64 + pp], l_r = lkr[k * 64 + pp], l_i = lki[k * 64 + pp];
            const float er = c_r * l_r - c_i * l_i, ei = c_r * l_i + c_i * l_r;
            sacc += er * bbr[pp * 16 + h2] - ei * bbi[pp * 16 + h2];
        }
        if (k == 0 && h == h2) sacc += p.d_skip[g * 16 + h];
        Kt[tid] = sacc;
    }
    __syncthreads();
    bf16_t* WCAT = (bf16_t*)(p.ws + WS_WCAT) + (size_t)g * 256 * 384;
    bf16_t* WST = (bf16_t*)(p.ws + WS_WST) + (size_t)g * 256 * 256;
    for (int e = tid; e < 32 * 192; e += 512) {
        const int rl = e / 192, kk = (e - rl * 192) * 2;
        const int t = rl >> 1, hl = rl & 1, h = 2 * sub + hl;
        const int row = 128 * (h >> 3) + 32 * (t >> 2) + 16 * ((h >> 2) & 1) + 4 * (t & 3) + (h & 3);
        float v[2];
#pragma unroll
        for (int q = 0; q < 2; ++q) {
            const int k2 = kk + q;
            if (k2 < 128) { const int pp = k2 & 63; const float c_r = cr[h * 64 + pp], c_i = ci[h * 64 + pp], l_r = lkr[(t + 1) * 64 + pp], l_i = lki[(t + 1) * 64 + pp];
                v[q] = k2 < 64 ? (c_r * l_r - c_i * l_i) : -(c_r * l_i + c_i * l_r); }
            else { const int s2 = (k2 - 128) >> 4, h2 = (k2 - 128) & 15; v[q] = s2 <= t ? Kt[((t - s2) * 2 + hl) * 16 + h2] : 0.f; }
        }
        *(unsigned*)(WCAT + (size_t)row * 384 + kk) = pk2(v[0], v[1]);
    }
    for (int e = tid; e < 32 * 128; e += 512) {
        const int rl = e >> 7, kk = (e & 127) * 2;
        const int row = rl < 16 ? 16 * sub + rl : 128 + 16 * sub + (rl - 16);
        float v[2] = {0.f, 0.f};
        if (row < 128) {
            const int pp = row & 63;
#pragma unroll
            for (int q = 0; q < 2; ++q) { const int s2 = (kk + q) >> 4, h = (kk + q) & 15; const float l_r = lkr[(15 - s2) * 64 + pp], l_i = lki[(15 - s2) * 64 + pp], b_r = bbr[pp * 16 + h], b_i = bbi[pp * 16 + h];
                v[q] = row < 64 ? (l_r * b_r - l_i * b_i) : (l_r * b_i + l_i * b_r); }
        }
        *(unsigned*)(WST + (size_t)row * 256 + kk) = pk2(v[0], v[1]);
    }
    if (sub == 0 && tid < 64) { float* L16 = (float*)(p.ws + WS_LAM16) + (g * 64 + tid) * 2; L16[0] = lkr[16 * 64 + tid]; L16[1] = lki[16 * 64 + tid]; }
    __syncthreads();
}

__device__ __forceinline__ void phase_prep(const Params& p, LAS unsigned char* lds) {
    const int tid = threadIdx.x, lane = tid & 63, wave = tid >> 6, G = 256, bid = blockIdx.x;
    for (int item = bid; item < 256; item += G) ssm_group_prep(p, item, (LAS float*)lds);
    const int gw = bid * 8 + wave, NGW = G * 8;
    {
        bf16_t* XB = (bf16_t*)(p.ws + WS_XB); float* RS = (float*)(p.ws + WS_RS);
        for (int row = gw; row < NTOK; row += NGW) {
            const f32x4* xr = (const f32x4*)(p.x + (size_t)row * DM) + lane;
            f32x4 v[4]; float s = 0.f;
#pragma unroll
            for (int j = 0; j < 4; ++j) { v[j] = xr[64 * j]; s += (v[j][0] * v[j][0] + v[j][1] * v[j][1]) + (v[j][2] * v[j][2] + v[j][3] * v[j][3]); }
            s = wave_sum(s);
            if (lane == 0) RS[row] = 1.0f / sqrtf(s * (1.f / DM) + 1e-6f);
            u32x2* o = (u32x2*)(XB + (size_t)row * DM) + lane;
#pragma unroll
            for (int j = 0; j < 4; ++j) o[64 * j] = (u32x2){pk2(v[j][0], v[j][1]), pk2(v[j][2], v[j][3])};
        }
    }
    {
        LAS float* scr = (LAS float*)(lds + 49152) + wave * (64 * 33);
        constexpr int I_IN = (DM / 64) * (NPROJ / 32), I_OUT = (DM / 64) * (DM / 32), I_GLU = (512 / 64) * (512 / 32);
        for (int it = gw; it < I_IN + I_OUT + I_GLU; it += NGW) {
            int r = it;
            if (r < I_IN) { transpose_item<0>(p.w_in, DM, NPROJ, (bf16_t*)(p.ws + WS_WINT), p.norm_gain, scr, r, lane); continue; } r -= I_IN;
            if (r < I_OUT) { transpose_item<1>(p.w_out, DM, DM, (bf16_t*)(p.ws + WS_WOUTT), nullptr, scr, r, lane); continue; } r -= I_OUT;
            transpose_item<1>(p.w_glu, 512, 512, (bf16_t*)(p.ws + WS_WGLUT), nullptr, scr, r, lane);
        }
    }
    {
        float* COS = (float*)(p.ws + WS_COS); float* SIN = (float*)(p.ws + WS_SIN); float* KSUM = (float*)(p.ws + WS_KSUM);
        for (int i = bid * 512 + tid; i < SEQ * 32; i += G * 512) {
            const int pos = i >> 5, f = i & 31;
            const float inv = 1.0f / powf(10000.0f, (float)f * (1.f / 32.f));
            const float ang = (float)pos * inv; float sn, cs; sincosf(ang, &sn, &cs);
            COS[i] = cs; SIN[i] = sn;
        }
        for (int i = bid * 512 + tid; i < 4096; i += G * 512) KSUM[i] = 0.f;
    }
}

__device__ __forceinline__ int swap23(int r) { return (r & ~12) | ((r & 4) << 1) | ((r & 8) >> 1); }

typedef float f32x2 __attribute__((ext_vector_type(2)));
__device__ __forceinline__ float max3f(float a, float b, float c) { float r; asm("v_max3_f32 %0, %1, %2, %3" : "=v"(r) : "v"(a), "v"(b), "v"(c)); return r; }
template <bool DIAG>
__device__ __forceinline__ void attn_tile(LAS unsigned char* B, unsigned kf_off, unsigned vf_off, const bf16x8 (&qf)[4], f32x16& O0, f32x16& O1, float& mrun, float& lrun,
                                          bool on, int kpos0, int qpos, int hh) {
    constexpr int ROWB = 144;
    const float cinit = on ? -mrun : -1e30f;
    f32x16 st0, st1;
#pragma unroll
    for (int i = 0; i < 16; ++i) { st0[i] = cinit; st1[i] = cinit; }
#pragma unroll
    for (int s = 0; s < 4; ++s) {
        const bf16x8 k0 = *(const LAS bf16x8*)(B + kf_off + s * 32), k1 = *(const LAS bf16x8*)(B + kf_off + 32 * ROWB + s * 32);
        st0 = __builtin_amdgcn_mfma_f32_32x32x16_bf16(k0, qf[s], st0, 0, 0, 0);
        st1 = __builtin_amdgcn_mfma_f32_32x32x16_bf16(k1, qf[s], st1, 0, 0, 0);
    }
    if (DIAG) {
#pragma unroll
        for (int i = 0; i < 16; ++i) {
            const int key = kpos0 + (i & 7) + 8 * hh + 16 * (i >> 3);
            if (key > qpos) st0[i] = -1e30f;
            if (key + 32 > qpos) st1[i] = -1e30f;
        }
    }
    float mx = max3f(st0[0], st0[1], st0[2]);
#pragma unroll
    for (int i = 3; i < 15; i += 2) mx = max3f(mx, st0[i], st0[i + 1]);
    mx = max3f(mx, st0[15], st1[0]);
#pragma unroll
    for (int i = 1; i < 15; i += 2) mx = max3f(mx, st1[i], st1[i + 1]);
    mx = fmaxf(mx, st1[15]);
    mx = fmaxf(mx, __shfl_xor(mx, 32));
    const bool grow = on && (mx > 8.f);
    if (__ballot(grow) != 0ull) {
        const float d = grow ? mx : 0.f;
        const float alpha = __builtin_amdgcn_exp2f(-d);
        lrun *= alpha; mrun += d;
#pragma unroll
        for (int i = 0; i < 16; ++i) { O0[i] *= alpha; O1[i] *= alpha; st0[i] -= d; st1[i] -= d; }
    }
    float rsum = 0.f;
#pragma unroll
    for (int i = 0; i < 16; ++i) { const float p0 = __builtin_amdgcn_exp2f(st0[i]), p1 = __builtin_amdgcn_exp2f(st1[i]); st0[i] = p0; st1[i] = p1; rsum += p0; rsum += p1; }
    rsum += __shfl_xor(rsum, 32);
    lrun += rsum;
#pragma unroll
    for (int s4 = 0; s4 < 4; ++s4) {
        u32x4 t4;
        if (s4 < 2) t4 = (u32x4){pk2(st0[8 * s4], st0[8 * s4 + 1]), pk2(st0[8 * s4 + 2], st0[8 * s4 + 3]), pk2(st0[8 * s4 + 4], st0[8 * s4 + 5]), pk2(st0[8 * s4 + 6], st0[8 * s4 + 7])};
        else { const int s = s4 - 2; t4 = (u32x4){pk2(st1[8 * s], st1[8 * s + 1]), pk2(st1[8 * s + 2], st1[8 * s + 3]), pk2(st1[8 * s + 4], st1[8 * s + 5]), pk2(st1[8 * s + 6], st1[8 * s + 7])}; }
        const bf16x8 pf = __builtin_bit_cast(bf16x8, t4);
        const bf16x8 v0 = *(const LAS bf16x8*)(B + vf_off + s4 * 32), v1 = *(const LAS bf16x8*)(B + vf_off + 32 * ROWB + s4 * 32);
        O0 = __builtin_amdgcn_mfma_f32_32x32x16_bf16(v0, pf, O0, 0, 0, 0);
        O1 = __builtin_amdgcn_mfma_f32_32x32x16_bf16(v1, pf, O1, 0, 0, 0);
    }
}

__device__ __forceinline__ void attn_tile2(LAS unsigned char* BA, LAS unsigned char* BB, unsigned kf_off, unsigned vf_off, const bf16x8 (&qf)[4], f32x16& O0, f32x16& O1, float& mrun, float& lrun, bool on) {
    constexpr int ROWB = 144;
    const float cinit = on ? -mrun : -1e30f;
    f32x16 sa0, sa1, sb0, sb1;
#pragma unroll
    for (int i = 0; i < 16; ++i) { sa0[i] = cinit; sa1[i] = cinit; sb0[i] = cinit; sb1[i] = cinit; }
#pragma unroll
    for (int s = 0; s < 4; ++s) {
        const bf16x8 k0 = *(const LAS bf16x8*)(BA + kf_off + s * 32), k1 = *(const LAS bf16x8*)(BA + kf_off + 32 * ROWB + s * 32);
        const bf16x8 k2 = *(const LAS bf16x8*)(BB + kf_off + s * 32), k3 = *(const LAS bf16x8*)(BB + kf_off + 32 * ROWB + s * 32);
        sa0 = __builtin_amdgcn_mfma_f32_32x32x16_bf16(k0, qf[s], sa0, 0, 0, 0);
        sa1 = __builtin_amdgcn_mfma_f32_32x32x16_bf16(k1, qf[s], sa1, 0, 0, 0);
        sb0 = __builtin_amdgcn_mfma_f32_32x32x16_bf16(k2, qf[s], sb0, 0, 0, 0);
        sb1 = __builtin_amdgcn_mfma_f32_32x32x16_bf16(k3, qf[s], sb1, 0, 0, 0);
    }
    float mx = max3f(sa0[0], sa0[1], sa0[2]), my = max3f(sb0[0], sb0[1], sb0[2]);
#pragma unroll
    for (int i = 3; i < 15; i += 2) { mx = max3f(mx, sa0[i], sa0[i + 1]); my = max3f(my, sb0[i], sb0[i + 1]); }
    mx = max3f(mx, sa0[15], sa1[0]); my = max3f(my, sb0[15], sb1[0]);
#pragma unroll
    for (int i = 1; i < 15; i += 2) { mx = max3f(mx, sa1[i], sa1[i + 1]); my = max3f(my, sb1[i], sb1[i + 1]); }
    mx = max3f(mx, sa1[15], fmaxf(my, sb1[15]));
    mx = fmaxf(mx, __shfl_xor(mx, 32));
    const bool grow = on && (mx > 8.f);
    if (__ballot(grow) != 0ull) {
        const float d = grow ? mx : 0.f;
        const float alpha = __builtin_amdgcn_exp2f(-d);
        lrun *= alpha; mrun += d;
#pragma unroll
        for (int i = 0; i < 16; ++i) { O0[i] *= alpha; O1[i] *= alpha; sa0[i] -= d; sa1[i] -= d; sb0[i] -= d; sb1[i] -= d; }
    }
    float rsum = 0.f;
#define AT2_EXP(S0, S1) _Pragma("unroll") for (int i = 0; i < 16; ++i) { const float p0 = __builtin_amdgcn_exp2f(S0[i]), p1 = __builtin_amdgcn_exp2f(S1[i]); S0[i] = p0; S1[i] = p1; rsum += p0; rsum += p1; }
#define AT2_PV(S0, S1, BUF) _Pragma("unroll") for (int s4 = 0; s4 < 4; ++s4) { \
        u32x4 t4; \
        if (s4 < 2) t4 = (u32x4){pk2(S0[8 * s4], S0[8 * s4 + 1]), pk2(S0[8 * s4 + 2], S0[8 * s4 + 3]), pk2(S0[8 * s4 + 4], S0[8 * s4 + 5]), pk2(S0[8 * s4 + 6], S0[8 * s4 + 7])}; \
        else { const int s_ = s4 - 2; t4 = (u32x4){pk2(S1[8 * s_], S1[8 * s_ + 1]), pk2(S1[8 * s_ + 2], S1[8 * s_ + 3]), pk2(S1[8 * s_ + 4], S1[8 * s_ + 5]), pk2(S1[8 * s_ + 6], S1[8 * s_ + 7])}; } \
        const bf16x8 pf = __builtin_bit_cast(bf16x8, t4); \
        const bf16x8 v0 = *(const LAS bf16x8*)(BUF + vf_off + s4 * 32), v1 = *(const LAS bf16x8*)(BUF + vf_off + 32 * ROWB + s4 * 32); \
        O0 = __builtin_amdgcn_mfma_f32_32x32x16_bf16(v0, pf, O0, 0, 0, 0); \
        O1 = __builtin_amdgcn_mfma_f32_32x32x16_bf16(v1, pf, O1, 0, 0, 0); }
    AT2_EXP(sa0, sa1)
    AT2_PV(sa0, sa1, BA)
    AT2_EXP(sb0, sb1)
    AT2_PV(sb0, sb1, BB)
#undef AT2_EXP
#undef AT2_PV
    rsum += __shfl_xor(rsum, 32);
    lrun += rsum;
}

__device__ __forceinline__ void phase_attn(const Params& p, LAS unsigned char* lds, unsigned* queue) {
    const int tid = threadIdx.x, lane = tid & 63, w = __builtin_amdgcn_readfirstlane(tid >> 6), r = lane & 31, hh = lane >> 5;
    const bf16_t* Qg = (const bf16_t*)(p.ws + WS_Q); const bf16_t* Kg = (const bf16_t*)(p.ws + WS_K); const bf16_t* VTg = (const bf16_t*)(p.ws + WS_VT);
    const bf16_t* SZA = (const bf16_t*)(p.ws + WS_SZA); const float* KSUM = (const float*)(p.ws + WS_KSUM);
    bf16_t* MIXED = (bf16_t*)(p.ws + WS_XB);
    constexpr int ROWB = 144, TILEB = 64 * ROWB, BUFB = 2 * TILEB;
    const int srow = tid >> 3, sch = tid & 7;
    const unsigned st_off = (unsigned)(srow * ROWB + sch * 16);
    const unsigned kf_off = (unsigned)(swap23(r) * ROWB + hh * 16);
    const unsigned vf_off = (unsigned)(TILEB + r * ROWB + hh * 16);
    volatile LAS unsigned* tick = (volatile LAS unsigned*)(lds + 131072 + 8);
    for (;;) {
        if (tid == 0) *tick = __hip_atomic_fetch_add(queue, 1u, __ATOMIC_RELAXED, __HIP_MEMORY_SCOPE_AGENT);
        __syncthreads();
        const int idx = (int)*tick;
        if (idx >= 512) break;
        const int blk = 7 - (idx >> 6), bh = idx & 63, b = bh >> 3, h = bh & 7;
        const int qpos = blk * 256 + w * 32 + r;
        const bf16_t* Qp = Qg + ((size_t)bh * 2048 + qpos) * 64 + 8 * hh;
        bf16x8 qf[4];
#pragma unroll
        for (int s = 0; s < 4; ++s) qf[s] = *(const bf16x8*)(Qp + 16 * s);
        unsigned selmask;
        if (blk <= 3) selmask = (1u << blk) - 1u;
        else {
            float v1 = -3e38f, v2 = -3e38f, v3 = -3e38f; int i1 = 0, i2 = 0, i3 = 0;
#pragma unroll
            for (int j = 0; j < 7; ++j) {
                if (j < blk) {
                    const float* ks = KSUM + ((size_t)bh * 8 + j) * 64 + 8 * hh;
                    float gsum = 0.f;
#pragma unroll
                    for (int s = 0; s < 4; ++s) {
                        const f32x4 k0 = *(const f32x4*)(ks + 16 * s), k1 = *(const f32x4*)(ks + 16 * s + 4);
                        gsum += bf2f((unsigned short)qf[s][0]) * k0[0] + bf2f((unsigned short)qf[s][1]) * k0[1] + bf2f((unsigned short)qf[s][2]) * k0[2] + bf2f((unsigned short)qf[s][3]) * k0[3]
                              + bf2f((unsigned short)qf[s][4]) * k1[0] + bf2f((unsigned short)qf[s][5]) * k1[1] + bf2f((unsigned short)qf[s][6]) * k1[2] + bf2f((unsigned short)qf[s][7]) * k1[3];
                    }
                    gsum += __shfl_xor(gsum, 32);
                    if (gsum > v1) { v3 = v2; i3 = i2; v2 = v1; i2 = i1; v1 = gsum; i1 = j; }
                    else if (gsum > v2) { v3 = v2; i3 = i2; v2 = gsum; i2 = j; }
                    else if (gsum > v3) { v3 = gsum; i3 = j; }
                }
            }
            selmask = (1u << i1) | (1u << i2) | (1u << i3);
        }
        f32x16 O0, O1;
#pragma unroll
        for (int i = 0; i < 16; ++i) { O0[i] = 0.f; O1[i] = 0.f; }
        float mrun = 0.f, lrun = 0.f;
        const int ntile = 4 + 4 * blk;
        const bf16_t* Kst = Kg + ((size_t)bh * 2048 + srow) * 64 + sch * 8;
        const bf16_t* Vst = VTg + ((size_t)bh * 64 + srow) * 2048 + sch * 8;
        u32x4 kreg[2], vreg[2];
#pragma unroll
        for (int q = 0; q < 2; ++q) { const int kp = blk * 256 + 64 * q; kreg[q] = *(const u32x4*)(Kst + (size_t)kp * 64); vreg[q] = *(const u32x4*)(Vst + kp); }
#pragma unroll
        for (int q = 0; q < 2; ++q) { *(LAS u32x4*)(lds + q * BUFB + st_off) = kreg[q]; *(LAS u32x4*)(lds + q * BUFB + TILEB + st_off) = vreg[q]; }
        __syncthreads();
        for (int n = 0; n < ntile; n += 2) {
            if (n + 2 < ntile) {
#pragma unroll
                for (int q = 0; q < 2; ++q) { const int m = n + 2 + q; const int kp = m < 4 ? blk * 256 + 64 * m : ((m - 4) >> 2) * 256 + 64 * ((m - 4) & 3);
                    kreg[q] = *(const u32x4*)(Kst + (size_t)kp * 64); vreg[q] = *(const u32x4*)(Vst + kp); }
            }
            LAS unsigned char* SB = lds + ((n >> 1) & 1) * (2 * BUFB);
            if (n >= 4) {
                const bool on = (selmask >> ((n - 4) >> 2)) & 1u;
                if (__ballot(on) != 0ull) attn_tile2(SB, SB + BUFB, kf_off, vf_off, qf, O0, O1, mrun, lrun, on);
            } else {
#pragma unroll
                for (int q = 0; q < 2; ++q) {
                    const int nn = n + q;
                    const int kpos0 = blk * 256 + 64 * nn;
                    LAS unsigned char* B = SB + q * BUFB;
                    const int dt_ = w >> 1;
                    if (nn == dt_) attn_tile<true>(B, kf_off, vf_off, qf, O0, O1, mrun, lrun, true, kpos0, qpos, hh);
                    else if (nn < dt_) attn_tile<false>(B, kf_off, vf_off, qf, O0, O1, mrun, lrun, true, kpos0, qpos, hh);
                }
            }
            if (n + 2 < ntile) { LAS unsigned char* Bn = lds + (((n >> 1) + 1) & 1) * (2 * BUFB);
#pragma unroll
                for (int q = 0; q < 2; ++q) { *(LAS u32x4*)(Bn + q * BUFB + st_off) = kreg[q]; *(LAS u32x4*)(Bn + q * BUFB + TILEB + st_off) = vreg[q]; } }
            __syncthreads();
        }
        const float inv = 1.f / lrun;
        const size_t row = (size_t)b * 2048 + qpos;
#pragma unroll
        for (int dt = 0; dt < 2; ++dt)
#pragma unroll
            for (int g4 = 0; g4 < 4; ++g4) {
                const int d0 = 32 * dt + 8 * g4 + 4 * hh;
                const u32x2 z2 = *(const u32x2*)(SZA + row * 512 + h * 64 + d0);
                float o0, o1, o2, o3;
                if (dt == 0) { o0 = O0[4 * g4]; o1 = O0[4 * g4 + 1]; o2 = O0[4 * g4 + 2]; o3 = O0[4 * g4 + 3]; }
                else { o0 = O1[4 * g4]; o1 = O1[4 * g4 + 1]; o2 = O1[4 * g4 + 2]; o3 = O1[4 * g4 + 3]; }
                o0 *= inv * bflo(z2[0]); o1 *= inv * bfhi(z2[0]); o2 *= inv * bflo(z2[1]); o3 *= inv * bfhi(z2[1]);
                *(u32x2*)(MIXED + row * 1024 + h * 64 + d0) = (u32x2){pk2(o0, o1), pk2(o2, o3)};
            }
    }
}

__device__ __forceinline__ void scan_unit(const Params& p, LAS unsigned char* lds, int L) {
    const int tid = threadIdx.x, lane = tid & 63, wave = __builtin_amdgcn_readfirstlane(tid >> 6);
    float* SST = (float*)(p.ws + WS_SST); bf16_t* XU = (bf16_t*)(p.ws + WS_XU); const float* L16 = (const float*)(p.ws + WS_LAM16);
    LAS float* E = (LAS float*)lds;
    const int g = L >> 2;
    const float lr = L16[(g * 64 + lane) * 2], li = L16[(g * 64 + lane) * 2 + 1];
    float pr = lr, pi = li;
#pragma unroll
    for (int q = 0; q < 4; ++q) { const float nr = pr * pr - pi * pi, ni = 2.f * pr * pi; pr = nr; pi = ni; }
    for (int bb = 0; bb < 2; ++bb) {
        const size_t base = (size_t)256 * L + 128 * bb + 16 * wave;
        float sr[16], si[16];
#pragma unroll
        for (int c = 0; c < 16; ++c) { sr[c] = __hip_atomic_load(SST + (base + c) * 128 + lane, __ATOMIC_RELAXED, __HIP_MEMORY_SCOPE_AGENT); si[c] = __hip_atomic_load(SST + (base + c) * 128 + 64 + lane, __ATOMIC_RELAXED, __HIP_MEMORY_SCOPE_AGENT); }
        float er = 0.f, ei = 0.f;
#pragma unroll
        for (int c = 0; c < 16; ++c) { const float nr = lr * er - li * ei + sr[c], ni = lr * ei + li * er + si[c]; er = nr; ei = ni; }
        E[(wave * 2) * 64 + lane] = er; E[(wave * 2 + 1) * 64 + lane] = ei;
        __syncthreads();
        float Xr = 0.f, Xi = 0.f;
        for (int s2 = 0; s2 < wave; ++s2) { const float e_r = E[(s2 * 2) * 64 + lane], e_i = E[(s2 * 2 + 1) * 64 + lane]; const float nr = pr * Xr - pi * Xi + e_r, ni = pr * Xi + pi * Xr + e_i; Xr = nr; Xi = ni; }
#pragma unroll
        for (int c = 0; c < 16; ++c) {
            const size_t R = base + c;
            XU[R * 384 + lane] = (bf16_t)(pk2(Xr, 0.f) & 0xffffu); XU[R * 384 + 64 + lane] = (bf16_t)(pk2(Xi, 0.f) & 0xffffu);
            const float nr = lr * Xr - li * Xi + sr[c], ni = lr * Xi + li * Xr + si[c]; Xr = nr; Xi = ni;
        }
        __syncthreads();
    }
}

__device__ __forceinline__ void phase_norm(const Params& p) {
    const int tid = threadIdx.x, lane = tid & 63, wave = tid >> 6, G = gridDim.x;
    const float* SSQ = (const float*)(p.ws + WS_SSQ);
    f32x4 gn[4];
#pragma unroll
    for (int j = 0; j < 4; ++j) gn[j] = *((const f32x4*)p.final_gain + lane + 64 * j);
    for (int row = blockIdx.x * 8 + wave; row < NTOK; row += 8 * G) {
        float s = 0.f;
#pragma unroll
        for (int i = 0; i < 16; ++i) s += SSQ[row * 16 + i];
        const float rinv = 1.0f / sqrtf(s * (1.f / DM) + 1e-6f);
        f32x4* o = (f32x4*)(p.out + (size_t)row * DM) + lane;
#pragma unroll
        for (int j = 0; j < 4; ++j) { f32x4 v = o[64 * j]; v = v * rinv * gn[j]; o[64 * j] = v; }
    }
}

__global__ __launch_bounds__(512, 2) void hymba_fwd(Params p) {
    extern __shared__ __attribute__((aligned(16))) unsigned char shm_raw[];
    LAS unsigned char* lds = (LAS unsigned char*)shm_raw;
    cg::grid_group grid = cg::this_grid();
    constexpr int G = 256;
    const int bid = blockIdx.x;
    unsigned char* ws = p.ws;
#if N_LAUNCH == 1
    constexpr int lo = 0, hi = NPH;
#else
    const int lo = p.ph_lo, hi = p.ph_hi;
#endif
    if (threadIdx.x < 4) ((LAS unsigned*)(lds + 131072))[threadIdx.x] = 0u;
    __syncthreads();
    XcdBarrier xbar = xcd_barrier_post((unsigned*)(ws + WS_BAR), (volatile LAS unsigned*)(lds + 131072));
    if (hi > 1000) grid.sync();
#define IN(k) (PH_ON(k) && lo <= (k) && (k) < hi)
#define SEAM(k) do { if (lo <= (k) && (k) + 1 < hi) xcd_barrier(xbar); } while (0)
    if (IN(0)) { phase_prep(p, lds); }
    SEAM(0);
    if (IN(1)) {
        pg8::Gemm g{(const bf16_t*)(ws + WS_XB), (const bf16_t*)(ws + WS_WINT)};
        pg8::StaticOrder<NTOK, NPROJ> S{bid};
        EpiInProj E{(const float*)(ws + WS_RS), (const float*)(ws + WS_COS), (const float*)(ws + WS_SIN),
                    (bf16_t*)(ws + WS_Q), (bf16_t*)(ws + WS_K), (bf16_t*)(ws + WS_VT), (bf16_t*)(ws + WS_SZA), (bf16_t*)(ws + WS_SZS), (bf16_t*)(ws + WS_XU), (float*)(ws + WS_KSUM)};
        pg8::gemm_phase<DM, DM, DM>(lds, g, S, E);
    }
    SEAM(1);
    if (IN(2)) {
        unsigned* cnt = (unsigned*)(ws + WS_BAR) + XCD_BAR_WORDS;
        if (bid < 128) {
            const int L = bid;
            {
                pg8::Gemm g{(const bf16_t*)(ws + WS_XU) + 128, (const bf16_t*)(ws + WS_WST)};
                pg8::OneUnit S{L, L >> 2};
                EpiS E{(float*)(ws + WS_SST)};
                pg8::gemm_phase<384, 256, 256, false, true, false>(lds, g, S, E);
            }
            asm volatile("s_waitcnt vmcnt(0)" ::: "memory");
            __syncthreads();
            scan_unit(p, lds, L);
            asm volatile("s_waitcnt vmcnt(0)" ::: "memory");
            __syncthreads();
            {
                pg8::Gemm g{(const bf16_t*)(ws + WS_XU), (const bf16_t*)(ws + WS_WCAT)};
                pg8::OneUnit S{L, L >> 2};
                EpiY E{(bf16_t*)(ws + WS_YG)};
                pg8::gemm_phase<384, 384, 384, false, true, false>(lds, g, S, E);
            }
            asm volatile("s_waitcnt vmcnt(0)" ::: "memory");
            __syncthreads();
            if (threadIdx.x == 0) {
                __builtin_amdgcn_fence(__ATOMIC_RELEASE, "agent");
                asm volatile("s_waitcnt vmcnt(0)" ::: "memory");
                __hip_atomic_fetch_add(cnt + 64 * (L & 3), 1u, __ATOMIC_RELAXED, __HIP_MEMORY_SCOPE_AGENT);
            }
        }
        if (bid < 128) {
            const int U = bid;
            const int pm = U >> 1, pn = U & 1;
            if (threadIdx.x == 0) {
                unsigned sp = 0;
                while (__hip_atomic_load(cnt + 64 * (pm >> 4), __ATOMIC_RELAXED, __HIP_MEMORY_SCOPE_AGENT) < 32u) { __builtin_amdgcn_s_sleep(2); if (++sp > (1u << 22)) break; }
                __builtin_amdgcn_fence(__ATOMIC_ACQUIRE, "agent");
                asm volatile("s_waitcnt vmcnt(0)" ::: "memory");
            }
            __syncthreads();
            pg8::Gemm g{(const bf16_t*)(ws + WS_YG), (const bf16_t*)(ws + WS_WGLUT)};
            pg8::OneUnit S{pm, pn};
            EpiGlu E{(const bf16_t*)(ws + WS_YG), (const bf16_t*)(ws + WS_SZS), p.b_glu, (bf16_t*)(ws + WS_XB)};
            pg8::gemm_phase<512, 512, 512, false, true, false>(lds, g, S, E);
        }
        phase_attn(p, lds, cnt + 256);
    }
    SEAM(2);
    if (G == 256) {
        if (IN(6)) {
            pg8::Gemm g{(const bf16_t*)(ws + WS_XB), (const bf16_t*)(ws + WS_WOUTT)};
            pg8::StaticOrder<NTOK, DM> S{bid};
            EpiOutFused E{p.x, p.out, (float*)(ws + WS_SSQ), p.final_gain, xbar};
            pg8::gemm_phase<DM, DM, DM, true, false, true>(lds, g, S, E);
        }
    } else {
        if (IN(6)) {
            pg8::Gemm g{(const bf16_t*)(ws + WS_XB), (const bf16_t*)(ws + WS_WOUTT)};
            pg8::StaticOrder<NTOK, DM> S{bid};
            EpiOut E{p.x, p.out, (float*)(ws + WS_SSQ)};
            pg8::gemm_phase<DM, DM, DM>(lds, g, S, E);
        }
        SEAM(6);
        if (IN(7)) { phase_norm(p); }
    }
#undef IN
#undef SEAM
}

extern "C" void kernel_launch(void* const* d_in, const int* in_sizes, int n_in, void* d_out, int out_size, void* d_ws, size_t ws_size, hipStream_t stream) {
    static int grid = 0;
    if (grid == 0) {
        if (n_in != 15 || in_sizes[0] != NTOK * DM || out_size != NTOK * DM || ws_size < WS_END) { fprintf(stderr, "kernel_launch: unexpected shapes (n_in %d, in0 %d, out %d, ws %zu)\n", n_in, n_in > 0 ? in_sizes[0] : -1, out_size, ws_size); grid = -1; return; }
        int dev = 0, cus = 0, per_cu = 0;
        (void)hipGetDevice(&dev); (void)hipDeviceGetAttribute(&cus, hipDeviceAttributeMultiprocessorCount, dev);
        if (hipFuncSetAttribute((const void*)hymba_fwd, hipFuncAttributeMaxDynamicSharedMemorySize, LDS_BYTES) != hipSuccess) { fprintf(stderr, "kernel_launch: hipFuncSetAttribute failed\n"); grid = -1; return; }
        if (hipOccupancyMaxActiveBlocksPerMultiprocessor(&per_cu, (const void*)hymba_fwd, 512, LDS_BYTES) != hipSuccess || per_cu < 1) { fprintf(stderr, "kernel_launch: occupancy query says %d\n", per_cu); per_cu = 1; }
        (void)hipGetLastError();
        if (cus != 256) { fprintf(stderr, "kernel_launch: built for a 256-CU device (one workgroup per CU), found %d CUs; nothing launched\n", cus); grid = -1; return; }
        grid = 256;
    }
    if (grid < 0) return;
    if (hipMemsetAsync((char*)d_ws + WS_BAR, 0, (XCD_BAR_WORDS + 512) * 4, stream) != hipSuccess) { fprintf(stderr, "kernel_launch: memset of barrier words failed\n"); return; }
    Params p{};
    p.x = (const float*)d_in[0]; p.norm_gain = (const float*)d_in[1]; p.w_in = (const float*)d_in[2]; p.w_out = (const float*)d_in[3];
    p.lam_re = (const float*)d_in[4]; p.lam_im = (const float*)d_in[5]; p.b_re = (const float*)d_in[6]; p.b_im = (const float*)d_in[7];
    p.c_re = (const float*)d_in[8]; p.c_im = (const float*)d_in[9]; p.d_skip = (const float*)d_in[10]; p.log_dt = (const float*)d_in[11];
    p.w_glu = (const float*)d_in[12]; p.b_glu = (const float*)d_in[13]; p.final_gain = (const float*)d_in[14];
    p.out = (float*)d_out; p.ws = (unsigned char*)d_ws;
#if N_LAUNCH == 1
    p.ph_lo = 0; p.ph_hi = NPH;
    void* args[] = {&p};
    hipError_t e = hipLaunchCooperativeKernel((const void*)hymba_fwd, dim3(grid), dim3(512), args, LDS_BYTES, stream);
    if (e != hipSuccess) fprintf(stderr, "cooperative launch failed: %s (grid %d)\n", hipGetErrorString(e), grid);
#else
    for (int ph = 0; ph < NPH; ++ph) {
        p.ph_lo = ph; p.ph_hi = ph + 1;
        hipLaunchKernelGGL(hymba_fwd, dim3(grid), dim3(512), LDS_BYTES, stream, p);
    }
#endif
}
```

```cpp
#include <hip/hip_runtime.h>
#include <hip/hip_cooperative_groups.h>
#include <cstdio>
#include <cstdint>
namespace cg = cooperative_groups;

#ifndef ONLY_PH
#define ONLY_PH -1
#endif
#define PH_ON(x) (ONLY_PH < 0 || ONLY_PH == (x))
#ifndef N_LAUNCH
#define N_LAUNCH 1
#endif

#define LAS __attribute__((address_space(3)))
typedef unsigned short bf16_t;
typedef short bf16x8 __attribute__((ext_vector_type(8)));
typedef float f32x4 __attribute__((ext_vector_type(4)));
typedef float f32x16 __attribute__((ext_vector_type(16)));
typedef unsigned u32x2 __attribute__((ext_vector_type(2)));
typedef unsigned u32x4 __attribute__((ext_vector_type(4)));

constexpr int NTOK = 16384, DM = 1024, SEQ = 2048, NPROJ = 3072;
constexpr int NPH = 8;
constexpr size_t MBy = 1u << 20;
constexpr size_t WS_XB = 0;
constexpr size_t WS_WINT = 32 * MBy;
constexpr size_t WS_WOUTT = 38 * MBy;
constexpr size_t WS_WGLUT = 40 * MBy;
constexpr size_t WS_WST = 41 * MBy;
constexpr size_t WS_WCAT = 45 * MBy;
constexpr size_t WS_LAM16 = 51 * MBy;
constexpr size_t WS_RS = WS_LAM16 + 64 * 1024;
constexpr size_t WS_COS = WS_RS + 64 * 1024;
constexpr size_t WS_SIN = WS_COS + 256 * 1024;
constexpr size_t WS_KSUM = WS_SIN + 256 * 1024;
constexpr size_t WS_Q = 52 * MBy;
constexpr size_t WS_K = 68 * MBy;
constexpr size_t WS_VT = 84 * MBy;
constexpr size_t WS_SZA = 100 * MBy;
constexpr size_t WS_SZS = 116 * MBy;
constexpr size_t WS_XU = 132 * MBy;
constexpr size_t WS_SST = 156 * MBy;
constexpr size_t WS_YG = 172 * MBy;
constexpr size_t WS_SSQ = 188 * MBy;
constexpr size_t WS_BAR = 189 * MBy;
constexpr size_t WS_END = 190 * MBy;
constexpr int LDS_BYTES = 131072 + 16;

struct Params {
    const float *x, *norm_gain, *w_in, *w_out, *lam_re, *lam_im, *b_re, *b_im, *c_re, *c_im, *d_skip, *log_dt, *w_glu, *b_glu, *final_gain;
    float* out; unsigned char* ws;
    int ph_lo, ph_hi;
};

__device__ __forceinline__ unsigned pk2(float lo, float hi) { unsigned r; asm("v_cvt_pk_bf16_f32 %0, %1, %2" : "=v"(r) : "v"(lo), "v"(hi)); return r; }
__device__ __forceinline__ float bf2f(unsigned short b) { return __uint_as_float(((unsigned)b) << 16); }
__device__ __forceinline__ float bflo(unsigned w) { return __uint_as_float(w << 16); }
__device__ __forceinline__ float bfhi(unsigned w) { return __uint_as_float(w & 0xffff0000u); }
__device__ __forceinline__ float wave_sum(float v) {
#pragma unroll
    for (int o = 1; o < 64; o <<= 1) v += __shfl_xor(v, o);
    return v;
}
__device__ __forceinline__ float sigmoidf_(float v) { return __builtin_amdgcn_rcpf(1.f + __expf(-v)); }
__device__ __forceinline__ float siluf_(float v) { return v * sigmoidf_(v); }
__device__ __forceinline__ float gelu_tanh(float y) { const float t = 1.5957691216f * (y + 0.044715f * y * y * y); return y * sigmoidf_(t); }


#define XB_TMO      128
#define XB_XCNT(j)  (256  + 64 * (j))
#define XB_XSUB(j)  (1280 + 64 * (j))
#define XB_XGEN(j)  (2304 + 64 * (j))
#define XB_TOP      3328
#define XB_TOPGEN   3392
#define XCD_BAR_WORDS 3456
#define XB_SPIN_CAP (1u << 18)
__device__ __forceinline__ unsigned xb_ld(unsigned* p)              { return __hip_atomic_load(p, __ATOMIC_RELAXED, __HIP_MEMORY_SCOPE_AGENT); }
__device__ __forceinline__ unsigned xb_add(unsigned* p, unsigned v) { return __hip_atomic_fetch_add(p, v, __ATOMIC_RELAXED, __HIP_MEMORY_SCOPE_AGENT); }
__device__ __forceinline__ unsigned xb_xcc_id() { return (unsigned)__builtin_amdgcn_s_getreg((3 << 11) | 20) & 0xFu; }
#define XB_SPIN(cond, bar) do { unsigned _sp = 0; while (cond) { __builtin_amdgcn_s_sleep(1); \
    if ((++_sp & 255u) == 0u) { if (xb_ld(&(bar)[XB_TMO])) break; if (_sp > XB_SPIN_CAP) { atomicAdd(&(bar)[XB_TMO], 1u); break; } } } } while (0)
struct XcdBarrier { unsigned* bar; unsigned x; volatile LAS unsigned* st; };
__device__ __forceinline__ XcdBarrier xcd_barrier_post(unsigned* bar, volatile LAS unsigned* st) {
    XcdBarrier b; b.bar = bar; b.x = xb_xcc_id(); b.st = st;
    if (threadIdx.x == 0) (void)xb_add(&bar[XB_XCNT(b.x)], 1u);
    return b;
}
__device__ __forceinline__ void xcd_barrier_complete(unsigned* bar, unsigned x, unsigned& nloc, unsigned& nx) {
    const unsigned G = 256u;
    unsigned sum, cnt, mine, sp = 0u;
    for (;;) {
        sum = 0u; cnt = 0u; mine = 0u;
#pragma unroll
        for (unsigned j = 0; j < 16; ++j) { const unsigned c = xb_ld(&bar[XB_XCNT(j)]); sum += c; cnt += (c > 0u) ? 1u : 0u; mine = (j == x) ? c : mine; }
        if (sum == G) break;
        __builtin_amdgcn_s_sleep(1);
        if ((++sp & 255u) == 0u) { if (xb_ld(&bar[XB_TMO])) break; if (sp > XB_SPIN_CAP) { atomicAdd(&bar[XB_TMO], 1u); break; } }
    }
    nloc = mine > 0u ? mine : 1u; nx = cnt > 0u ? cnt : 1u;
}
__device__ __forceinline__ void xcd_barrier(const XcdBarrier& b) {
    asm volatile("s_waitcnt vmcnt(0)" ::: "memory");
    __syncthreads();
    if (threadIdx.x == 0) {
        unsigned* bar = b.bar;
        __builtin_amdgcn_s_waitcnt(0);
        unsigned nloc = b.st[0], nx = b.st[1];
        if (nloc == 0u) { xcd_barrier_complete(bar, b.x, nloc, nx); b.st[0] = nloc; b.st[1] = nx; }
        const unsigned old = xb_add(&bar[XB_XSUB(b.x)], 1u);
        const unsigned gen = old / nloc;
        if (old + 1u == (gen + 1u) * nloc) {
            __builtin_amdgcn_fence(__ATOMIC_RELEASE, "agent");
            asm volatile("s_waitcnt vmcnt(0)" ::: "memory");
            const unsigned og = xb_add(&bar[XB_TOP], 1u);
            const unsigned tg = og / nx;
            if (og + 1u == (tg + 1u) * nx) xb_add(&bar[XB_TOPGEN], 1u);
            else XB_SPIN(xb_ld(&bar[XB_TOPGEN]) == tg, bar);
            __builtin_amdgcn_fence(__ATOMIC_ACQUIRE, "agent");
            xb_add(&bar[XB_XGEN(b.x)], 1u);
            asm volatile("s_waitcnt vmcnt(0)" ::: "memory");
        } else {
            XB_SPIN(xb_ld(&bar[XB_XGEN(b.x)]) == gen, bar);
            __builtin_amdgcn_fence(__ATOMIC_ACQUIRE, "agent");
            asm volatile("s_waitcnt vmcnt(0)" ::: "memory");
        }
    }
    __syncthreads();
}

namespace pg8 {
constexpr int BM = 256, BK = 64, HALF = 128, HTB = HALF * BK * 2, STAGE_BYTES = 8 * HTB, NXCD = 8, WGM = 8;
__device__ __forceinline__ int lds_byte(int r, int c) { const int st = (r >> 4) * 2 + (c >> 5), rr = r & 15, cc = c & 31, ob = rr * 64 + cc * 2; return st * 1024 + (ob ^ (((ob >> 9) & 1) << 5)); }
__device__ __forceinline__ void stage_rc(int b, int& R, int& C) { const int st = b / 1024, sb = b % 1024, swz = sb ^ (((sb >> 9) & 1) << 5); R = (st >> 1) * 16 + swz / 64; C = (st & 1) * 32 + (swz % 64) / 2; }
struct Unit { int pm, pn; };
struct Gemm { const bf16_t* A; const bf16_t* Bt; };

template <int M, int N>
struct StaticOrder {
    static constexpr int nM = M / BM, nN = N / BM, nwg = nM * nN, G = 256;
    int c;
    __device__ bool next(int i, Unit& u) const {
        const int L = i * G + c; if (L >= nwg) return false;
        int wgid = L; { constexpr int q = nwg / NXCD, r = nwg % NXCD; const int xcd = wgid % NXCD, off = wgid / NXCD; wgid = (xcd < r ? xcd * (q + 1) : r * (q + 1) + (xcd - r) * q) + off; }
        constexpr int nig = WGM * nN; const int gid = wgid / nig, fm = gid * WGM, gsz = (nM - fm) < WGM ? (nM - fm) : WGM;
        u.pm = fm + ((wgid % nig) % gsz); u.pn = (wgid % nig) / gsz; return true;
    }
};
struct GroupOrder {
    int G, c;
    __device__ bool next(int i, Unit& u) const { const int L = i * G + c; if (L >= 128) return false; u.pm = L; u.pn = L >> 2; return true; }
};

struct OneUnit {
    int pm, pn;
    __device__ bool next(int i, Unit& u) const { if (i) return false; u.pm = pm; u.pn = pn; return true; }
};

template <int LDA, int LDB, int KK, bool AFTER = false, bool ALIGN_EPI = true, bool SP2 = true, class Epi, class Sched>
__device__ __forceinline__ void gemm_phase(LAS unsigned char* lds, const Gemm g, const Sched& S, const Epi& E) {
    const int tid = threadIdx.x, wid = __builtin_amdgcn_readfirstlane(tid >> 6), lane = tid & 63, wr = wid >> 2, wc = wid & 3, fr = lane & 15, fq = lane >> 4;
    constexpr int K = KK, nt = K / BK;
    unsigned voffA[2], voffB[2];
#pragma unroll
    for (int i = 0; i < 2; ++i) { int R, C; stage_rc(tid * 16 + i * 8192, R, C); voffA[i] = (unsigned)(R * LDA + C) * 2u; voffB[i] = (unsigned)(R * LDB + C) * 2u; }
    constexpr size_t kstep = (size_t)(BK * 2);
    constexpr size_t hstepA = (size_t)HALF * LDA * 2, hstepB = (size_t)HALF * LDB * 2;
    constexpr size_t tstepA = 2 * hstepA, tstepB = 2 * hstepB;
    const unsigned ldsw = (unsigned)wid * 1024u;
    const int aoff = lds_byte(wr * 64 + fr, fq * 8), boff = lds_byte(wc * 32 + fr, fq * 8);
#define PG8_SA(b, h) (((b) * 2 + (h)) * HTB)
#define PG8_SB(b, h) ((4 + (b) * 2 + (h)) * HTB)
#define PG8_STAGE(bufoff, gbase, voff) do { _Pragma("unroll") for (int _i = 0; _i < 2; ++_i) \
        __builtin_amdgcn_global_load_lds((const unsigned*)((const char*)(gbase) + (voff)[_i]), (LAS unsigned*)(lds + (bufoff) + ldsw + _i * 8192), 16, 0, 0); } while (0)
#define PG8_LDA(dst, b, h) do { _Pragma("unroll") for (int m = 0; m < 4; ++m) _Pragma("unroll") for (int k = 0; k < 2; ++k) dst[m][k] = *(const LAS bf16x8*)(lds + PG8_SA(b, h) + aoff + m * 2048 + k * 1024); } while (0)
#define PG8_LDB(dst, b, h) do { _Pragma("unroll") for (int n = 0; n < 2; ++n) _Pragma("unroll") for (int k = 0; k < 2; ++k) dst[n][k] = *(const LAS bf16x8*)(lds + PG8_SB(b, h) + boff + n * 2048 + k * 1024); } while (0)
#define PG8_MMA(ai, bj, At, Bt) do { __builtin_amdgcn_s_setprio(1); _Pragma("unroll") for (int m = 0; m < 4; ++m) _Pragma("unroll") for (int n = 0; n < 2; ++n) _Pragma("unroll") for (int k = 0; k < 2; ++k) \
        acc[ai][bj][m][n] = __builtin_amdgcn_mfma_f32_16x16x32_bf16(Bt[n][k], At[m][k], acc[ai][bj][m][n], 0, 0, 0); __builtin_amdgcn_s_setprio(0); } while (0)
#define PG8_WAIT_V(n) asm volatile("s_waitcnt vmcnt(" #n ")" ::: "memory")
#define PG8_WAIT_L(n) asm volatile("s_waitcnt lgkmcnt(" #n ")" ::: "memory")
#define PG8_BAR __builtin_amdgcn_s_barrier()
#define PG8_SCHED __builtin_amdgcn_sched_barrier(0)
    Unit cur, nxt; int ui = 0;
    if (!S.next(0, cur)) return;
    f32x4 acc[2][2][4][2];
#pragma unroll
    for (int a = 0; a < 2; ++a)
#pragma unroll
        for (int b = 0; b < 2; ++b)
#pragma unroll
            for (int m = 0; m < 4; ++m)
#pragma unroll
                for (int n = 0; n < 2; ++n) acc[a][b][m][n] = (f32x4){0.f, 0.f, 0.f, 0.f};
    bf16x8 At[4][2], B0[2][2], B1[2][2];
    const char* cA = (const char*)g.A + (size_t)cur.pm * tstepA; const char* cB = (const char*)g.Bt + (size_t)cur.pn * tstepB;
    if constexpr (SP2) {
        PG8_STAGE(PG8_SB(0, 0), cB, voffB); PG8_STAGE(PG8_SB(0, 1), cB + hstepB, voffB); PG8_STAGE(PG8_SA(0, 0), cA, voffA); PG8_STAGE(PG8_SA(0, 1), cA + hstepA, voffA);
        if (wr == 1) PG8_BAR;
        PG8_WAIT_V(2); PG8_BAR;
        PG8_STAGE(PG8_SB(1, 0), cB + kstep, voffB); PG8_STAGE(PG8_SA(1, 0), cA + kstep, voffA); PG8_STAGE(PG8_SB(1, 1), cB + hstepB + kstep, voffB);
        PG8_WAIT_V(6); PG8_BAR;
    } else {
        PG8_STAGE(PG8_SB(0, 0), cB, voffB); PG8_STAGE(PG8_SA(0, 0), cA, voffA); PG8_STAGE(PG8_SB(0, 1), cB + hstepB, voffB); PG8_STAGE(PG8_SA(0, 1), cA + hstepA, voffA);
        if (wr == 1) PG8_BAR;
        PG8_WAIT_V(4); PG8_BAR;
        PG8_STAGE(PG8_SB(1, 0), cB + kstep, voffB); PG8_STAGE(PG8_SA(1, 0), cA + kstep, voffA); PG8_STAGE(PG8_SB(1, 1), cB + hstepB + kstep, voffB);
        PG8_WAIT_V(6); PG8_BAR;
    }
    for (;;) {
        const bool has_next = S.next(ui + 1, nxt);
        const char* nA = has_next ? (const char*)g.A + (size_t)nxt.pm * tstepA : cA; const char* nB = has_next ? (const char*)g.Bt + (size_t)nxt.pn * tstepB : cB;
        for (int t = 0; t < nt; t += 2) {
            const bool last = (t == nt - 2);
            const char* a1 = cA + (size_t)(t + 1) * kstep;
            const char* a2 = last ? nA : cA + (size_t)(t + 2) * kstep; const char* b2 = last ? nB : cB + (size_t)(t + 2) * kstep;
            const char* a3 = a2 + kstep; const char* b3 = b2 + kstep;
            if constexpr (SP2) {
            PG8_LDB(B0, 0, 0); PG8_LDB(B1, 0, 1); PG8_SCHED; PG8_LDA(At, 0, 0); PG8_STAGE(PG8_SA(1, 1), a1 + hstepA, voffA);
            PG8_WAIT_V(8); PG8_WAIT_L(0); PG8_BAR; PG8_MMA(0, 0, At, B0); PG8_MMA(0, 1, At, B1); PG8_BAR; PG8_SCHED;
            PG8_LDA(At, 0, 1); PG8_STAGE(PG8_SB(0, 0), b2, voffB); PG8_STAGE(PG8_SB(0, 1), b2 + hstepB, voffB); PG8_STAGE(PG8_SA(0, 0), a2, voffA);
            PG8_WAIT_V(8); PG8_WAIT_L(0); PG8_BAR; PG8_MMA(1, 0, At, B0); PG8_MMA(1, 1, At, B1); PG8_BAR; PG8_SCHED;
            PG8_LDB(B0, 1, 0); PG8_LDB(B1, 1, 1); PG8_SCHED; PG8_LDA(At, 1, 0); PG8_STAGE(PG8_SA(0, 1), a2 + hstepA, voffA);
            PG8_WAIT_V(8); PG8_WAIT_L(0); PG8_BAR; PG8_MMA(0, 0, At, B0); PG8_MMA(0, 1, At, B1); PG8_BAR; PG8_SCHED;
            PG8_LDA(At, 1, 1); PG8_STAGE(PG8_SB(1, 0), b3, voffB); PG8_STAGE(PG8_SB(1, 1), b3 + hstepB, voffB); PG8_STAGE(PG8_SA(1, 0), a3, voffA);
            PG8_WAIT_V(8); PG8_WAIT_L(0); PG8_BAR; PG8_MMA(1, 0, At, B0); PG8_MMA(1, 1, At, B1); PG8_BAR; PG8_SCHED;
            } else {
            PG8_LDB(B0, 0, 0); PG8_SCHED; PG8_LDA(At, 0, 0); PG8_STAGE(PG8_SA(1, 1), a1 + hstepA, voffA);
            PG8_WAIT_L(8); PG8_BAR; PG8_WAIT_L(0); PG8_MMA(0, 0, At, B0); PG8_BAR; PG8_SCHED;
            PG8_LDB(B1, 0, 1); PG8_STAGE(PG8_SB(0, 0), b2, voffB);
            PG8_BAR; PG8_WAIT_L(0); PG8_MMA(0, 1, At, B1); PG8_BAR;
            PG8_LDA(At, 0, 1); PG8_STAGE(PG8_SA(0, 0), a2, voffA);
            PG8_BAR; PG8_WAIT_L(0); PG8_MMA(1, 0, At, B0); PG8_BAR; PG8_SCHED;
            PG8_STAGE(PG8_SB(0, 1), b2 + hstepB, voffB);
            PG8_WAIT_V(6); PG8_BAR; PG8_MMA(1, 1, At, B1); PG8_BAR;
            PG8_LDB(B0, 1, 0); PG8_SCHED; PG8_LDA(At, 1, 0); PG8_STAGE(PG8_SA(0, 1), a2 + hstepA, voffA);
            PG8_WAIT_L(8); PG8_BAR; PG8_WAIT_L(0); PG8_MMA(0, 0, At, B0); PG8_BAR; PG8_SCHED;
            PG8_LDB(B1, 1, 1); PG8_STAGE(PG8_SB(1, 0), b3, voffB);
            PG8_BAR; PG8_WAIT_L(0); PG8_MMA(0, 1, At, B1); PG8_BAR;
            PG8_LDA(At, 1, 1); PG8_STAGE(PG8_SA(1, 0), a3, voffA);
            PG8_BAR; PG8_WAIT_L(0); PG8_MMA(1, 0, At, B0); PG8_BAR; PG8_SCHED;
            PG8_STAGE(PG8_SB(1, 1), b3 + hstepB, voffB);
            PG8_WAIT_V(6); PG8_BAR; PG8_MMA(1, 1, At, B1); PG8_BAR;
                    }
        }
        if constexpr (ALIGN_EPI) { if (wr == 0) PG8_BAR; }
        E(acc, cur, wr, wc, fr, fq);
        if (!has_next) break;
#pragma unroll
        for (int a = 0; a < 2; ++a)
#pragma unroll
            for (int b = 0; b < 2; ++b)
#pragma unroll
                for (int m = 0; m < 4; ++m)
#pragma unroll
                    for (int n = 0; n < 2; ++n) acc[a][b][m][n] = (f32x4){0.f, 0.f, 0.f, 0.f};
        cur = nxt; cA = nA; cB = nB; ++ui;
        if constexpr (ALIGN_EPI) { if (wr == 1) PG8_BAR; }
    }
    PG8_WAIT_V(0);
    if constexpr (!ALIGN_EPI) { if (wr == 0) PG8_BAR; }
    PG8_BAR;
    if constexpr (AFTER) E.after(acc, cur, wr, wc, fr, fq);
#undef PG8_SA
#undef PG8_SB
#undef PG8_STAGE
#undef PG8_LDA
#undef PG8_LDB
#undef PG8_MMA
#undef PG8_WAIT_V
#undef PG8_WAIT_L
#undef PG8_BAR
#undef PG8_SCHED
}
}
using pg8::Unit;


__device__ __forceinline__ int inproj_row(int e) {
    const int pn = e >> 8, o = e & 255;
    const int wc = o >> 6, bj = (o >> 5) & 1, fq = (o >> 3) & 3, n = (o >> 2) & 1, i = o & 3;
    return 256 * pn + 128 * bj + 32 * wc + 16 * n + 4 * fq + i;
}

struct EpiInProj {
    const float *rs, *cosT, *sinT;
    bf16_t *Q, *Kk, *VT, *SZA, *SZS, *XU; float* KSUM;
    __device__ __forceinline__ void operator()(const f32x4 (&acc)[2][2][4][2], const Unit& u, int wr, int wc, int fr, int fq) const {
        const int seg = u.pn >> 1, half = u.pn & 1;
        const int b = u.pm >> 3, blk = u.pm & 7;
        const int lbase = blk * 256 + wr * 64 + fr;
        if (seg <= 1) {
            bf16_t* dst = seg == 0 ? Q : Kk; const float qs = seg == 0 ? 0.18033688011112042f : 1.0f;
            const int head = 4 * half + wc;
            f32x4 cl[2], ch[2];
#pragma unroll
            for (int n = 0; n < 2; ++n) { cl[n] = (f32x4){0.f, 0.f, 0.f, 0.f}; ch[n] = (f32x4){0.f, 0.f, 0.f, 0.f}; }
            bf16_t* obase = dst + ((size_t)((b * 8 + head) * 2048)) * 64 + 8 * fq;
#pragma unroll
            for (int ai = 0; ai < 2; ++ai)
#pragma unroll
                for (int m = 0; m < 4; ++m) {
                    const int l = lbase + 128 * ai + 16 * m; const float rsv = rs[b * 2048 + l] * qs;
                    unsigned wl[4], wh[4];
#pragma unroll
                    for (int n = 0; n < 2; ++n) {
                        const f32x4 c4 = *(const f32x4*)(cosT + l * 32 + 8 * fq + 4 * n), s4 = *(const f32x4*)(sinT + l * 32 + 8 * fq + 4 * n);
                        const f32x4 t1 = acc[ai][0][m][n] * rsv, t2 = acc[ai][1][m][n] * rsv;
                        const f32x4 lo = t1 * c4 - t2 * s4, hi = t2 * c4 + t1 * s4;
                        wl[2 * n] = pk2(lo[0], lo[1]); wl[2 * n + 1] = pk2(lo[2], lo[3]); wh[2 * n] = pk2(hi[0], hi[1]); wh[2 * n + 1] = pk2(hi[2], hi[3]);
                        cl[n] += lo; ch[n] += hi;
                    }
                    bf16_t* o = obase + (unsigned)l * 64u;
                    *(u32x4*)o = (u32x4){wl[0], wl[1], wl[2], wl[3]};
                    *(u32x4*)(o + 32) = (u32x4){wh[0], wh[1], wh[2], wh[3]};
                }
            if (seg == 1) {
#pragma unroll
                for (int n = 0; n < 2; ++n)
#pragma unroll
                    for (int i = 0; i < 4; ++i) {
                        float v = cl[n][i], v2 = ch[n][i];
                        v += __shfl_xor(v, 1); v += __shfl_xor(v, 2); v += __shfl_xor(v, 4); v += __shfl_xor(v, 8);
                        v2 += __shfl_xor(v2, 1); v2 += __shfl_xor(v2, 2); v2 += __shfl_xor(v2, 4); v2 += __shfl_xor(v2, 8);
                        if (fr == 0) { float* kp = KSUM + ((b * 8 + head) * 8 + blk) * 64 + 8 * fq + 4 * n + i; atomicAdd(kp, v); atomicAdd(kp + 32, v2); }
                    }
            }
        } else if (seg == 2) {
            const int head = 4 * half + wc;
#pragma unroll
            for (int ai = 0; ai < 2; ++ai)
#pragma unroll
                for (int m = 0; m < 4; ++m) {
                    const int l = lbase + 128 * ai + 16 * m; const float rsv = rs[b * 2048 + l];
#pragma unroll
                    for (int bj = 0; bj < 2; ++bj)
#pragma unroll
                        for (int n = 0; n < 2; ++n) {
                            const int d0 = 32 * bj + 8 * fq + 4 * n;
                            const f32x4 v = acc[ai][bj][m][n] * rsv;
                            bf16_t* o = VT + ((size_t)((b * 8 + head) * 64 + d0)) * 2048 + l;
                            const unsigned p0 = pk2(v[0], v[1]), p1 = pk2(v[2], v[3]);
                            o[0] = (bf16_t)(p0 & 0xffffu); o[2048] = (bf16_t)(p0 >> 16); o[4096] = (bf16_t)(p1 & 0xffffu); o[6144] = (bf16_t)(p1 >> 16);
                        }
                }
        } else if (seg == 4) {
#pragma unroll
            for (int ai = 0; ai < 2; ++ai)
#pragma unroll
                for (int m = 0; m < 4; ++m) {
                    const int l = lbase + 128 * ai + 16 * m; const float rsv = rs[b * 2048 + l];
                    const int c = l >> 4, t = l & 15;
#pragma unroll
                    for (int bj = 0; bj < 2; ++bj) {
                        const int g = 16 * half + 4 * wc + 2 * bj + (fq >> 1);
                        const f32x4 v0 = acc[ai][bj][m][0] * rsv, v1 = acc[ai][bj][m][1] * rsv;
                        bf16_t* o = XU + ((size_t)(1024 * g + b * 128 + c)) * 384 + 128 + t * 16 + 8 * (fq & 1);
                        *(u32x4*)o = (u32x4){pk2(v0[0], v0[1]), pk2(v0[2], v0[3]), pk2(v1[0], v1[1]), pk2(v1[2], v1[3])};
                    }
                }
        } else {
            bf16_t* dst = seg == 3 ? SZA : SZS;
#pragma unroll
            for (int ai = 0; ai < 2; ++ai)
#pragma unroll
                for (int m = 0; m < 4; ++m) {
                    const int l = lbase + 128 * ai + 16 * m; const int row = b * 2048 + l; const float rsv = rs[row];
#pragma unroll
                    for (int bj = 0; bj < 2; ++bj) {
                        const int col = 256 * half + 64 * wc + 32 * bj + 8 * fq;
                        const f32x4 v0 = acc[ai][bj][m][0] * rsv, v1 = acc[ai][bj][m][1] * rsv;
                        *(u32x4*)(dst + (size_t)row * 512 + col) = (u32x4){pk2(siluf_(v0[0]), siluf_(v0[1])), pk2(siluf_(v0[2]), siluf_(v0[3])), pk2(siluf_(v1[0]), siluf_(v1[1])), pk2(siluf_(v1[2]), siluf_(v1[3]))};
                    }
                }
        }
    }
};

struct EpiS {
    float* SST;
    __device__ __forceinline__ void operator()(const f32x4 (&acc)[2][2][4][2], const Unit& u, int wr, int wc, int fr, int fq) const {
#pragma unroll
        for (int ai = 0; ai < 2; ++ai)
#pragma unroll
            for (int m = 0; m < 4; ++m) {
                const int R = 256 * u.pm + 128 * ai + 64 * wr + 16 * m + fr;
#pragma unroll
                for (int n = 0; n < 2; ++n) *(f32x4*)(SST + (size_t)R * 128 + 32 * wc + 16 * n + 4 * fq) = acc[ai][0][m][n];
            }
    }
};

struct EpiY {
    bf16_t* YG;
    __device__ __forceinline__ void operator()(const f32x4 (&acc)[2][2][4][2], const Unit& u, int wr, int wc, int fr, int fq) const {
        const int g = u.pn, t = 4 * wc + fq;
#pragma unroll
        for (int ai = 0; ai < 2; ++ai)
#pragma unroll
            for (int m = 0; m < 4; ++m) {
                const int rr = 256 * (u.pm & 3) + 128 * ai + 64 * wr + 16 * m + fr;
                const int b = rr >> 7, c = rr & 127; const int token = b * 2048 + 16 * c + t;
                bf16_t* ob = YG + (size_t)token * 512 + 16 * g;
#pragma unroll
                for (int bj = 0; bj < 2; ++bj) {
                    const f32x4 v0 = acc[ai][bj][m][0], v1 = acc[ai][bj][m][1];
                    *(u32x4*)(ob + 8 * bj) = (u32x4){pk2(gelu_tanh(v0[0]), gelu_tanh(v0[1])), pk2(gelu_tanh(v0[2]), gelu_tanh(v0[3])), pk2(gelu_tanh(v1[0]), gelu_tanh(v1[1])), pk2(gelu_tanh(v1[2]), gelu_tanh(v1[3]))};
                }
            }
    }
};

struct EpiGlu {
    const bf16_t *YG, *SZS; const float* bglu; bf16_t* MIXED;
    __device__ __forceinline__ void operator()(const f32x4 (&acc)[2][2][4][2], const Unit& u, int wr, int wc, int fr, int fq) const {
        f32x4 bias[2][2];
#pragma unroll
        for (int bj = 0; bj < 2; ++bj)
#pragma unroll
            for (int n = 0; n < 2; ++n) bias[bj][n] = *(const f32x4*)(bglu + 256 * u.pn + 64 * wc + 32 * bj + 8 * fq + 4 * n);
#pragma unroll
        for (int ai = 0; ai < 2; ++ai) {
            u32x4 y4[4][2], z4[4][2];
#pragma unroll
            for (int m = 0; m < 4; ++m) {
                const int row = 256 * u.pm + 128 * ai + 64 * wr + 16 * m + fr;
#pragma unroll
                for (int bj = 0; bj < 2; ++bj) {
                    const unsigned off = (unsigned)row * 512u + (unsigned)(256 * u.pn + 64 * wc + 32 * bj + 8 * fq);
                    y4[m][bj] = *(const u32x4*)(YG + off); z4[m][bj] = *(const u32x4*)(SZS + off);
                }
            }
#pragma unroll
            for (int m = 0; m < 4; ++m) {
                const int row = 256 * u.pm + 128 * ai + 64 * wr + 16 * m + fr;
#pragma unroll
                for (int bj = 0; bj < 2; ++bj) {
                    const int col = 256 * u.pn + 64 * wc + 32 * bj + 8 * fq;
                    unsigned w[4];
#pragma unroll
                    for (int n = 0; n < 2; ++n) {
                        const f32x4 a = acc[ai][bj][m][n] + bias[bj][n];
                        const unsigned ya = y4[m][bj][2 * n], yb = y4[m][bj][2 * n + 1], za = z4[m][bj][2 * n], zb = z4[m][bj][2 * n + 1];
                        const float o0 = bflo(ya) * sigmoidf_(a[0]) * bflo(za), o1 = bfhi(ya) * sigmoidf_(a[1]) * bfhi(za);
                        const float o2 = bflo(yb) * sigmoidf_(a[2]) * bflo(zb), o3 = bfhi(yb) * sigmoidf_(a[3]) * bfhi(zb);
                        w[2 * n] = pk2(o0, o1); w[2 * n + 1] = pk2(o2, o3);
                    }
                    *(u32x4*)(MIXED + (size_t)row * 1024 + 512 + col) = (u32x4){w[0], w[1], w[2], w[3]};
                }
            }
        }
    }
};

struct EpiOut {
    const float* x; float* out; float* SSQ;
    __device__ __forceinline__ void operator()(const f32x4 (&acc)[2][2][4][2], const Unit& u, int wr, int wc, int fr, int fq) const {
#pragma unroll
        for (int ai = 0; ai < 2; ++ai) {
            f32x4 xv[4][2][2];
#pragma unroll
            for (int m = 0; m < 4; ++m) {
                const int row = 256 * u.pm + 128 * ai + 64 * wr + 16 * m + fr;
#pragma unroll
                for (int bj = 0; bj < 2; ++bj)
#pragma unroll
                    for (int n = 0; n < 2; ++n) xv[m][bj][n] = *(const f32x4*)(x + (size_t)row * 1024 + 256 * u.pn + 64 * wc + 32 * bj + 8 * fq + 4 * n);
            }
#pragma unroll
            for (int m = 0; m < 4; ++m) {
                const int row = 256 * u.pm + 128 * ai + 64 * wr + 16 * m + fr;
                float ss = 0.f;
#pragma unroll
                for (int bj = 0; bj < 2; ++bj)
#pragma unroll
                    for (int n = 0; n < 2; ++n) {
                        const int col = 256 * u.pn + 64 * wc + 32 * bj + 8 * fq + 4 * n;
                        const f32x4 v = acc[ai][bj][m][n] + xv[m][bj][n];
                        *(f32x4*)(out + (size_t)row * 1024 + col) = v;
                        ss += (v[0] * v[0] + v[1] * v[1]) + (v[2] * v[2] + v[3] * v[3]);
                    }
                ss += __shfl_xor(ss, 16); ss += __shfl_xor(ss, 32);
                if (fq == 0) SSQ[row * 16 + 4 * u.pn + wc] = ss;
            }
        }
    }
};

struct EpiOutFused {
    const float* x; float* out; float* SSQ; const float* gain; XcdBarrier xbar;
    __device__ __forceinline__ void operator()(f32x4 (&acc)[2][2][4][2], const Unit& u, int wr, int wc, int fr, int fq) const {
#pragma unroll
        for (int ai = 0; ai < 2; ++ai) {
            f32x4 xv[4][2][2];
#pragma unroll
            for (int m = 0; m < 4; ++m) {
                const int row = 256 * u.pm + 128 * ai + 64 * wr + 16 * m + fr;
#pragma unroll
                for (int bj = 0; bj < 2; ++bj)
#pragma unroll
                    for (int n = 0; n < 2; ++n) xv[m][bj][n] = *(const f32x4*)(x + (size_t)row * 1024 + 256 * u.pn + 64 * wc + 32 * bj + 8 * fq + 4 * n);
            }
#pragma unroll
            for (int m = 0; m < 4; ++m) {
                const int row = 256 * u.pm + 128 * ai + 64 * wr + 16 * m + fr;
                float ss = 0.f;
#pragma unroll
                for (int bj = 0; bj < 2; ++bj)
#pragma unroll
                    for (int n = 0; n < 2; ++n) {
                        const f32x4 v = acc[ai][bj][m][n] + xv[m][bj][n];
                        acc[ai][bj][m][n] = v;
                        ss += (v[0] * v[0] + v[1] * v[1]) + (v[2] * v[2] + v[3] * v[3]);
                    }
                ss += __shfl_xor(ss, 16); ss += __shfl_xor(ss, 32);
                if (fq == 0) SSQ[row * 16 + 4 * u.pn + wc] = ss;
            }
        }
    }
    __device__ __forceinline__ void after(f32x4 (&acc)[2][2][4][2], const Unit& u, int wr, int wc, int fr, int fq) const {
        xcd_barrier(xbar);
        f32x4 gn[2][2];
#pragma unroll
        for (int bj = 0; bj < 2; ++bj)
#pragma unroll
            for (int n = 0; n < 2; ++n) gn[bj][n] = *(const f32x4*)(gain + 256 * u.pn + 64 * wc + 32 * bj + 8 * fq + 4 * n);
#pragma unroll
        for (int ai = 0; ai < 2; ++ai)
#pragma unroll
            for (int m = 0; m < 4; ++m) {
                const int row = 256 * u.pm + 128 * ai + 64 * wr + 16 * m + fr;
                const f32x4* sp = (const f32x4*)(SSQ + row * 16);
                const f32x4 s0 = sp[0], s1 = sp[1], s2 = sp[2], s3 = sp[3];
                const float tot = ((s0[0] + s0[1]) + (s0[2] + s0[3])) + ((s1[0] + s1[1]) + (s1[2] + s1[3])) + ((s2[0] + s2[1]) + (s2[2] + s2[3])) + ((s3[0] + s3[1]) + (s3[2] + s3[3]));
                const float rinv = 1.0f / sqrtf(tot * (1.f / DM) + 1e-6f);
#pragma unroll
                for (int bj = 0; bj < 2; ++bj)
#pragma unroll
                    for (int n = 0; n < 2; ++n) {
                        const int col = 256 * u.pn + 64 * wc + 32 * bj + 8 * fq + 4 * n;
                        *(f32x4*)(out + (size_t)row * 1024 + col) = acc[ai][bj][m][n] * rinv * gn[bj][n];
                    }
            }
    }
};

template <int MODE>
__device__ __forceinline__ void transpose_item(const float* W, int K, int N, bf16_t* WT, const float* gain, LAS float* scr, int item, int lane) {
    const int nblk = N / 32, kb = item / nblk, nb = item % nblk, k0 = 64 * kb, n0 = 32 * nb;
#pragma unroll 8
    for (int i = 0; i < 32; ++i) { const int kk = 2 * i + (lane >> 5); float w = W[(size_t)(k0 + kk) * N + n0 + (lane & 31)]; if (MODE == 0) w *= gain[k0 + kk]; scr[kk * 33 + (lane & 31)] = w; }
    const int c = lane & 7;
#pragma unroll
    for (int j = 0; j < 4; ++j) { const int n = (lane >> 3) + 8 * j; const LAS float* s = scr + (8 * c) * 33 + n;
        u32x4 o; o.x = pk2(s[0 * 33], s[1 * 33]); o.y = pk2(s[2 * 33], s[3 * 33]); o.z = pk2(s[4 * 33], s[5 * 33]); o.w = pk2(s[6 * 33], s[7 * 33]);
        const int drow = inproj_row(n0 + n);
        *(u32x4*)(WT + (size_t)drow * K + k0 + 8 * c) = o; }
}

__device__ __forceinline__ void ssm_group_prep(const Params& p, int item, LAS float* L) {
    LAS float* lkr = L; LAS float* lki = L + 1088; LAS float* bbr = L + 2176; LAS float* bbi = L + 3200; LAS float* cr = L + 4224; LAS float* ci = L + 5248; LAS float* Kt = L + 6272;
    const int tid = threadIdx.x, g = item >> 3, sub = item & 7;
    const float dt = expf(p.log_dt[g]);
    for (int t = tid; t < 17 * 64; t += 512) {
        const int pp = t & 63, k = t >> 6;
        const float a = p.lam_re[g * 64 + pp] * dt, th = p.lam_im[g * 64 + pp] * dt;
        const float mag = expf((float)k * a); float sn, cs; sincosf((float)k * th, &sn, &cs);
        lkr[k * 64 + pp] = mag * cs; lki[k * 64 + pp] = mag * sn;
    }
    for (int t = tid; t < 1024; t += 512) {
        const int pp = t >> 4, h = t & 15;
        const float lr = p.lam_re[g * 64 + pp], li = p.lam_im[g * 64 + pp];
        const float a = lr * dt, th = li * dt;
        float sn, cs; sincosf(th, &sn, &cs); const float sh = sinf(0.5f * th);
        const float em1 = expm1f(a), ea = em1 + 1.f;
        const float xr = em1 * cs - 2.f * sh * sh, xi = ea * sn;
        const float den = 1.f / (lr * lr + li * li);
        const float cfr = (xr * lr + xi * li) * den, cfi = (xi * lr - xr * li) * den;
        const float br = p.b_re[(g * 64 + pp) * 16 + h], bi = p.b_im[(g * 64 + pp) * 16 + h];
        bbr[pp * 16 + h] = cfr * br - cfi * bi; bbi[pp * 16 + h] = cfr * bi + cfi * br;
        cr[h * 64 + pp] = p.c_re[(g * 16 + h) * 64 + pp]; ci[h * 64 + pp] = p.c_im[(g * 16 + h) * 64 + pp];
    }
    __syncthreads();
    {
        const int k = tid >> 5, hl = (tid >> 4) & 1, h2 = tid & 15, h = 2 * sub + hl;
        float sacc = 0.f;
        for (int pp = 0; pp < 64; ++pp) {
            const float c_r = cr[h * 64 + pp], c_i = ci[h * 64 + pp], l_r = lkr[k * 64 + pp], l_i = lki[k * 64 + pp];
            const float er = c_r * l_r - c_i * l_i, ei = c_r * l_i + c_i * l_r;
            sacc += er * bbr[pp * 16 + h2] - ei * bbi[pp * 16 + h2];
        }
        if (k == 0 && h == h2) sacc += p.d_skip[g * 16 + h];
        Kt[tid] = sacc;
    }
    __syncthreads();
    bf16_t* WCAT = (bf16_t*)(p.ws + WS_WCAT) + (size_t)g * 256 * 384;
    bf16_t* WST = (bf16_t*)(p.ws + WS_WST) + (size_t)g * 256 * 256;
    for (int e = tid; e < 32 * 192; e += 512) {
        const int rl = e / 192, kk = (e - rl * 192) * 2;
        const int t = rl >> 1, hl = rl & 1, h = 2 * sub + hl;
        const int row = 128 * (h >> 3) + 32 * (t >> 2) + 16 * ((h >> 2) & 1) + 4 * (t & 3) + (h & 3);
        float v[2];
#pragma unroll
        for (int q = 0; q < 2; ++q) {
            const int k2 = kk + q;
            if (k2 < 128) { const int pp = k2 & 63; const float c_r = cr[h * 64 + pp], c_i = ci[h * 64 + pp], l_r = lkr[(t + 1) * 64 + pp], l_i = lki[(t + 1) * 64 + pp];
                v[q] = k2 < 64 ? (c_r * l_r - c_i * l_i) : -(c_r * l_i + c_i * l_r); }
            else { const int s2 = (k2 - 128) >> 4, h2 = (k2 - 128) & 15; v[q] = s2 <= t ? Kt[((t - s2) * 2 + hl) * 16 + h2] : 0.f; }
        }
        *(unsigned*)(WCAT + (size_t)row * 384 + kk) = pk2(v[0], v[1]);
    }
    for (int e = tid; e < 32 * 128; e += 512) {
        const int rl = e >> 7, kk = (e & 127) * 2;
        const int row = rl < 16 ? 16 * sub + rl : 128 + 16 * sub + (rl - 16);
        float v[2] = {0.f, 0.f};
        if (row < 128) {
            const int pp = row & 63;
#pragma unroll
            for (int q = 0; q < 2; ++q) { const int s2 = (kk + q) >> 4, h = (kk + q) & 15; const float l_r = lkr[(15 - s2) * 64 + pp], l_i = lki[(15 - s2) * 64 + pp], b_r = bbr[pp * 16 + h], b_i = bbi[pp * 16 + h];
                v[q] = row < 64 ? (l_r * b_r - l_i * b_i) : (l_r * b_i + l_i * b_r); }
        }
        *(unsigned*)(WST + (size_t)row * 256 + kk) = pk2(v[0], v[1]);
    }
    if (sub == 0 && tid < 64) { float* L16 = (float*)(p.ws + WS_LAM16) + (g * 64 + tid) * 2; L16[0] = lkr[16 * 64 + tid]; L16[1] = lki[16 * 64 + tid]; }
    __syncthreads();
}

__device__ __forceinline__ void phase_prep(const Params& p, LAS unsigned char* lds) {
    const int tid = threadIdx.x, lane = tid & 63, wave = tid >> 6, G = 256, bid = blockIdx.x;
    for (int item = bid; item < 256; item += G) ssm_group_prep(p, item, (LAS float*)lds);
    const int gw = bid * 8 + wave, NGW = G * 8;
    {
        bf16_t* XB = (bf16_t*)(p.ws + WS_XB); float* RS = (float*)(p.ws + WS_RS);
        for (int row = gw; row < NTOK; row += NGW) {
            const f32x4* xr = (const f32x4*)(p.x + (size_t)row * DM) + lane;
            f32x4 v[4]; float s = 0.f;
#pragma unroll
            for (int j = 0; j < 4; ++j) { v[j] = xr[64 * j]; s += (v[j][0] * v[j][0] + v[j][1] * v[j][1]) + (v[j][2] * v[j][2] + v[j][3] * v[j][3]); }
            s = wave_sum(s);
            if (lane == 0) RS[row] = 1.0f / sqrtf(s * (1.f / DM) + 1e-6f);
            u32x2* o = (u32x2*)(XB + (size_t)row * DM) + lane;
#pragma unroll
            for (int j = 0; j < 4; ++j) o[64 * j] = (u32x2){pk2(v[j][0], v[j][1]), pk2(v[j][2], v[j][3])};
        }
    }
    {
        LAS float* scr = (LAS float*)(lds + 49152) + wave * (64 * 33);
        constexpr int I_IN = (DM / 64) * (NPROJ / 32), I_OUT = (DM / 64) * (DM / 32), I_GLU = (512 / 64) * (512 / 32);
        for (int it = gw; it < I_IN + I_OUT + I_GLU; it += NGW) {
            int r = it;
            if (r < I_IN) { transpose_item<0>(p.w_in, DM, NPROJ, (bf16_t*)(p.ws + WS_WINT), p.norm_gain, scr, r, lane); continue; } r -= I_IN;
            if (r < I_OUT) { transpose_item<1>(p.w_out, DM, DM, (bf16_t*)(p.ws + WS_WOUTT), nullptr, scr, r, lane); continue; } r -= I_OUT;
            transpose_item<1>(p.w_glu, 512, 512, (bf16_t*)(p.ws + WS_WGLUT), nullptr, scr, r, lane);
        }
    }
    {
        float* COS = (float*)(p.ws + WS_COS); float* SIN = (float*)(p.ws + WS_SIN); float* KSUM = (float*)(p.ws + WS_KSUM);
        for (int i = bid * 512 + tid; i < SEQ * 32; i += G * 512) {
            const int pos = i >> 5, f = i & 31;
            const float inv = 1.0f / powf(10000.0f, (float)f * (1.f / 32.f));
            const float ang = (float)pos * inv; float sn, cs; sincosf(ang, &sn, &cs);
            COS[i] = cs; SIN[i] = sn;
        }
        for (int i = bid * 512 + tid; i < 4096; i += G * 512) KSUM[i] = 0.f;
    }
}

__device__ __forceinline__ int swap23(int r) { return (r & ~12) | ((r & 4) << 1) | ((r & 8) >> 1); }

typedef float f32x2 __attribute__((ext_vector_type(2)));
__device__ __forceinline__ float max3f(float a, float b, float c) { float r; asm("v_max3_f32 %0, %1, %2, %3" : "=v"(r) : "v"(a), "v"(b), "v"(c)); return r; }
template <bool DIAG>
__device__ __forceinline__ void attn_tile(LAS unsigned char* B, unsigned kf_off, unsigned vf_off, const bf16x8 (&qf)[4], f32x16& O0, f32x16& O1, float& mrun, float& lrun,
                                          bool on, int kpos0, int qpos, int hh) {
    constexpr int ROWB = 144;
    const float cinit = on ? -mrun : -1e30f;
    f32x16 st0, st1;
#pragma unroll
    for (int i = 0; i < 16; ++i) { st0[i] = cinit; st1[i] = cinit; }
#pragma unroll
    for (int s = 0; s < 4; ++s) {
        const bf16x8 k0 = *(const LAS bf16x8*)(B + kf_off + s * 32), k1 = *(const LAS bf16x8*)(B + kf_off + 32 * ROWB + s * 32);
        st0 = __builtin_amdgcn_mfma_f32_32x32x16_bf16(k0, qf[s], st0, 0, 0, 0);
        st1 = __builtin_amdgcn_mfma_f32_32x32x16_bf16(k1, qf[s], st1, 0, 0, 0);
    }
    if (DIAG) {
#pragma unroll
        for (int i = 0; i < 16; ++i) {
            const int key = kpos0 + (i & 7) + 8 * hh + 16 * (i >> 3);
            if (key > qpos) st0[i] = -1e30f;
            if (key + 32 > qpos) st1[i] = -1e30f;
        }
    }
    float mx = max3f(st0[0], st0[1], st0[2]);
#pragma unroll
    for (int i = 3; i < 15; i += 2) mx = max3f(mx, st0[i], st0[i + 1]);
    mx = max3f(mx, st0[15], st1[0]);
#pragma unroll
    for (int i = 1; i < 15; i += 2) mx = max3f(mx, st1[i], st1[i + 1]);
    mx = fmaxf(mx, st1[15]);
    mx = fmaxf(mx, __shfl_xor(mx, 32));
    const bool grow = on && (mx > 8.f);
    if (__ballot(grow) != 0ull) {
        const float d = grow ? mx : 0.f;
        const float alpha = __builtin_amdgcn_exp2f(-d);
        lrun *= alpha; mrun += d;
#pragma unroll
        for (int i = 0; i < 16; ++i) { O0[i] *= alpha; O1[i] *= alpha; st0[i] -= d; st1[i] -= d; }
    }
    float rsum = 0.f;
#pragma unroll
    for (int i = 0; i < 16; ++i) { const float p0 = __builtin_amdgcn_exp2f(st0[i]), p1 = __builtin_amdgcn_exp2f(st1[i]); st0[i] = p0; st1[i] = p1; rsum += p0; rsum += p1; }
    rsum += __shfl_xor(rsum, 32);
    lrun += rsum;
#pragma unroll
    for (int s4 = 0; s4 < 4; ++s4) {
        u32x4 t4;
        if (s4 < 2) t4 = (u32x4){pk2(st0[8 * s4], st0[8 * s4 + 1]), pk2(st0[8 * s4 + 2], st0[8 * s4 + 3]), pk2(st0[8 * s4 + 4], st0[8 * s4 + 5]), pk2(st0[8 * s4 + 6], st0[8 * s4 + 7])};
        else { const int s = s4 - 2; t4 = (u32x4){pk2(st1[8 * s], st1[8 * s + 1]), pk2(st1[8 * s + 2], st1[8 * s + 3]), pk2(st1[8 * s + 4], st1[8 * s + 5]), pk2(st1[8 * s + 6], st1[8 * s + 7])}; }
        const bf16x8 pf = __builtin_bit_cast(bf16x8, t4);
        const bf16x8 v0 = *(const LAS bf16x8*)(B + vf_off + s4 * 32), v1 = *(const LAS bf16x8*)(B + vf_off + 32 * ROWB + s4 * 32);
        O0 = __builtin_amdgcn_mfma_f32_32x32x16_bf16(v0, pf, O0, 0, 0, 0);
        O1 = __builtin_amdgcn_mfma_f32_32x32x16_bf16(v1, pf, O1, 0, 0, 0);
    }
}

__device__ __forceinline__ void attn_tile2(LAS unsigned char* BA, LAS unsigned char* BB, unsigned kf_off, unsigned vf_off, const bf16x8 (&qf)[4], f32x16& O0, f32x16& O1, float& mrun, float& lrun, bool on) {
    constexpr int ROWB = 144;
    const float cinit = on ? -mrun : -1e30f;
    f32x16 sa0, sa1, sb0, sb1;
#pragma unroll
    for (int i = 0; i < 16; ++i) { sa0[i] = cinit; sa1[i] = cinit; sb0[i] = cinit; sb1[i] = cinit; }
#pragma unroll
    for (int s = 0; s < 4; ++s) {
        const bf16x8 k0 = *(const LAS bf16x8*)(BA + kf_off + s * 32), k1 = *(const LAS bf16x8*)(BA + kf_off + 32 * ROWB + s * 32);
        const bf16x8 k2 = *(const LAS bf16x8*)(BB + kf_off + s * 32), k3 = *(const LAS bf16x8*)(BB + kf_off + 32 * ROWB + s * 32);
        sa0 = __builtin_amdgcn_mfma_f32_32x32x16_bf16(k0, qf[s], sa0, 0, 0, 0);
        sa1 = __builtin_amdgcn_mfma_f32_32x32x16_bf16(k1, qf[s], sa1, 0, 0, 0);
        sb0 = __builtin_amdgcn_mfma_f32_32x32x16_bf16(k2, qf[s], sb0, 0, 0, 0);
        sb1 = __builtin_amdgcn_mfma_f32_32x32x16_bf16(k3, qf[s], sb1, 0, 0, 0);
    }
    float mx = max3f(sa0[0], sa0[1], sa0[2]), my = max3f(sb0[0], sb0[1], sb0[2]);
#pragma unroll
    for (int i = 3; i < 15; i += 2) { mx = max3f(mx, sa0[i], sa0[i + 1]); my = max3f(my, sb0[i], sb0[i + 1]); }
    mx = max3f(mx, sa0[15], sa1[0]); my = max3f(my, sb0[15], sb1[0]);
#pragma unroll
    for (int i = 1; i < 15; i += 2) { mx = max3f(mx, sa1[i], sa1[i + 1]); my = max3f(my, sb1[i], sb1[i + 1]); }
    mx = max3f(mx, sa1[15], fmaxf(my, sb1[15]));
    mx = fmaxf(mx, __shfl_xor(mx, 32));
    const bool grow = on && (mx > 8.f);
    if (__ballot(grow) != 0ull) {
        const float d = grow ? mx : 0.f;
        const float alpha = __builtin_amdgcn_exp2f(-d);
        lrun *= alpha; mrun += d;
#pragma unroll
        for (int i = 0; i < 16; ++i) { O0[i] *= alpha; O1[i] *= alpha; sa0[i] -= d; sa1[i] -= d; sb0[i] -= d; sb1[i] -= d; }
    }
    float rsum = 0.f;
#define AT2_EXP(S0, S1) _Pragma("unroll") for (int i = 0; i < 16; ++i) { const float p0 = __builtin_amdgcn_exp2f(S0[i]), p1 = __builtin_amdgcn_exp2f(S1[i]); S0[i] = p0; S1[i] = p1; rsum += p0; rsum += p1; }
#define AT2_PV(S0, S1, BUF) _Pragma("unroll") for (int s4 = 0; s4 < 4; ++s4) { \
        u32x4 t4; \
        if (s4 < 2) t4 = (u32x4){pk2(S0[8 * s4], S0[8 * s4 + 1]), pk2(S0[8 * s4 + 2], S0[8 * s4 + 3]), pk2(S0[8 * s4 + 4], S0[8 * s4 + 5]), pk2(S0[8 * s4 + 6], S0[8 * s4 + 7])}; \
        else { const int s_ = s4 - 2; t4 = (u32x4){pk2(S1[8 * s_], S1[8 * s_ + 1]), pk2(S1[8 * s_ + 2], S1[8 * s_ + 3]), pk2(S1[8 * s_ + 4], S1[8 * s_ + 5]), pk2(S1[8 * s_ + 6], S1[8 * s_ + 7])}; } \
        const bf16x8 pf = __builtin_bit_cast(bf16x8, t4); \
        const bf16x8 v0 = *(const LAS bf16x8*)(BUF + vf_off + s4 * 32), v1 = *(const LAS bf16x8*)(BUF + vf_off + 32 * ROWB + s4 * 32); \
        O0 = __builtin_amdgcn_mfma_f32_32x32x16_bf16(v0, pf, O0, 0, 0, 0); \
        O1 = __builtin_amdgcn_mfma_f32_32x32x16_bf16(v1, pf, O1, 0, 0, 0); }
    AT2_EXP(sa0, sa1)
    AT2_PV(sa0, sa1, BA)
    AT2_EXP(sb0, sb1)
    AT2_PV(sb0, sb1, BB)
#undef AT2_EXP
#undef AT2_PV
    rsum += __shfl_xor(rsum, 32);
    lrun += rsum;
}

__device__ __forceinline__ void phase_attn(const Params& p, LAS unsigned char* lds, unsigned* queue) {
    const int tid = threadIdx.x, lane = tid & 63, w = __builtin_amdgcn_readfirstlane(tid >> 6), r = lane & 31, hh = lane >> 5;
    const bf16_t* Qg = (const bf16_t*)(p.ws + WS_Q); const bf16_t* Kg = (const bf16_t*)(p.ws + WS_K); const bf16_t* VTg = (const bf16_t*)(p.ws + WS_VT);
    const bf16_t* SZA = (const bf16_t*)(p.ws + WS_SZA); const float* KSUM = (const float*)(p.ws + WS_KSUM);
    bf16_t* MIXED = (bf16_t*)(p.ws + WS_XB);
    constexpr int ROWB = 144, TILEB = 64 * ROWB, BUFB = 2 * TILEB;
    const int srow = tid >> 3, sch = tid & 7;
    const unsigned st_off = (unsigned)(srow * ROWB + sch * 16);
    const unsigned kf_off = (unsigned)(swap23(r) * ROWB + hh * 16);
    const unsigned vf_off = (unsigned)(TILEB + r * ROWB + hh * 16);
    volatile LAS unsigned* tick = (volatile LAS unsigned*)(lds + 131072 + 8);
    for (;;) {
        if (tid == 0) *tick = __hip_atomic_fetch_add(queue, 1u, __ATOMIC_RELAXED, __HIP_MEMORY_SCOPE_AGENT);
        __syncthreads();
        const int idx = (int)*tick;
        if (idx >= 512) break;
        const int blk = 7 - (idx >> 6), bh = idx & 63, b = bh >> 3, h = bh & 7;
        const int qpos = blk * 256 + w * 32 + r;
        const bf16_t* Qp = Qg + ((size_t)bh * 2048 + qpos) * 64 + 8 * hh;
        bf16x8 qf[4];
#pragma unroll
        for (int s = 0; s < 4; ++s) qf[s] = *(const bf16x8*)(Qp + 16 * s);
        unsigned selmask;
        if (blk <= 3) selmask = (1u << blk) - 1u;
        else {
            float v1 = -3e38f, v2 = -3e38f, v3 = -3e38f; int i1 = 0, i2 = 0, i3 = 0;
#pragma unroll
            for (int j = 0; j < 7; ++j) {
                if (j < blk) {
                    const float* ks = KSUM + ((size_t)bh * 8 + j) * 64 + 8 * hh;
                    float gsum = 0.f;
#pragma unroll
                    for (int s = 0; s < 4; ++s) {
                        const f32x4 k0 = *(const f32x4*)(ks + 16 * s), k1 = *(const f32x4*)(ks + 16 * s + 4);
                        gsum += bf2f((unsigned short)qf[s][0]) * k0[0] + bf2f((unsigned short)qf[s][1]) * k0[1] + bf2f((unsigned short)qf[s][2]) * k0[2] + bf2f((unsigned short)qf[s][3]) * k0[3]
                              + bf2f((unsigned short)qf[s][4]) * k1[0] + bf2f((unsigned short)qf[s][5]) * k1[1] + bf2f((unsigned short)qf[s][6]) * k1[2] + bf2f((unsigned short)qf[s][7]) * k1[3];
                    }
                    gsum += __shfl_xor(gsum, 32);
                    if (gsum > v1) { v3 = v2; i3 = i2; v2 = v1; i2 = i1; v1 = gsum; i1 = j; }
                    else if (gsum > v2) { v3 = v2; i3 = i2; v2 = gsum; i2 = j; }
                    else if (gsum > v3) { v3 = gsum; i3 = j; }
                }
            }
            selmask = (1u << i1) | (1u << i2) | (1u << i3);
        }
        f32x16 O0, O1;
#pragma unroll
        for (int i = 0; i < 16; ++i) { O0[i] = 0.f; O1[i] = 0.f; }
        float mrun = 0.f, lrun = 0.f;
        const int ntile = 4 + 4 * blk;
        const bf16_t* Kst = Kg + ((size_t)bh * 2048 + srow) * 64 + sch * 8;
        const bf16_t* Vst = VTg + ((size_t)bh * 64 + srow) * 2048 + sch * 8;
        u32x4 kreg[2], vreg[2];
#pragma unroll
        for (int q = 0; q < 2; ++q) { const int kp = blk * 256 + 64 * q; kreg[q] = *(const u32x4*)(Kst + (size_t)kp * 64); vreg[q] = *(const u32x4*)(Vst + kp); }
#pragma unroll
        for (int q = 0; q < 2; ++q) { *(LAS u32x4*)(lds + q * BUFB + st_off) = kreg[q]; *(LAS u32x4*)(lds + q * BUFB + TILEB + st_off) = vreg[q]; }
        __syncthreads();
        for (int n = 0; n < ntile; n += 2) {
            if (n + 2 < ntile) {
#pragma unroll
                for (int q = 0; q < 2; ++q) { const int m = n + 2 + q; const int kp = m < 4 ? blk * 256 + 64 * m : ((m - 4) >> 2) * 256 + 64 * ((m - 4) & 3);
                    kreg[q] = *(const u32x4*)(Kst + (size_t)kp * 64); vreg[q] = *(const u32x4*)(Vst + kp); }
            }
            LAS unsigned char* SB = lds + ((n >> 1) & 1) * (2 * BUFB);
            if (n >= 4) {
                const bool on = (selmask >> ((n - 4) >> 2)) & 1u;
                if (__ballot(on) != 0ull) attn_tile2(SB, SB + BUFB, kf_off, vf_off, qf, O0, O1, mrun, lrun, on);
            } else {
#pragma unroll
                for (int q = 0; q < 2; ++q) {
                    const int nn = n + q;
                    const int kpos0 = blk * 256 + 64 * nn;
                    LAS unsigned char* B = SB + q * BUFB;
                    const int dt_ = w >> 1;
                    if (nn == dt_) attn_tile<true>(B, kf_off, vf_off, qf, O0, O1, mrun, lrun, true, kpos0, qpos, hh);
                    else if (nn < dt_) attn_tile<false>(B, kf_off, vf_off, qf, O0, O1, mrun, lrun, true, kpos0, qpos, hh);
                }
            }
            if (n + 2 < ntile) { LAS unsigned char* Bn = lds + (((n >> 1) + 1) & 1) * (2 * BUFB);
#pragma unroll
                for (int q = 0; q < 2; ++q) { *(LAS u32x4*)(Bn + q * BUFB + st_off) = kreg[q]; *(LAS u32x4*)(Bn + q * BUFB + TILEB + st_off) = vreg[q]; } }
            __syncthreads();
        }
        const float inv = 1.f / lrun;
        const size_t row = (size_t)b * 2048 + qpos;
#pragma unroll
        for (int dt = 0; dt < 2; ++dt)
#pragma unroll
            for (int g4 = 0; g4 < 4; ++g4) {
                const int d0 = 32 * dt + 8 * g4 + 4 * hh;
                const u32x2 z2 = *(const u32x2*)(SZA + row * 512 + h * 64 + d0);
                float o0, o1, o2, o3;
                if (dt == 0) { o0 = O0[4 * g4]; o1 = O0[4 * g4 + 1]; o2 = O0[4 * g4 + 2]; o3 = O0[4 * g4 + 3]; }
                else { o0 = O1[4 * g4]; o1 = O1[4 * g4 + 1]; o2 = O1[4 * g4 + 2]; o3 = O1[4 * g4 + 3]; }
                o0 *= inv * bflo(z2[0]); o1 *= inv * bfhi(z2[0]); o2 *= inv * bflo(z2[1]); o3 *= inv * bfhi(z2[1]);
                *(u32x2*)(MIXED + row * 1024 + h * 64 + d0) = (u32x2){pk2(o0, o1), pk2(o2, o3)};
            }
    }
}

__device__ __forceinline__ void scan_unit(const Params& p, LAS unsigned char* lds, int L) {
    const int tid = threadIdx.x, lane = tid & 63, wave = __builtin_amdgcn_readfirstlane(tid >> 6);
    float* SST = (float*)(p.ws + WS_SST); bf16_t* XU = (bf16_t*)(p.ws + WS_XU); const float* L16 = (const float*)(p.ws + WS_LAM16);
    LAS float* E = (LAS float*)lds;
    const int g = L >> 2;
    const float lr = L16[(g * 64 + lane) * 2], li = L16[(g * 64 + lane) * 2 + 1];
    float pr = lr, pi = li;
#pragma unroll
    for (int q = 0; q < 4; ++q) { const float nr = pr * pr - pi * pi, ni = 2.f * pr * pi; pr = nr; pi = ni; }
    for (int bb = 0; bb < 2; ++bb) {
        const size_t base = (size_t)256 * L + 128 * bb + 16 * wave;
        float sr[16], si[16];
#pragma unroll
        for (int c = 0; c < 16; ++c) { sr[c] = __hip_atomic_load(SST + (base + c) * 128 + lane, __ATOMIC_RELAXED, __HIP_MEMORY_SCOPE_AGENT); si[c] = __hip_atomic_load(SST + (base + c) * 128 + 64 + lane, __ATOMIC_RELAXED, __HIP_MEMORY_SCOPE_AGENT); }
        float er = 0.f, ei = 0.f;
#pragma unroll
        for (int c = 0; c < 16; ++c) { const float nr = lr * er - li * ei + sr[c], ni = lr * ei + li * er + si[c]; er = nr; ei = ni; }
        E[(wave * 2) * 64 + lane] = er; E[(wave * 2 + 1) * 64 + lane] = ei;
        __syncthreads();
        float Xr = 0.f, Xi = 0.f;
        for (int s2 = 0; s2 < wave; ++s2) { const float e_r = E[(s2 * 2) * 64 + lane], e_i = E[(s2 * 2 + 1) * 64 + lane]; const float nr = pr * Xr - pi * Xi + e_r, ni = pr * Xi + pi * Xr + e_i; Xr = nr; Xi = ni; }
#pragma unroll
        for (int c = 0; c < 16; ++c) {
            const size_t R = base + c;
            XU[R * 384 + lane] = (bf16_t)(pk2(Xr, 0.f) & 0xffffu); XU[R * 384 + 64 + lane] = (bf16_t)(pk2(Xi, 0.f) & 0xffffu);
            const float nr = lr * Xr - li * Xi + sr[c], ni = lr * Xi + li * Xr + si[c]; Xr = nr; Xi = ni;
        }
        __syncthreads();
    }
}

__device__ __forceinline__ void phase_norm(const Params& p) {
    const int tid = threadIdx.x, lane = tid & 63, wave = tid >> 6, G = gridDim.x;
    const float* SSQ = (const float*)(p.ws + WS_SSQ);
    f32x4 gn[4];
#pragma unroll
    for (int j = 0; j < 4; ++j) gn[j] = *((const f32x4*)p.final_gain + lane + 64 * j);
    for (int row = blockIdx.x * 8 + wave; row < NTOK; row += 8 * G) {
        float s = 0.f;
#pragma unroll
        for (int i = 0; i < 16; ++i) s += SSQ[row * 16 + i];
        const float rinv = 1.0f / sqrtf(s * (1.f / DM) + 1e-6f);
        f32x4* o = (f32x4*)(p.out + (size_t)row * DM) + lane;
#pragma unroll
        for (int j = 0; j < 4; ++j) { f32x4 v = o[64 * j]; v = v * rinv * gn[j]; o[64 * j] = v; }
    }
}

__global__ __launch_bounds__(512, 2) void hymba_fwd(Params p) {
    extern __shared__ __attribute__((aligned(16))) unsigned char shm_raw[];
    LAS unsigned char* lds = (LAS unsigned char*)shm_raw;
    cg::grid_group grid = cg::this_grid();
    constexpr int G = 256;
    const int bid = blockIdx.x;
    unsigned char* ws = p.ws;
#if N_LAUNCH == 1
    constexpr int lo = 0, hi = NPH;
#else
    const int lo = p.ph_lo, hi = p.ph_hi;
#endif
    if (threadIdx.x < 4) ((LAS unsigned*)(lds + 131072))[threadIdx.x] = 0u;
    __syncthreads();
    XcdBarrier xbar = xcd_barrier_post((unsigned*)(ws + WS_BAR), (volatile LAS unsigned*)(lds + 131072));
    if (hi > 1000) grid.sync();
#define IN(k) (PH_ON(k) && lo <= (k) && (k) < hi)
#define SEAM(k) do { if (lo <= (k) && (k) + 1 < hi) xcd_barrier(xbar); } while (0)
    if (IN(0)) { phase_prep(p, lds); }
    SEAM(0);
    if (IN(1)) {
        pg8::Gemm g{(const bf16_t*)(ws + WS_XB), (const bf16_t*)(ws + WS_WINT)};
        pg8::StaticOrder<NTOK, NPROJ> S{bid};
        EpiInProj E{(const float*)(ws + WS_RS), (const float*)(ws + WS_COS), (const float*)(ws + WS_SIN),
                    (bf16_t*)(ws + WS_Q), (bf16_t*)(ws + WS_K), (bf16_t*)(ws + WS_VT), (bf16_t*)(ws + WS_SZA), (bf16_t*)(ws + WS_SZS), (bf16_t*)(ws + WS_XU), (float*)(ws + WS_KSUM)};
        pg8::gemm_phase<DM, DM, DM>(lds, g, S, E);
    }
    SEAM(1);
    if (IN(2)) {
        unsigned* cnt = (unsigned*)(ws + WS_BAR) + XCD_BAR_WORDS;
        if (bid < 128) {
            const int L = bid;
            {
                pg8::Gemm g{(const bf16_t*)(ws + WS_XU) + 128, (const bf16_t*)(ws + WS_WST)};
                pg8::OneUnit S{L, L >> 2};
                EpiS E{(float*)(ws + WS_SST)};
                pg8::gemm_phase<384, 256, 256, false, true, false>(lds, g, S, E);
            }
            asm volatile("s_waitcnt vmcnt(0)" ::: "memory");
            __syncthreads();
            scan_unit(p, lds, L);
            asm volatile("s_waitcnt vmcnt(0)" ::: "memory");
            __syncthreads();
            {
                pg8::Gemm g{(const bf16_t*)(ws + WS_XU), (const bf16_t*)(ws + WS_WCAT)};
                pg8::OneUnit S{L, L >> 2};
                EpiY E{(bf16_t*)(ws + WS_YG)};
                pg8::gemm_phase<384, 384, 384, false, true, false>(lds, g, S, E);
            }
            asm volatile("s_waitcnt vmcnt(0)" ::: "memory");
            __syncthreads();
            if (threadIdx.x == 0) {
                __builtin_amdgcn_fence(__ATOMIC_RELEASE, "agent");
                asm volatile("s_waitcnt vmcnt(0)" ::: "memory");
                __hip_atomic_fetch_add(cnt + 64 * (L & 3), 1u, __ATOMIC_RELAXED, __HIP_MEMORY_SCOPE_AGENT);
            }
        }
        if (bid < 128) {
            const int U = bid;
            const int pm = U >> 1, pn = U & 1;
            if (threadIdx.x == 0) {
                unsigned sp = 0;
                while (__hip_atomic_load(cnt + 64 * (pm >> 4), __ATOMIC_RELAXED, __HIP_MEMORY_SCOPE_AGENT) < 32u) { __builtin_amdgcn_s_sleep(2); if (++sp > (1u << 22)) break; }
                __builtin_amdgcn_fence(__ATOMIC_ACQUIRE, "agent");
                asm volatile("s_waitcnt vmcnt(0)" ::: "memory");
            }
            __syncthreads();
            pg8::Gemm g{(const bf16_t*)(ws + WS_YG), (const bf16_t*)(ws + WS_WGLUT)};
            pg8::OneUnit S{pm, pn};
            EpiGlu E{(const bf16_t*)(ws + WS_YG), (const bf16_t*)(ws + WS_SZS), p.b_glu, (bf16_t*)(ws + WS_XB)};
            pg8::gemm_phase<512, 512, 512, false, true, false>(lds, g, S, E);
        }
        phase_attn(p, lds, cnt + 256);
    }
    SEAM(2);
    if (G == 256) {
        if (IN(6)) {
            pg8::Gemm g{(const bf16_t*)(ws + WS_XB), (const bf16_t*)(ws + WS_WOUTT)};
            pg8::StaticOrder<NTOK, DM> S{bid};
            EpiOutFused E{p.x, p.out, (float*)(ws + WS_SSQ), p.final_gain, xbar};
            pg8::gemm_phase<DM, DM, DM, true, true, true>(lds, g, S, E);
        }
    } else {
        if (IN(6)) {
            pg8::Gemm g{(const bf16_t*)(ws + WS_XB), (const bf16_t*)(ws + WS_WOUTT)};
            pg8::StaticOrder<NTOK, DM> S{bid};
            EpiOut E{p.x, p.out, (float*)(ws + WS_SSQ)};
            pg8::gemm_phase<DM, DM, DM>(lds, g, S, E);
        }
        SEAM(6);
        if (IN(7)) { phase_norm(p); }
    }
#undef IN
#undef SEAM
}

extern "C" void kernel_launch(void* const* d_in, const int* in_sizes, int n_in, void* d_out, int out_size, void* d_ws, size_t ws_size, hipStream_t stream) {
    static int grid = 0;
    if (grid == 0) {
        if (n_in != 15 || in_sizes[0] != NTOK * DM || out_size != NTOK * DM || ws_size < WS_END) { fprintf(stderr, "kernel_launch: unexpected shapes (n_in %d, in0 %d, out %d, ws %zu)\n", n_in, n_in > 0 ? in_sizes[0] : -1, out_size, ws_size); grid = -1; return; }
        int dev = 0, cus = 0, per_cu = 0;
        (void)hipGetDevice(&dev); (void)hipDeviceGetAttribute(&cus, hipDeviceAttributeMultiprocessorCount, dev);
        if (hipFuncSetAttribute((const void*)hymba_fwd, hipFuncAttributeMaxDynamicSharedMemorySize, LDS_BYTES) != hipSuccess) { fprintf(stderr, "kernel_launch: hipFuncSetAttribute failed\n"); grid = -1; return; }
        if (hipOccupancyMaxActiveBlocksPerMultiprocessor(&per_cu, (const void*)hymba_fwd, 512, LDS_BYTES) != hipSuccess || per_cu < 1) { fprintf(stderr, "kernel_launch: occupancy query says %d\n", per_cu); per_cu = 1; }
        (void)hipGetLastError();
        if (cus != 256) { fprintf(stderr, "kernel_launch: built for a 256-CU device (one workgroup per CU), found %d CUs; nothing launched\n", cus); grid = -1; return; }
        grid = 256;
    }
    if (grid < 0) return;
    if (hipMemsetAsync((char*)d_ws + WS_BAR, 0, (XCD_BAR_WORDS + 512) * 4, stream) != hipSuccess) { fprintf(stderr, "kernel_launch: memset of barrier words failed\n"); return; }
    Params p{};
    p.x = (const float*)d_in[0]; p.norm_gain = (const float*)d_in[1]; p.w_in = (const float*)d_in[2]; p.w_out = (const float*)d_in[3];
    p.lam_re = (const float*)d_in[4]; p.lam_im = (const float*)d_in[5]; p.b_re = (const float*)d_in[6]; p.b_im = (const float*)d_in[7];
    p.c_re = (const float*)d_in[8]; p.c_im = (const float*)d_in[9]; p.d_skip = (const float*)d_in[10]; p.log_dt = (const float*)d_in[11];
    p.w_glu = (const float*)d_in[12]; p.b_glu = (const float*)d_in[13]; p.final_gain = (const float*)d_in[14];
    p.out = (float*)d_out; p.ws = (unsigned char*)d_ws;
#if N_LAUNCH == 1
    p.ph_lo = 0; p.ph_hi = NPH;
    void* args[] = {&p};
    hipError_t e = hipLaunchCooperativeKernel((const void*)hymba_fwd, dim3(grid), dim3(512), args, LDS_BYTES, stream);
    if (e != hipSuccess) fprintf(stderr, "cooperative launch failed: %s (grid %d)\n", hipGetErrorString(e), grid);
#else
    for (int ph = 0; ph < NPH; ++ph) {
        p.ph_lo = ph; p.ph_hi = ph + 1;
        hipLaunchKernelGGL(hymba_fwd, dim3(grid), dim3(512), LDS_BYTES, stream, p);
    }
#endif
}
```

```cpp
#include <hip/hip_runtime.h>
#include <hip/hip_cooperative_groups.h>
#include <cstdio>
#include <cstdint>
namespace cg = cooperative_groups;

#ifndef ONLY_PH
#define ONLY_PH -1
#endif
#define PH_ON(x) (ONLY_PH < 0 || ONLY_PH == (x))
#ifndef N_LAUNCH
#define N_LAUNCH 1
#endif

#define LAS __attribute__((address_space(3)))
typedef unsigned short bf16_t;
typedef short bf16x8 __attribute__((ext_vector_type(8)));
typedef float f32x4 __attribute__((ext_vector_type(4)));
typedef float f32x16 __attribute__((ext_vector_type(16)));
typedef unsigned u32x2 __attribute__((ext_vector_type(2)));
typedef unsigned u32x4 __attribute__((ext_vector_type(4)));

constexpr int NTOK = 16384, DM = 1024, SEQ = 2048, NPROJ = 3072;
constexpr int NPH = 8;
constexpr size_t MBy = 1u << 20;
constexpr size_t WS_XB = 0;
constexpr size_t WS_WINT = 32 * MBy;
constexpr size_t WS_WOUTT = 38 * MBy;
constexpr size_t WS_WGLUT = 40 * MBy;
constexpr size_t WS_WST = 41 * MBy;
constexpr size_t WS_WCAT = 45 * MBy;
constexpr size_t WS_LAM16 = 51 * MBy;
constexpr size_t WS_RS = WS_LAM16 + 64 * 1024;
constexpr size_t WS_COS = WS_RS + 64 * 1024;
constexpr size_t WS_SIN = WS_COS + 256 * 1024;
constexpr size_t WS_KSUM = WS_SIN + 256 * 1024;
constexpr size_t WS_Q = 52 * MBy;
constexpr size_t WS_K = 68 * MBy;
constexpr size_t WS_VT = 84 * MBy;
constexpr size_t WS_SZA = 100 * MBy;
constexpr size_t WS_SZS = 116 * MBy;
constexpr size_t WS_XU = 132 * MBy;
constexpr size_t WS_SST = 156 * MBy;
constexpr size_t WS_YG = 172 * MBy;
constexpr size_t WS_SSQ = 188 * MBy;
constexpr size_t WS_BAR = 189 * MBy;
constexpr size_t WS_END = 190 * MBy;
constexpr int LDS_BYTES = 131072 + 16;

struct Params {
    const float *x, *norm_gain, *w_in, *w_out, *lam_re, *lam_im, *b_re, *b_im, *c_re, *c_im, *d_skip, *log_dt, *w_glu, *b_glu, *final_gain;
    float* out; unsigned char* ws;
    int ph_lo, ph_hi;
};

typedef float f32x2c_t __attribute__((ext_vector_type(2)));
typedef __bf16 bf16x2c_t __attribute__((ext_vector_type(2)));
__device__ __forceinline__ unsigned pk2(float lo, float hi) { const f32x2c_t v = {lo, hi}; return __builtin_bit_cast(unsigned, __builtin_convertvector(v, bf16x2c_t)); }
__device__ __forceinline__ float bf2f(unsigned short b) { return __uint_as_float(((unsigned)b) << 16); }
__device__ __forceinline__ float bflo(unsigned w) { return __uint_as_float(w << 16); }
__device__ __forceinline__ float bfhi(unsigned w) { return __uint_as_float(w & 0xffff0000u); }
__device__ __forceinline__ float wave_sum(float v) {
#pragma unroll
    for (int o = 1; o < 64; o <<= 1) v += __shfl_xor(v, o);
    return v;
}
__device__ __forceinline__ float sigmoidf_(float v) { return __builtin_amdgcn_rcpf(1.f + __expf(-v)); }
__device__ __forceinline__ float siluf_(float v) { return v * sigmoidf_(v); }
__device__ __forceinline__ float gelu_tanh(float y) { const float t = 1.5957691216f * (y + 0.044715f * y * y * y); return y * sigmoidf_(t); }


#define XB_TMO      128
#define XB_XCNT(j)  (256  + 64 * (j))
#define XB_XSUB(j)  (1280 + 64 * (j))
#define XB_XGEN(j)  (2304 + 64 * (j))
#define XB_TOP      3328
#define XB_TOPGEN   3392
#define XCD_BAR_WORDS 3456
#define XB_SPIN_CAP (1u << 18)
__device__ __forceinline__ unsigned xb_ld(unsigned* p)              { return __hip_atomic_load(p, __ATOMIC_RELAXED, __HIP_MEMORY_SCOPE_AGENT); }
__device__ __forceinline__ unsigned xb_add(unsigned* p, unsigned v) { return __hip_atomic_fetch_add(p, v, __ATOMIC_RELAXED, __HIP_MEMORY_SCOPE_AGENT); }
__device__ __forceinline__ unsigned xb_xcc_id() { return (unsigned)__builtin_amdgcn_s_getreg((3 << 11) | 20) & 0xFu; }
#define XB_SPIN(cond, bar) do { unsigned _sp = 0; while (cond) { __builtin_amdgcn_s_sleep(1); \
    if ((++_sp & 255u) == 0u) { if (xb_ld(&(bar)[XB_TMO])) break; if (_sp > XB_SPIN_CAP) { atomicAdd(&(bar)[XB_TMO], 1u); break; } } } } while (0)
struct XcdBarrier { unsigned* bar; unsigned x; volatile LAS unsigned* st; };
__device__ __forceinline__ XcdBarrier xcd_barrier_post(unsigned* bar, volatile LAS unsigned* st) {
    XcdBarrier b; b.bar = bar; b.x = xb_xcc_id(); b.st = st;
    if (threadIdx.x == 0) (void)xb_add(&bar[XB_XCNT(b.x)], 1u);
    return b;
}
__device__ __forceinline__ void xcd_barrier_complete(unsigned* bar, unsigned x, unsigned& nloc, unsigned& nx) {
    const unsigned G = 256u;
    unsigned sum, cnt, mine, sp = 0u;
    for (;;) {
        sum = 0u; cnt = 0u; mine = 0u;
#pragma unroll
        for (unsigned j = 0; j < 16; ++j) { const unsigned c = xb_ld(&bar[XB_XCNT(j)]); sum += c; cnt += (c > 0u) ? 1u : 0u; mine = (j == x) ? c : mine; }
        if (sum == G) break;
        __builtin_amdgcn_s_sleep(1);
        if ((++sp & 255u) == 0u) { if (xb_ld(&bar[XB_TMO])) break; if (sp > XB_SPIN_CAP) { atomicAdd(&bar[XB_TMO], 1u); break; } }
    }
    nloc = mine > 0u ? mine : 1u; nx = cnt > 0u ? cnt : 1u;
}
__device__ __forceinline__ void xcd_barrier(const XcdBarrier& b) {
    asm volatile("s_waitcnt vmcnt(0)" ::: "memory");
    __syncthreads();
    if (threadIdx.x == 0) {
        unsigned* bar = b.bar;
        __builtin_amdgcn_s_waitcnt(0);
        unsigned nloc = b.st[0], nx = b.st[1];
        if (nloc == 0u) { xcd_barrier_complete(bar, b.x, nloc, nx); b.st[0] = nloc; b.st[1] = nx; }
        const unsigned old = xb_add(&bar[XB_XSUB(b.x)], 1u);
        const unsigned gen = old / nloc;
        if (old + 1u == (gen + 1u) * nloc) {
            __builtin_amdgcn_fence(__ATOMIC_RELEASE, "agent");
            asm volatile("s_waitcnt vmcnt(0)" ::: "memory");
            const unsigned og = xb_add(&bar[XB_TOP], 1u);
            const unsigned tg = og / nx;
            if (og + 1u == (tg + 1u) * nx) xb_add(&bar[XB_TOPGEN], 1u);
            else XB_SPIN(xb_ld(&bar[XB_TOPGEN]) == tg, bar);
            __builtin_amdgcn_fence(__ATOMIC_ACQUIRE, "agent");
            xb_add(&bar[XB_XGEN(b.x)], 1u);
            asm volatile("s_waitcnt vmcnt(0)" ::: "memory");
        } else {
            XB_SPIN(xb_ld(&bar[XB_XGEN(b.x)]) == gen, bar);
            __builtin_amdgcn_fence(__ATOMIC_ACQUIRE, "agent");
            asm volatile("s_waitcnt vmcnt(0)" ::: "memory");
        }
    }
    __syncthreads();
}

namespace pg8 {
constexpr int BM = 256, BK = 64, HALF = 128, HTB = HALF * BK * 2, STAGE_BYTES = 8 * HTB, NXCD = 8, WGM = 8;
__device__ __forceinline__ int lds_byte(int r, int c) { const int st = (r >> 4) * 2 + (c >> 5), rr = r & 15, cc = c & 31, ob = rr * 64 + cc * 2; return st * 1024 + (ob ^ (((ob >> 9) & 1) << 5)); }
__device__ __forceinline__ void stage_rc(int b, int& R, int& C) { const int st = b / 1024, sb = b % 1024, swz = sb ^ (((sb >> 9) & 1) << 5); R = (st >> 1) * 16 + swz / 64; C = (st & 1) * 32 + (swz % 64) / 2; }
struct Unit { int pm, pn; };
struct Gemm { const bf16_t* A; const bf16_t* Bt; };

template <int M, int N>
struct StaticOrder {
    static constexpr int nM = M / BM, nN = N / BM, nwg = nM * nN, G = 256;
    int c;
    __device__ bool next(int i, Unit& u) const {
        const int L = i * G + c; if (L >= nwg) return false;
        int wgid = L; { constexpr int q = nwg / NXCD, r = nwg % NXCD; const int xcd = wgid % NXCD, off = wgid / NXCD; wgid = (xcd < r ? xcd * (q + 1) : r * (q + 1) + (xcd - r) * q) + off; }
        constexpr int nig = WGM * nN; const int gid = wgid / nig, fm = gid * WGM, gsz = (nM - fm) < WGM ? (nM - fm) : WGM;
        u.pm = fm + ((wgid % nig) % gsz); u.pn = (wgid % nig) / gsz; return true;
    }
};
struct GroupOrder {
    int G, c;
    __device__ bool next(int i, Unit& u) const { const int L = i * G + c; if (L >= 128) return false; u.pm = L; u.pn = L >> 2; return true; }
};

struct OneUnit {
    int pm, pn;
    __device__ bool next(int i, Unit& u) const { if (i) return false; u.pm = pm; u.pn = pn; return true; }
};

template <int LDA, int LDB, int KK, bool AFTER = false, bool ALIGN_EPI = true, bool SP2 = true, class Epi, class Sched>
__device__ __forceinline__ void gemm_phase(LAS unsigned char* lds, const Gemm g, const Sched& S, const Epi& E) {
    const int tid = threadIdx.x, wid = __builtin_amdgcn_readfirstlane(tid >> 6), lane = tid & 63, wr = wid >> 2, wc = wid & 3, fr = lane & 15, fq = lane >> 4;
    constexpr int K = KK, nt = K / BK;
    unsigned voffA[2], voffB[2];
#pragma unroll
    for (int i = 0; i < 2; ++i) { int R, C; stage_rc(tid * 16 + i * 8192, R, C); voffA[i] = (unsigned)(R * LDA + C) * 2u; voffB[i] = (unsigned)(R * LDB + C) * 2u; }
    constexpr size_t kstep = (size_t)(BK * 2);
    constexpr size_t hstepA = (size_t)HALF * LDA * 2, hstepB = (size_t)HALF * LDB * 2;
    constexpr size_t tstepA = 2 * hstepA, tstepB = 2 * hstepB;
    const unsigned ldsw = (unsigned)wid * 1024u;
    const int aoff = lds_byte(wr * 64 + fr, fq * 8), boff = lds_byte(wc * 32 + fr, fq * 8);
#define PG8_SA(b, h) (((b) * 2 + (h)) * HTB)
#define PG8_SB(b, h) ((4 + (b) * 2 + (h)) * HTB)
#define PG8_STAGE(bufoff, gbase, voff) do { _Pragma("unroll") for (int _i = 0; _i < 2; ++_i) \
        __builtin_amdgcn_global_load_lds((const unsigned*)((const char*)(gbase) + (voff)[_i]), (LAS unsigned*)(lds + (bufoff) + ldsw + _i * 8192), 16, 0, 0); } while (0)
#define PG8_LDA(dst, b, h) do { _Pragma("unroll") for (int m = 0; m < 4; ++m) _Pragma("unroll") for (int k = 0; k < 2; ++k) dst[m][k] = *(const LAS bf16x8*)(lds + PG8_SA(b, h) + aoff + m * 2048 + k * 1024); } while (0)
#define PG8_LDB(dst, b, h) do { _Pragma("unroll") for (int n = 0; n < 2; ++n) _Pragma("unroll") for (int k = 0; k < 2; ++k) dst[n][k] = *(const LAS bf16x8*)(lds + PG8_SB(b, h) + boff + n * 2048 + k * 1024); } while (0)
#define PG8_MMA(ai, bj, At, Bt) do { __builtin_amdgcn_s_setprio(1); _Pragma("unroll") for (int m = 0; m < 4; ++m) _Pragma("unroll") for (int n = 0; n < 2; ++n) _Pragma("unroll") for (int k = 0; k < 2; ++k) \
        acc[ai][bj][m][n] = __builtin_amdgcn_mfma_f32_16x16x32_bf16(Bt[n][k], At[m][k], acc[ai][bj][m][n], 0, 0, 0); __builtin_amdgcn_s_setprio(0); } while (0)
#define PG8_WAIT_V(n) asm volatile("s_waitcnt vmcnt(" #n ")" ::: "memory")
#define PG8_WAIT_L(n) asm volatile("s_waitcnt lgkmcnt(" #n ")" ::: "memory")
#define PG8_BAR __builtin_amdgcn_s_barrier()
#define PG8_SCHED __builtin_amdgcn_sched_barrier(0)
    Unit cur, nxt; int ui = 0;
    if (!S.next(0, cur)) return;
    f32x4 acc[2][2][4][2];
#pragma unroll
    for (int a = 0; a < 2; ++a)
#pragma unroll
        for (int b = 0; b < 2; ++b)
#pragma unroll
            for (int m = 0; m < 4; ++m)
#pragma unroll
                for (int n = 0; n < 2; ++n) acc[a][b][m][n] = (f32x4){0.f, 0.f, 0.f, 0.f};
    bf16x8 At[4][2], B0[2][2], B1[2][2];
    const char* cA = (const char*)g.A + (size_t)cur.pm * tstepA; const char* cB = (const char*)g.Bt + (size_t)cur.pn * tstepB;
    if constexpr (SP2) {
        PG8_STAGE(PG8_SB(0, 0), cB, voffB); PG8_STAGE(PG8_SB(0, 1), cB + hstepB, voffB); PG8_STAGE(PG8_SA(0, 0), cA, voffA); PG8_STAGE(PG8_SA(0, 1), cA + hstepA, voffA);
        if (wr == 1) PG8_BAR;
        PG8_WAIT_V(2); PG8_BAR;
        PG8_STAGE(PG8_SB(1, 0), cB + kstep, voffB); PG8_STAGE(PG8_SA(1, 0), cA + kstep, voffA); PG8_STAGE(PG8_SB(1, 1), cB + hstepB + kstep, voffB);
        PG8_WAIT_V(6); PG8_BAR;
    } else {
        PG8_STAGE(PG8_SB(0, 0), cB, voffB); PG8_STAGE(PG8_SA(0, 0), cA, voffA); PG8_STAGE(PG8_SB(0, 1), cB + hstepB, voffB); PG8_STAGE(PG8_SA(0, 1), cA + hstepA, voffA);
        if (wr == 1) PG8_BAR;
        PG8_WAIT_V(4); PG8_BAR;
        PG8_STAGE(PG8_SB(1, 0), cB + kstep, voffB); PG8_STAGE(PG8_SA(1, 0), cA + kstep, voffA); PG8_STAGE(PG8_SB(1, 1), cB + hstepB + kstep, voffB);
        PG8_WAIT_V(6); PG8_BAR;
    }
    for (;;) {
        const bool has_next = S.next(ui + 1, nxt);
        const char* nA = has_next ? (const char*)g.A + (size_t)nxt.pm * tstepA : cA; const char* nB = has_next ? (const char*)g.Bt + (size_t)nxt.pn * tstepB : cB;
        for (int t = 0; t < nt; t += 2) {
            const bool last = (t == nt - 2);
            const char* a1 = cA + (size_t)(t + 1) * kstep;
            const char* a2 = last ? nA : cA + (size_t)(t + 2) * kstep; const char* b2 = last ? nB : cB + (size_t)(t + 2) * kstep;
            const char* a3 = a2 + kstep; const char* b3 = b2 + kstep;
            if constexpr (SP2) {
            PG8_LDB(B0, 0, 0); PG8_LDB(B1, 0, 1); PG8_SCHED; PG8_LDA(At, 0, 0); PG8_STAGE(PG8_SA(1, 1), a1 + hstepA, voffA);
            PG8_WAIT_V(8); PG8_WAIT_L(0); PG8_BAR; PG8_MMA(0, 0, At, B0); PG8_MMA(0, 1, At, B1); PG8_BAR; PG8_SCHED;
            PG8_LDA(At, 0, 1); PG8_STAGE(PG8_SB(0, 0), b2, voffB); PG8_STAGE(PG8_SB(0, 1), b2 + hstepB, voffB); PG8_STAGE(PG8_SA(0, 0), a2, voffA);
            PG8_WAIT_V(8); PG8_WAIT_L(0); PG8_BAR; PG8_MMA(1, 0, At, B0); PG8_MMA(1, 1, At, B1); PG8_BAR; PG8_SCHED;
            PG8_LDB(B0, 1, 0); PG8_LDB(B1, 1, 1); PG8_SCHED; PG8_LDA(At, 1, 0); PG8_STAGE(PG8_SA(0, 1), a2 + hstepA, voffA);
            PG8_WAIT_V(8); PG8_WAIT_L(0); PG8_BAR; PG8_MMA(0, 0, At, B0); PG8_MMA(0, 1, At, B1); PG8_BAR; PG8_SCHED;
            PG8_LDA(At, 1, 1); PG8_STAGE(PG8_SB(1, 0), b3, voffB); PG8_STAGE(PG8_SB(1, 1), b3 + hstepB, voffB); PG8_STAGE(PG8_SA(1, 0), a3, voffA);
            PG8_WAIT_V(8); PG8_WAIT_L(0); PG8_BAR; PG8_MMA(1, 0, At, B0); PG8_MMA(1, 1, At, B1); PG8_BAR; PG8_SCHED;
            } else {
            PG8_LDB(B0, 0, 0); PG8_SCHED; PG8_LDA(At, 0, 0); PG8_STAGE(PG8_SA(1, 1), a1 + hstepA, voffA);
            PG8_WAIT_L(8); PG8_BAR; PG8_WAIT_L(0); PG8_MMA(0, 0, At, B0); PG8_BAR; PG8_SCHED;
            PG8_LDB(B1, 0, 1); PG8_STAGE(PG8_SB(0, 0), b2, voffB);
            PG8_BAR; PG8_WAIT_L(0); PG8_MMA(0, 1, At, B1); PG8_BAR;
            PG8_LDA(At, 0, 1); PG8_STAGE(PG8_SA(0, 0), a2, voffA);
            PG8_BAR; PG8_WAIT_L(0); PG8_MMA(1, 0, At, B0); PG8_BAR; PG8_SCHED;
            PG8_STAGE(PG8_SB(0, 1), b2 + hstepB, voffB);
            PG8_WAIT_V(6); PG8_BAR; PG8_MMA(1, 1, At, B1); PG8_BAR;
            PG8_LDB(B0, 1, 0); PG8_SCHED; PG8_LDA(At, 1, 0); PG8_STAGE(PG8_SA(0, 1), a2 + hstepA, voffA);
            PG8_WAIT_L(8); PG8_BAR; PG8_WAIT_L(0); PG8_MMA(0, 0, At, B0); PG8_BAR; PG8_SCHED;
            PG8_LDB(B1, 1, 1); PG8_STAGE(PG8_SB(1, 0), b3, voffB);
            PG8_BAR; PG8_WAIT_L(0); PG8_MMA(0, 1, At, B1); PG8_BAR;
            PG8_LDA(At, 1, 1); PG8_STAGE(PG8_SA(1, 0), a3, voffA);
            PG8_BAR; PG8_WAIT_L(0); PG8_MMA(1, 0, At, B0); PG8_BAR; PG8_SCHED;
            PG8_STAGE(PG8_SB(1, 1), b3 + hstepB, voffB);
            PG8_WAIT_V(6); PG8_BAR; PG8_MMA(1, 1, At, B1); PG8_BAR;
                    }
        }
        if constexpr (ALIGN_EPI) { if (wr == 0) PG8_BAR; }
        E(acc, cur, wr, wc, fr, fq);
        if (!has_next) break;
#pragma unroll
        for (int a = 0; a < 2; ++a)
#pragma unroll
            for (int b = 0; b < 2; ++b)
#pragma unroll
                for (int m = 0; m < 4; ++m)
#pragma unroll
                    for (int n = 0; n < 2; ++n) acc[a][b][m][n] = (f32x4){0.f, 0.f, 0.f, 0.f};
        cur = nxt; cA = nA; cB = nB; ++ui;
        if constexpr (ALIGN_EPI) { if (wr == 1) PG8_BAR; }
    }
    PG8_WAIT_V(0);
    if constexpr (!ALIGN_EPI) { if (wr == 0) PG8_BAR; }
    PG8_BAR;
    if constexpr (AFTER) E.after(acc, cur, wr, wc, fr, fq);
#undef PG8_SA
#undef PG8_SB
#undef PG8_STAGE
#undef PG8_LDA
#undef PG8_LDB
#undef PG8_MMA
#undef PG8_WAIT_V
#undef PG8_WAIT_L
#undef PG8_BAR
#undef PG8_SCHED
}
}
using pg8::Unit;


__device__ __forceinline__ int inproj_row(int e) {
    const int pn = e >> 8, o = e & 255;
    const int wc = o >> 6, bj = (o >> 5) & 1, fq = (o >> 3) & 3, n = (o >> 2) & 1, i = o & 3;
    return 256 * pn + 128 * bj + 32 * wc + 16 * n + 4 * fq + i;
}

struct EpiInProj {
    const float *rs, *cosT, *sinT;
    bf16_t *Q, *Kk, *VT, *SZA, *SZS, *XU; float* KSUM;
    __device__ __forceinline__ void operator()(const f32x4 (&acc)[2][2][4][2], const Unit& u, int wr, int wc, int fr, int fq) const {
        const int seg = u.pn >> 1, half = u.pn & 1;
        const int b = u.pm >> 3, blk = u.pm & 7;
        const int lbase = blk * 256 + wr * 64 + fr;
        if (seg <= 1) {
            bf16_t* dst = seg == 0 ? Q : Kk; const float qs = seg == 0 ? 0.18033688011112042f : 1.0f;
            const int head = 4 * half + wc;
            f32x4 cl[2], ch[2];
#pragma unroll
            for (int n = 0; n < 2; ++n) { cl[n] = (f32x4){0.f, 0.f, 0.f, 0.f}; ch[n] = (f32x4){0.f, 0.f, 0.f, 0.f}; }
            bf16_t* obase = dst + ((size_t)((b * 8 + head) * 2048)) * 64 + 8 * fq;
#pragma unroll
            for (int ai = 0; ai < 2; ++ai)
#pragma unroll
                for (int m = 0; m < 4; ++m) {
                    const int l = lbase + 128 * ai + 16 * m; const float rsv = rs[b * 2048 + l] * qs;
                    unsigned wl[4], wh[4];
#pragma unroll
                    for (int n = 0; n < 2; ++n) {
                        const f32x4 c4 = *(const f32x4*)(cosT + l * 32 + 8 * fq + 4 * n), s4 = *(const f32x4*)(sinT + l * 32 + 8 * fq + 4 * n);
                        const f32x4 t1 = acc[ai][0][m][n] * rsv, t2 = acc[ai][1][m][n] * rsv;
                        const f32x4 lo = t1 * c4 - t2 * s4, hi = t2 * c4 + t1 * s4;
                        wl[2 * n] = pk2(lo[0], lo[1]); wl[2 * n + 1] = pk2(lo[2], lo[3]); wh[2 * n] = pk2(hi[0], hi[1]); wh[2 * n + 1] = pk2(hi[2], hi[3]);
                        cl[n] += lo; ch[n] += hi;
                    }
                    bf16_t* o = obase + (unsigned)l * 64u;
                    *(u32x4*)o = (u32x4){wl[0], wl[1], wl[2], wl[3]};
                    *(u32x4*)(o + 32) = (u32x4){wh[0], wh[1], wh[2], wh[3]};
                }
            if (seg == 1) {
#pragma unroll
                for (int n = 0; n < 2; ++n)
#pragma unroll
                    for (int i = 0; i < 4; ++i) {
                        float v = cl[n][i], v2 = ch[n][i];
                        v += __shfl_xor(v, 1); v += __shfl_xor(v, 2); v += __shfl_xor(v, 4); v += __shfl_xor(v, 8);
                        v2 += __shfl_xor(v2, 1); v2 += __shfl_xor(v2, 2); v2 += __shfl_xor(v2, 4); v2 += __shfl_xor(v2, 8);
                        if (fr == 0) { float* kp = KSUM + ((b * 8 + head) * 8 + blk) * 64 + 8 * fq + 4 * n + i; atomicAdd(kp, v); atomicAdd(kp + 32, v2); }
                    }
            }
        } else if (seg == 2) {
            const int head = 4 * half + wc;
#pragma unroll
            for (int ai = 0; ai < 2; ++ai)
#pragma unroll
                for (int m = 0; m < 4; ++m) {
                    const int l = lbase + 128 * ai + 16 * m; const float rsv = rs[b * 2048 + l];
#pragma unroll
                    for (int bj = 0; bj < 2; ++bj)
#pragma unroll
                        for (int n = 0; n < 2; ++n) {
                            const int d0 = 32 * bj + 8 * fq + 4 * n;
                            const f32x4 v = acc[ai][bj][m][n] * rsv;
                            bf16_t* o = VT + ((size_t)((b * 8 + head) * 64 + d0)) * 2048 + l;
                            const unsigned p0 = pk2(v[0], v[1]), p1 = pk2(v[2], v[3]);
                            o[0] = (bf16_t)(p0 & 0xffffu); o[2048] = (bf16_t)(p0 >> 16); o[4096] = (bf16_t)(p1 & 0xffffu); o[6144] = (bf16_t)(p1 >> 16);
                        }
                }
        } else if (seg == 4) {
#pragma unroll
            for (int ai = 0; ai < 2; ++ai)
#pragma unroll
                for (int m = 0; m < 4; ++m) {
                    const int l = lbase + 128 * ai + 16 * m; const float rsv = rs[b * 2048 + l];
                    const int c = l >> 4, t = l & 15;
#pragma unroll
                    for (int bj = 0; bj < 2; ++bj) {
                        const int g = 16 * half + 4 * wc + 2 * bj + (fq >> 1);
                        const f32x4 v0 = acc[ai][bj][m][0] * rsv, v1 = acc[ai][bj][m][1] * rsv;
                        bf16_t* o = XU + ((size_t)(1024 * g + b * 128 + c)) * 384 + 128 + t * 16 + 8 * (fq & 1);
                        *(u32x4*)o = (u32x4){pk2(v0[0], v0[1]), pk2(v0[2], v0[3]), pk2(v1[0], v1[1]), pk2(v1[2], v1[3])};
                    }
                }
        } else {
            bf16_t* dst = seg == 3 ? SZA : SZS;
#pragma unroll
            for (int ai = 0; ai < 2; ++ai)
#pragma unroll
                for (int m = 0; m < 4; ++m) {
                    const int l = lbase + 128 * ai + 16 * m; const int row = b * 2048 + l; const float rsv = rs[row];
#pragma unroll
                    for (int bj = 0; bj < 2; ++bj) {
                        const int col = 256 * half + 64 * wc + 32 * bj + 8 * fq;
                        const f32x4 v0 = acc[ai][bj][m][0] * rsv, v1 = acc[ai][bj][m][1] * rsv;
                        *(u32x4*)(dst + (size_t)row * 512 + col) = (u32x4){pk2(siluf_(v0[0]), siluf_(v0[1])), pk2(siluf_(v0[2]), siluf_(v0[3])), pk2(siluf_(v1[0]), siluf_(v1[1])), pk2(siluf_(v1[2]), siluf_(v1[3]))};
                    }
                }
        }
    }
};

struct EpiS {
    float* SST;
    __device__ __forceinline__ void operator()(const f32x4 (&acc)[2][2][4][2], const Unit& u, int wr, int wc, int fr, int fq) const {
#pragma unroll
        for (int ai = 0; ai < 2; ++ai)
#pragma unroll
            for (int m = 0; m < 4; ++m) {
                const int R = 256 * u.pm + 128 * ai + 64 * wr + 16 * m + fr;
#pragma unroll
                for (int n = 0; n < 2; ++n) *(f32x4*)(SST + (size_t)R * 128 + 32 * wc + 16 * n + 4 * fq) = acc[ai][0][m][n];
            }
    }
};

struct EpiY {
    bf16_t* YG;
    __device__ __forceinline__ void operator()(const f32x4 (&acc)[2][2][4][2], const Unit& u, int wr, int wc, int fr, int fq) const {
        const int g = u.pn, t = 4 * wc + fq;
#pragma unroll
        for (int ai = 0; ai < 2; ++ai)
#pragma unroll
            for (int m = 0; m < 4; ++m) {
                const int rr = 256 * (u.pm & 3) + 128 * ai + 64 * wr + 16 * m + fr;
                const int b = rr >> 7, c = rr & 127; const int token = b * 2048 + 16 * c + t;
                bf16_t* ob = YG + (size_t)token * 512 + 16 * g;
#pragma unroll
                for (int bj = 0; bj < 2; ++bj) {
                    const f32x4 v0 = acc[ai][bj][m][0], v1 = acc[ai][bj][m][1];
                    *(u32x4*)(ob + 8 * bj) = (u32x4){pk2(gelu_tanh(v0[0]), gelu_tanh(v0[1])), pk2(gelu_tanh(v0[2]), gelu_tanh(v0[3])), pk2(gelu_tanh(v1[0]), gelu_tanh(v1[1])), pk2(gelu_tanh(v1[2]), gelu_tanh(v1[3]))};
                }
            }
    }
};

struct EpiGlu {
    const bf16_t *YG, *SZS; const float* bglu; bf16_t* MIXED;
    __device__ __forceinline__ void operator()(const f32x4 (&acc)[2][2][4][2], const Unit& u, int wr, int wc, int fr, int fq) const {
        f32x4 bias[2][2];
#pragma unroll
        for (int bj = 0; bj < 2; ++bj)
#pragma unroll
            for (int n = 0; n < 2; ++n) bias[bj][n] = *(const f32x4*)(bglu + 256 * u.pn + 64 * wc + 32 * bj + 8 * fq + 4 * n);
#pragma unroll
        for (int ai = 0; ai < 2; ++ai) {
            u32x4 y4[4][2], z4[4][2];
#pragma unroll
            for (int m = 0; m < 4; ++m) {
                const int row = 256 * u.pm + 128 * ai + 64 * wr + 16 * m + fr;
#pragma unroll
                for (int bj = 0; bj < 2; ++bj) {
                    const unsigned off = (unsigned)row * 512u + (unsigned)(256 * u.pn + 64 * wc + 32 * bj + 8 * fq);
                    y4[m][bj] = *(const u32x4*)(YG + off); z4[m][bj] = *(const u32x4*)(SZS + off);
                }
            }
#pragma unroll
            for (int m = 0; m < 4; ++m) {
                const int row = 256 * u.pm + 128 * ai + 64 * wr + 16 * m + fr;
#pragma unroll
                for (int bj = 0; bj < 2; ++bj) {
                    const int col = 256 * u.pn + 64 * wc + 32 * bj + 8 * fq;
                    unsigned w[4];
#pragma unroll
                    for (int n = 0; n < 2; ++n) {
                        const f32x4 a = acc[ai][bj][m][n] + bias[bj][n];
                        const unsigned ya = y4[m][bj][2 * n], yb = y4[m][bj][2 * n + 1], za = z4[m][bj][2 * n], zb = z4[m][bj][2 * n + 1];
                        const float o0 = bflo(ya) * sigmoidf_(a[0]) * bflo(za), o1 = bfhi(ya) * sigmoidf_(a[1]) * bfhi(za);
                        const float o2 = bflo(yb) * sigmoidf_(a[2]) * bflo(zb), o3 = bfhi(yb) * sigmoidf_(a[3]) * bfhi(zb);
                        w[2 * n] = pk2(o0, o1); w[2 * n + 1] = pk2(o2, o3);
                    }
                    *(u32x4*)(MIXED + (size_t)row * 1024 + 512 + col) = (u32x4){w[0], w[1], w[2], w[3]};
                }
            }
        }
    }
};

struct EpiOut {
    const float* x; float* out; float* SSQ;
    __device__ __forceinline__ void operator()(const f32x4 (&acc)[2][2][4][2], const Unit& u, int wr, int wc, int fr, int fq) const {
#pragma unroll
        for (int ai = 0; ai < 2; ++ai) {
            f32x4 xv[4][2][2];
#pragma unroll
            for (int m = 0; m < 4; ++m) {
                const int row = 256 * u.pm + 128 * ai + 64 * wr + 16 * m + fr;
#pragma unroll
                for (int bj = 0; bj < 2; ++bj)
#pragma unroll
                    for (int n = 0; n < 2; ++n) xv[m][bj][n] = *(const f32x4*)(x + (size_t)row * 1024 + 256 * u.pn + 64 * wc + 32 * bj + 8 * fq + 4 * n);
            }
#pragma unroll
            for (int m = 0; m < 4; ++m) {
                const int row = 256 * u.pm + 128 * ai + 64 * wr + 16 * m + fr;
                float ss = 0.f;
#pragma unroll
                for (int bj = 0; bj < 2; ++bj)
#pragma unroll
                    for (int n = 0; n < 2; ++n) {
                        const int col = 256 * u.pn + 64 * wc + 32 * bj + 8 * fq + 4 * n;
                        const f32x4 v = acc[ai][bj][m][n] + xv[m][bj][n];
                        *(f32x4*)(out + (size_t)row * 1024 + col) = v;
                        ss += (v[0] * v[0] + v[1] * v[1]) + (v[2] * v[2] + v[3] * v[3]);
                    }
                ss += __shfl_xor(ss, 16); ss += __shfl_xor(ss, 32);
                if (fq == 0) SSQ[row * 16 + 4 * u.pn + wc] = ss;
            }
        }
    }
};

struct EpiOutFused {
    const float* x; float* out; float* SSQ; const float* gain; XcdBarrier xbar;
    __device__ __forceinline__ void operator()(f32x4 (&acc)[2][2][4][2], const Unit& u, int wr, int wc, int fr, int fq) const {
#pragma unroll
        for (int ai = 0; ai < 2; ++ai) {
            f32x4 xv[4][2][2];
#pragma unroll
            for (int m = 0; m < 4; ++m) {
                const int row = 256 * u.pm + 128 * ai + 64 * wr + 16 * m + fr;
#pragma unroll
                for (int bj = 0; bj < 2; ++bj)
#pragma unroll
                    for (int n = 0; n < 2; ++n) xv[m][bj][n] = *(const f32x4*)(x + (size_t)row * 1024 + 256 * u.pn + 64 * wc + 32 * bj + 8 * fq + 4 * n);
            }
#pragma unroll
            for (int m = 0; m < 4; ++m) {
                const int row = 256 * u.pm + 128 * ai + 64 * wr + 16 * m + fr;
                float ss = 0.f;
#pragma unroll
                for (int bj = 0; bj < 2; ++bj)
#pragma unroll
                    for (int n = 0; n < 2; ++n) {
                        const f32x4 v = acc[ai][bj][m][n] + xv[m][bj][n];
                        acc[ai][bj][m][n] = v;
                        ss += (v[0] * v[0] + v[1] * v[1]) + (v[2] * v[2] + v[3] * v[3]);
                    }
                ss += __shfl_xor(ss, 16); ss += __shfl_xor(ss, 32);
                if (fq == 0) SSQ[row * 16 + 4 * u.pn + wc] = ss;
            }
        }
    }
    __device__ __forceinline__ void after(f32x4 (&acc)[2][2][4][2], const Unit& u, int wr, int wc, int fr, int fq) const {
        xcd_barrier(xbar);
        f32x4 gn[2][2];
#pragma unroll
        for (int bj = 0; bj < 2; ++bj)
#pragma unroll
            for (int n = 0; n < 2; ++n) gn[bj][n] = *(const f32x4*)(gain + 256 * u.pn + 64 * wc + 32 * bj + 8 * fq + 4 * n);
#pragma unroll
        for (int ai = 0; ai < 2; ++ai)
#pragma unroll
            for (int m = 0; m < 4; ++m) {
                const int row = 256 * u.pm + 128 * ai + 64 * wr + 16 * m + fr;
                const f32x4* sp = (const f32x4*)(SSQ + row * 16);
                const f32x4 s0 = sp[0], s1 = sp[1], s2 = sp[2], s3 = sp[3];
                const float tot = ((s0[0] + s0[1]) + (s0[2] + s0[3])) + ((s1[0] + s1[1]) + (s1[2] + s1[3])) + ((s2[0] + s2[1]) + (s2[2] + s2[3])) + ((s3[0] + s3[1]) + (s3[2] + s3[3]));
                const float rinv = 1.0f / sqrtf(tot * (1.f / DM) + 1e-6f);
#pragma unroll
                for (int bj = 0; bj < 2; ++bj)
#pragma unroll
                    for (int n = 0; n < 2; ++n) {
                        const int col = 256 * u.pn + 64 * wc + 32 * bj + 8 * fq + 4 * n;
                        *(f32x4*)(out + (size_t)row * 1024 + col) = acc[ai][bj][m][n] * rinv * gn[bj][n];
                    }
            }
    }
};

template <int MODE>
__device__ __forceinline__ void transpose_item(const float* W, int K, int N, bf16_t* WT, const float* gain, LAS float* scr, int item, int lane) {
    const int nblk = N / 32, kb = item / nblk, nb = item % nblk, k0 = 64 * kb, n0 = 32 * nb;
#pragma unroll 8
    for (int i = 0; i < 32; ++i) { const int kk = 2 * i + (lane >> 5); float w = W[(size_t)(k0 + kk) * N + n0 + (lane & 31)]; if (MODE == 0) w *= gain[k0 + kk]; scr[kk * 33 + (lane & 31)] = w; }
    const int c = lane & 7;
#pragma unroll
    for (int j = 0; j < 4; ++j) { const int n = (lane >> 3) + 8 * j; const LAS float* s = scr + (8 * c) * 33 + n;
        u32x4 o; o.x = pk2(s[0 * 33], s[1 * 33]); o.y = pk2(s[2 * 33], s[3 * 33]); o.z = pk2(s[4 * 33], s[5 * 33]); o.w = pk2(s[6 * 33], s[7 * 33]);
        const int drow = inproj_row(n0 + n);
        *(u32x4*)(WT + (size_t)drow * K + k0 + 8 * c) = o; }
}

__device__ __forceinline__ void ssm_group_prep(const Params& p, int item, LAS float* L) {
    LAS float* lkr = L; LAS float* lki = L + 1088; LAS float* bbr = L + 2176; LAS float* bbi = L + 3200; LAS float* cr = L + 4224; LAS float* ci = L + 5248; LAS float* Kt = L + 6272;
    const int tid = threadIdx.x, g = item >> 3, sub = item & 7;
    const float dt = expf(p.log_dt[g]);
    for (int t = tid; t < 17 * 64; t += 512) {
        const int pp = t & 63, k = t >> 6;
        const float a = p.lam_re[g * 64 + pp] * dt, th = p.lam_im[g * 64 + pp] * dt;
        const float mag = expf((float)k * a); float sn, cs; sincosf((float)k * th, &sn, &cs);
        lkr[k * 64 + pp] = mag * cs; lki[k * 64 + pp] = mag * sn;
    }
    for (int t = tid; t < 1024; t += 512) {
        const int pp = t >> 4, h = t & 15;
        const float lr = p.lam_re[g * 64 + pp], li = p.lam_im[g * 64 + pp];
        const float a = lr * dt, th = li * dt;
        float sn, cs; sincosf(th, &sn, &cs); const float sh = sinf(0.5f * th);
        const float em1 = expm1f(a), ea = em1 + 1.f;
        const float xr = em1 * cs - 2.f * sh * sh, xi = ea * sn;
        const float den = 1.f / (lr * lr + li * li);
        const float cfr = (xr * lr + xi * li) * den, cfi = (xi * lr - xr * li) * den;
        const float br = p.b_re[(g * 64 + pp) * 16 + h], bi = p.b_im[(g * 64 + pp) * 16 + h];
        bbr[pp * 16 + h] = cfr * br - cfi * bi; bbi[pp * 16 + h] = cfr * bi + cfi * br;
        cr[h * 64 + pp] = p.c_re[(g * 16 + h) * 64 + pp]; ci[h * 64 + pp] = p.c_im[(g * 16 + h) * 64 + pp];
    }
    __syncthreads();
    {
        const int k = tid >> 5, hl = (tid >> 4) & 1, h2 = tid & 15, h = 2 * sub + hl;
        float sacc = 0.f;
        for (int pp = 0; pp < 64; ++pp) {
            const float c_r = cr[h * 64 + pp], c_i = ci[h * 64 + pp], l_r = lkr[k * 64 + pp], l_i = lki[k * 64 + pp];
            const float er = c_r * l_r - c_i * l_i, ei = c_r * l_i + c_i * l_r;
            sacc += er * bbr[pp * 16 + h2] - ei * bbi[pp * 16 + h2];
        }
        if (k == 0 && h == h2) sacc += p.d_skip[g * 16 + h];
        Kt[tid] = sacc;
    }
    __syncthreads();
    bf16_t* WCAT = (bf16_t*)(p.ws + WS_WCAT) + (size_t)g * 256 * 384;
    bf16_t* WST = (bf16_t*)(p.ws + WS_WST) + (size_t)g * 256 * 256;
    for (int e = tid; e < 32 * 192; e += 512) {
        const int rl = e / 192, kk = (e - rl * 192) * 2;
        const int t = rl >> 1, hl = rl & 1, h = 2 * sub + hl;
        const int row = 128 * (h >> 3) + 32 * (t >> 2) + 16 * ((h >> 2) & 1) + 4 * (t & 3) + (h & 3);
        float v[2];
#pragma unroll
        for (int q = 0; q < 2; ++q) {
            const int k2 = kk + q;
            if (k2 < 128) { const int pp = k2 & 63; const float c_r = cr[h * 64 + pp], c_i = ci[h * 64 + pp], l_r = lkr[(t + 1) * 64 + pp], l_i = lki[(t + 1) * 64 + pp];
                v[q] = k2 < 64 ? (c_r * l_r - c_i * l_i) : -(c_r * l_i + c_i * l_r); }
            else { const int s2 = (k2 - 128) >> 4, h2 = (k2 - 128) & 15; v[q] = s2 <= t ? Kt[((t - s2) * 2 + hl) * 16 + h2] : 0.f; }
        }
        *(unsigned*)(WCAT + (size_t)row * 384 + kk) = pk2(v[0], v[1]);
    }
    for (int e = tid; e < 32 * 128; e += 512) {
        const int rl = e >> 7, kk = (e & 127) * 2;
        const int row = rl < 16 ? 16 * sub + rl : 128 + 16 * sub + (rl - 16);
        float v[2] = {0.f, 0.f};
        if (row < 128) {
            const int pp = row & 63;
#pragma unroll
            for (int q = 0; q < 2; ++q) { const int s2 = (kk + q) >> 4, h = (kk + q) & 15; const float l_r = lkr[(15 - s2) * 64 + pp], l_i = lki[(15 - s2) * 64 + pp], b_r = bbr[pp * 16 + h], b_i = bbi[pp * 16 + h];
                v[q] = row < 64 ? (l_r * b_r - l_i * b_i) : (l_r * b_i + l_i * b_r); }
        }
        *(unsigned*)(WST + (size_t)row * 256 + kk) = pk2(v[0], v[1]);
    }
    if (sub == 0 && tid < 64) { float* L16 = (float*)(p.ws + WS_LAM16) + (g * 64 + tid) * 2; L16[0] = lkr[16 * 64 + tid]; L16[1] = lki[16 * 64 + tid]; }
    __syncthreads();
}

__device__ __forceinline__ void phase_prep(const Params& p, LAS unsigned char* lds) {
    const int tid = threadIdx.x, lane = tid & 63, wave = tid >> 6, G = 256, bid = blockIdx.x;
    for (int item = bid; item < 256; item += G) ssm_group_prep(p, item, (LAS float*)lds);
    const int gw = bid * 8 + wave, NGW = G * 8;
    {
        bf16_t* XB = (bf16_t*)(p.ws + WS_XB); float* RS = (float*)(p.ws + WS_RS);
        for (int row = gw; row < NTOK; row += NGW) {
            const f32x4* xr = (const f32x4*)(p.x + (size_t)row * DM) + lane;
            f32x4 v[4]; float s = 0.f;
#pragma unroll
            for (int j = 0; j < 4; ++j) { v[j] = xr[64 * j]; s += (v[j][0] * v[j][0] + v[j][1] * v[j][1]) + (v[j][2] * v[j][2] + v[j][3] * v[j][3]); }
            s = wave_sum(s);
            if (lane == 0) RS[row] = 1.0f / sqrtf(s * (1.f / DM) + 1e-6f);
            u32x2* o = (u32x2*)(XB + (size_t)row * DM) + lane;
#pragma unroll
            for (int j = 0; j < 4; ++j) o[64 * j] = (u32x2){pk2(v[j][0], v[j][1]), pk2(v[j][2], v[j][3])};
        }
    }
    {
        LAS float* scr = (LAS float*)(lds + 49152) + wave * (64 * 33);
        constexpr int I_IN = (DM / 64) * (NPROJ / 32), I_OUT = (DM / 64) * (DM / 32), I_GLU = (512 / 64) * (512 / 32);
        for (int it = gw; it < I_IN + I_OUT + I_GLU; it += NGW) {
            int r = it;
            if (r < I_IN) { transpose_item<0>(p.w_in, DM, NPROJ, (bf16_t*)(p.ws + WS_WINT), p.norm_gain, scr, r, lane); continue; } r -= I_IN;
            if (r < I_OUT) { transpose_item<1>(p.w_out, DM, DM, (bf16_t*)(p.ws + WS_WOUTT), nullptr, scr, r, lane); continue; } r -= I_OUT;
            transpose_item<1>(p.w_glu, 512, 512, (bf16_t*)(p.ws + WS_WGLUT), nullptr, scr, r, lane);
        }
    }
    {
        float* COS = (float*)(p.ws + WS_COS); float* SIN = (float*)(p.ws + WS_SIN); float* KSUM = (float*)(p.ws + WS_KSUM);
        for (int i = bid * 512 + tid; i < SEQ * 32; i += G * 512) {
            const int pos = i >> 5, f = i & 31;
            const float inv = 1.0f / powf(10000.0f, (float)f * (1.f / 32.f));
            const float ang = (float)pos * inv; float sn, cs; sincosf(ang, &sn, &cs);
            COS[i] = cs; SIN[i] = sn;
        }
        for (int i = bid * 512 + tid; i < 4096; i += G * 512) KSUM[i] = 0.f;
    }
}

__device__ __forceinline__ int swap23(int r) { return (r & ~12) | ((r & 4) << 1) | ((r & 8) >> 1); }

typedef float f32x2 __attribute__((ext_vector_type(2)));
__device__ __forceinline__ float max3f(float a, float b, float c) { float r; asm("v_max3_f32 %0, %1, %2, %3" : "=v"(r) : "v"(a), "v"(b), "v"(c)); return r; }
template <bool DIAG>
__device__ __forceinline__ void attn_tile(LAS unsigned char* B, unsigned kf_off, unsigned vf_off, const bf16x8 (&qf)[4], f32x16& O0, f32x16& O1, float& mrun, float& lrun,
                                          bool on, int kpos0, int qpos, int hh) {
    constexpr int ROWB = 144;
    const float cinit = on ? -mrun : -1e30f;
    f32x16 st0, st1;
#pragma unroll
    for (int i = 0; i < 16; ++i) { st0[i] = cinit; st1[i] = cinit; }
#pragma unroll
    for (int s = 0; s < 4; ++s) {
        const bf16x8 k0 = *(const LAS bf16x8*)(B + kf_off + s * 32), k1 = *(const LAS bf16x8*)(B + kf_off + 32 * ROWB + s * 32);
        st0 = __builtin_amdgcn_mfma_f32_32x32x16_bf16(k0, qf[s], st0, 0, 0, 0);
        st1 = __builtin_amdgcn_mfma_f32_32x32x16_bf16(k1, qf[s], st1, 0, 0, 0);
    }
    if (DIAG) {
#pragma unroll
        for (int i = 0; i < 16; ++i) {
            const int key = kpos0 + (i & 7) + 8 * hh + 16 * (i >> 3);
            if (key > qpos) st0[i] = -1e30f;
            if (key + 32 > qpos) st1[i] = -1e30f;
        }
    }
    float mx = max3f(st0[0], st0[1], st0[2]);
#pragma unroll
    for (int i = 3; i < 15; i += 2) mx = max3f(mx, st0[i], st0[i + 1]);
    mx = max3f(mx, st0[15], st1[0]);
#pragma unroll
    for (int i = 1; i < 15; i += 2) mx = max3f(mx, st1[i], st1[i + 1]);
    mx = fmaxf(mx, st1[15]);
    mx = fmaxf(mx, __shfl_xor(mx, 32));
    const bool grow = on && (mx > 8.f);
    if (__ballot(grow) != 0ull) {
        const float d = grow ? mx : 0.f;
        const float alpha = __builtin_amdgcn_exp2f(-d);
        lrun *= alpha; mrun += d;
#pragma unroll
        for (int i = 0; i < 16; ++i) { O0[i] *= alpha; O1[i] *= alpha; st0[i] -= d; st1[i] -= d; }
    }
    float rsum = 0.f;
#pragma unroll
    for (int i = 0; i < 16; ++i) { const float p0 = __builtin_amdgcn_exp2f(st0[i]), p1 = __builtin_amdgcn_exp2f(st1[i]); st0[i] = p0; st1[i] = p1; rsum += p0; rsum += p1; }
    rsum += __shfl_xor(rsum, 32);
    lrun += rsum;
#pragma unroll
    for (int s4 = 0; s4 < 4; ++s4) {
        u32x4 t4;
        if (s4 < 2) t4 = (u32x4){pk2(st0[8 * s4], st0[8 * s4 + 1]), pk2(st0[8 * s4 + 2], st0[8 * s4 + 3]), pk2(st0[8 * s4 + 4], st0[8 * s4 + 5]), pk2(st0[8 * s4 + 6], st0[8 * s4 + 7])};
        else { const int s = s4 - 2; t4 = (u32x4){pk2(st1[8 * s], st1[8 * s + 1]), pk2(st1[8 * s + 2], st1[8 * s + 3]), pk2(st1[8 * s + 4], st1[8 * s + 5]), pk2(st1[8 * s + 6], st1[8 * s + 7])}; }
        const bf16x8 pf = __builtin_bit_cast(bf16x8, t4);
        const bf16x8 v0 = *(const LAS bf16x8*)(B + vf_off + s4 * 32), v1 = *(const LAS bf16x8*)(B + vf_off + 32 * ROWB + s4 * 32);
        O0 = __builtin_amdgcn_mfma_f32_32x32x16_bf16(v0, pf, O0, 0, 0, 0);
        O1 = __builtin_amdgcn_mfma_f32_32x32x16_bf16(v1, pf, O1, 0, 0, 0);
    }
}

__device__ __forceinline__ void attn_tile2(LAS unsigned char* BA, LAS unsigned char* BB, unsigned kf_off, unsigned vf_off, const bf16x8 (&qf)[4], f32x16& O0, f32x16& O1, float& mrun, float& lrun, bool on) {
    constexpr int ROWB = 144;
    const float cinit = on ? -mrun : -1e30f;
    f32x16 sa0, sa1, sb0, sb1;
#pragma unroll
    for (int i = 0; i < 16; ++i) { sa0[i] = cinit; sa1[i] = cinit; sb0[i] = cinit; sb1[i] = cinit; }
#pragma unroll
    for (int s = 0; s < 4; ++s) {
        const bf16x8 k0 = *(const LAS bf16x8*)(BA + kf_off + s * 32), k1 = *(const LAS bf16x8*)(BA + kf_off + 32 * ROWB + s * 32);
        const bf16x8 k2 = *(const LAS bf16x8*)(BB + kf_off + s * 32), k3 = *(const LAS bf16x8*)(BB + kf_off + 32 * ROWB + s * 32);
        sa0 = __builtin_amdgcn_mfma_f32_32x32x16_bf16(k0, qf[s], sa0, 0, 0, 0);
        sa1 = __builtin_amdgcn_mfma_f32_32x32x16_bf16(k1, qf[s], sa1, 0, 0, 0);
        sb0 = __builtin_amdgcn_mfma_f32_32x32x16_bf16(k2, qf[s], sb0, 0, 0, 0);
        sb1 = __builtin_amdgcn_mfma_f32_32x32x16_bf16(k3, qf[s], sb1, 0, 0, 0);
    }
    float mx = max3f(sa0[0], sa0[1], sa0[2]), my = max3f(sb0[0], sb0[1], sb0[2]);
#pragma unroll
    for (int i = 3; i < 15; i += 2) { mx = max3f(mx, sa0[i], sa0[i + 1]); my = max3f(my, sb0[i], sb0[i + 1]); }
    mx = max3f(mx, sa0[15], sa1[0]); my = max3f(my, sb0[15], sb1[0]);
#pragma unroll
    for (int i = 1; i < 15; i += 2) { mx = max3f(mx, sa1[i], sa1[i + 1]); my = max3f(my, sb1[i], sb1[i + 1]); }
    mx = max3f(mx, sa1[15], fmaxf(my, sb1[15]));
    mx = fmaxf(mx, __shfl_xor(mx, 32));
    const bool grow = on && (mx > 8.f);
    if (__ballot(grow) != 0ull) {
        const float d = grow ? mx : 0.f;
        const float alpha = __builtin_amdgcn_exp2f(-d);
        lrun *= alpha; mrun += d;
#pragma unroll
        for (int i = 0; i < 16; ++i) { O0[i] *= alpha; O1[i] *= alpha; sa0[i] -= d; sa1[i] -= d; sb0[i] -= d; sb1[i] -= d; }
    }
    float rsum = 0.f;
#define AT2_EXP(S0, S1) _Pragma("unroll") for (int i = 0; i < 16; ++i) { const float p0 = __builtin_amdgcn_exp2f(S0[i]), p1 = __builtin_amdgcn_exp2f(S1[i]); S0[i] = p0; S1[i] = p1; rsum += p0; rsum += p1; }
#define AT2_PV(S0, S1, BUF) _Pragma("unroll") for (int s4 = 0; s4 < 4; ++s4) { \
        u32x4 t4; \
        if (s4 < 2) t4 = (u32x4){pk2(S0[8 * s4], S0[8 * s4 + 1]), pk2(S0[8 * s4 + 2], S0[8 * s4 + 3]), pk2(S0[8 * s4 + 4], S0[8 * s4 + 5]), pk2(S0[8 * s4 + 6], S0[8 * s4 + 7])}; \
        else { const int s_ = s4 - 2; t4 = (u32x4){pk2(S1[8 * s_], S1[8 * s_ + 1]), pk2(S1[8 * s_ + 2], S1[8 * s_ + 3]), pk2(S1[8 * s_ + 4], S1[8 * s_ + 5]), pk2(S1[8 * s_ + 6], S1[8 * s_ + 7])}; } \
        const bf16x8 pf = __builtin_bit_cast(bf16x8, t4); \
        const bf16x8 v0 = *(const LAS bf16x8*)(BUF + vf_off + s4 * 32), v1 = *(const LAS bf16x8*)(BUF + vf_off + 32 * ROWB + s4 * 32); \
        O0 = __builtin_amdgcn_mfma_f32_32x32x16_bf16(v0, pf, O0, 0, 0, 0); \
        O1 = __builtin_amdgcn_mfma_f32_32x32x16_bf16(v1, pf, O1, 0, 0, 0); }
    AT2_EXP(sa0, sa1)
    AT2_PV(sa0, sa1, BA)
    AT2_EXP(sb0, sb1)
    AT2_PV(sb0, sb1, BB)
#undef AT2_EXP
#undef AT2_PV
    rsum += __shfl_xor(rsum, 32);
    lrun += rsum;
}

__device__ __forceinline__ void phase_attn(const Params& p, LAS unsigned char* lds, unsigned* queue) {
    const int tid = threadIdx.x, lane = tid & 63, w = __builtin_amdgcn_readfirstlane(tid >> 6), r = lane & 31, hh = lane >> 5;
    const bf16_t* Qg = (const bf16_t*)(p.ws + WS_Q); const bf16_t* Kg = (const bf16_t*)(p.ws + WS_K); const bf16_t* VTg = (const bf16_t*)(p.ws + WS_VT);
    const bf16_t* SZA = (const bf16_t*)(p.ws + WS_SZA); const float* KSUM = (const float*)(p.ws + WS_KSUM);
    bf16_t* MIXED = (bf16_t*)(p.ws + WS_XB);
    constexpr int ROWB = 144, TILEB = 64 * ROWB, BUFB = 2 * TILEB;
    const int srow = tid >> 3, sch = tid & 7;
    const unsigned st_off = (unsigned)(srow * ROWB + sch * 16);
    const unsigned kf_off = (unsigned)(swap23(r) * ROWB + hh * 16);
    const unsigned vf_off = (unsigned)(TILEB + r * ROWB + hh * 16);
    volatile LAS unsigned* tick = (volatile LAS unsigned*)(lds + 131072 + 8);
    for (;;) {
        if (tid == 0) *tick = __hip_atomic_fetch_add(queue, 1u, __ATOMIC_RELAXED, __HIP_MEMORY_SCOPE_AGENT);
        __syncthreads();
        const int idx = (int)*tick;
        if (idx >= 512) break;
        const int blk = 7 - (idx >> 6), bh = idx & 63, b = bh >> 3, h = bh & 7;
        const int qpos = blk * 256 + w * 32 + r;
        const bf16_t* Qp = Qg + ((size_t)bh * 2048 + qpos) * 64 + 8 * hh;
        bf16x8 qf[4];
#pragma unroll
        for (int s = 0; s < 4; ++s) qf[s] = *(const bf16x8*)(Qp + 16 * s);
        unsigned selmask;
        if (blk <= 3) selmask = (1u << blk) - 1u;
        else {
            float v1 = -3e38f, v2 = -3e38f, v3 = -3e38f; int i1 = 0, i2 = 0, i3 = 0;
#pragma unroll
            for (int j = 0; j < 7; ++j) {
                if (j < blk) {
                    const float* ks = KSUM + ((size_t)bh * 8 + j) * 64 + 8 * hh;
                    float gsum = 0.f;
#pragma unroll
                    for (int s = 0; s < 4; ++s) {
                        const f32x4 k0 = *(const f32x4*)(ks + 16 * s), k1 = *(const f32x4*)(ks + 16 * s + 4);
                        gsum += bf2f((unsigned short)qf[s][0]) * k0[0] + bf2f((unsigned short)qf[s][1]) * k0[1] + bf2f((unsigned short)qf[s][2]) * k0[2] + bf2f((unsigned short)qf[s][3]) * k0[3]
                              + bf2f((unsigned short)qf[s][4]) * k1[0] + bf2f((unsigned short)qf[s][5]) * k1[1] + bf2f((unsigned short)qf[s][6]) * k1[2] + bf2f((unsigned short)qf[s][7]) * k1[3];
                    }
                    gsum += __shfl_xor(gsum, 32);
                    if (gsum > v1) { v3 = v2; i3 = i2; v2 = v1; i2 = i1; v1 = gsum; i1 = j; }
                    else if (gsum > v2) { v3 = v2; i3 = i2; v2 = gsum; i2 = j; }
                    else if (gsum > v3) { v3 = gsum; i3 = j; }
                }
            }
            selmask = (1u << i1) | (1u << i2) | (1u << i3);
        }
        f32x16 O0, O1;
#pragma unroll
        for (int i = 0; i < 16; ++i) { O0[i] = 0.f; O1[i] = 0.f; }
        float mrun = 0.f, lrun = 0.f;
        const int ntile = 4 + 4 * blk;
        const bf16_t* Kst = Kg + ((size_t)bh * 2048 + srow) * 64 + sch * 8;
        const bf16_t* Vst = VTg + ((size_t)bh * 64 + srow) * 2048 + sch * 8;
        u32x4 kreg[2], vreg[2];
#pragma unroll
        for (int q = 0; q < 2; ++q) { const int kp = blk * 256 + 64 * q; kreg[q] = *(const u32x4*)(Kst + (size_t)kp * 64); vreg[q] = *(const u32x4*)(Vst + kp); }
#pragma unroll
        for (int q = 0; q < 2; ++q) { *(LAS u32x4*)(lds + q * BUFB + st_off) = kreg[q]; *(LAS u32x4*)(lds + q * BUFB + TILEB + st_off) = vreg[q]; }
        __syncthreads();
        for (int n = 0; n < ntile; n += 2) {
            if (n + 2 < ntile) {
#pragma unroll
                for (int q = 0; q < 2; ++q) { const int m = n + 2 + q; const int kp = m < 4 ? blk * 256 + 64 * m : ((m - 4) >> 2) * 256 + 64 * ((m - 4) & 3);
                    kreg[q] = *(const u32x4*)(Kst + (size_t)kp * 64); vreg[q] = *(const u32x4*)(Vst + kp); }
            }
            LAS unsigned char* SB = lds + ((n >> 1) & 1) * (2 * BUFB);
            if (n >= 4) {
                const bool on = (selmask >> ((n - 4) >> 2)) & 1u;
                if (__ballot(on) != 0ull) attn_tile2(SB, SB + BUFB, kf_off, vf_off, qf, O0, O1, mrun, lrun, on);
            } else {
#pragma unroll
                for (int q = 0; q < 2; ++q) {
                    const int nn = n + q;
                    const int kpos0 = blk * 256 + 64 * nn;
                    LAS unsigned char* B = SB + q * BUFB;
                    const int dt_ = w >> 1;
                    if (nn == dt_) attn_tile<true>(B, kf_off, vf_off, qf, O0, O1, mrun, lrun, true, kpos0, qpos, hh);
                    else if (nn < dt_) attn_tile<false>(B, kf_off, vf_off, qf, O0, O1, mrun, lrun, true, kpos0, qpos, hh);
                }
            }
            if (n + 2 < ntile) { LAS unsigned char* Bn = lds + (((n >> 1) + 1) & 1) * (2 * BUFB);
#pragma unroll
                for (int q = 0; q < 2; ++q) { *(LAS u32x4*)(Bn + q * BUFB + st_off) = kreg[q]; *(LAS u32x4*)(Bn + q * BUFB + TILEB + st_off) = vreg[q]; } }
            __syncthreads();
        }
        const float inv = 1.f / lrun;
        const size_t row = (size_t)b * 2048 + qpos;
#pragma unroll
        for (int dt = 0; dt < 2; ++dt)
#pragma unroll
            for (int g4 = 0; g4 < 4; ++g4) {
                const int d0 = 32 * dt + 8 * g4 + 4 * hh;
                const u32x2 z2 = *(const u32x2*)(SZA + row * 512 + h * 64 + d0);
                float o0, o1, o2, o3;
                if (dt == 0) { o0 = O0[4 * g4]; o1 = O0[4 * g4 + 1]; o2 = O0[4 * g4 + 2]; o3 = O0[4 * g4 + 3]; }
                else { o0 = O1[4 * g4]; o1 = O1[4 * g4 + 1]; o2 = O1[4 * g4 + 2]; o3 = O1[4 * g4 + 3]; }
                o0 *= inv * bflo(z2[0]); o1 *= inv * bfhi(z2[0]); o2 *= inv * bflo(z2[1]); o3 *= inv * bfhi(z2[1]);
                *(u32x2*)(MIXED + row * 1024 + h * 64 + d0) = (u32x2){pk2(o0, o1), pk2(o2, o3)};
            }
    }
}

__device__ __forceinline__ void scan_unit(const Params& p, LAS unsigned char* lds, int L) {
    const int tid = threadIdx.x, lane = tid & 63, wave = __builtin_amdgcn_readfirstlane(tid >> 6);
    float* SST = (float*)(p.ws + WS_SST); bf16_t* XU = (bf16_t*)(p.ws + WS_XU); const float* L16 = (const float*)(p.ws + WS_LAM16);
    LAS float* E = (LAS float*)lds;
    const int g = L >> 2;
    const float lr = L16[(g * 64 + lane) * 2], li = L16[(g * 64 + lane) * 2 + 1];
    float pr = lr, pi = li;
#pragma unroll
    for (int q = 0; q < 4; ++q) { const float nr = pr * pr - pi * pi, ni = 2.f * pr * pi; pr = nr; pi = ni; }
    for (int bb = 0; bb < 2; ++bb) {
        const size_t base = (size_t)256 * L + 128 * bb + 16 * wave;
        float sr[16], si[16];
#pragma unroll
        for (int c = 0; c < 16; ++c) { sr[c] = __hip_atomic_load(SST + (base + c) * 128 + lane, __ATOMIC_RELAXED, __HIP_MEMORY_SCOPE_AGENT); si[c] = __hip_atomic_load(SST + (base + c) * 128 + 64 + lane, __ATOMIC_RELAXED, __HIP_MEMORY_SCOPE_AGENT); }
        float er = 0.f, ei = 0.f;
#pragma unroll
        for (int c = 0; c < 16; ++c) { const float nr = lr * er - li * ei + sr[c], ni = lr * ei + li * er + si[c]; er = nr; ei = ni; }
        E[(wave * 2) * 64 + lane] = er; E[(wave * 2 + 1) * 64 + lane] = ei;
        __syncthreads();
        float Xr = 0.f, Xi = 0.f;
        for (int s2 = 0; s2 < wave; ++s2) { const float e_r = E[(s2 * 2) * 64 + lane], e_i = E[(s2 * 2 + 1) * 64 + lane]; const float nr = pr * Xr - pi * Xi + e_r, ni = pr * Xi + pi * Xr + e_i; Xr = nr; Xi = ni; }
#pragma unroll
        for (int c = 0; c < 16; ++c) {
            const size_t R = base + c;
            XU[R * 384 + lane] = (bf16_t)(pk2(Xr, 0.f) & 0xffffu); XU[R * 384 + 64 + lane] = (bf16_t)(pk2(Xi, 0.f) & 0xffffu);
            const float nr = lr * Xr - li * Xi + sr[c], ni = lr * Xi + li * Xr + si[c]; Xr = nr; Xi = ni;
        }
        __syncthreads();
    }
}

__device__ __forceinline__ void phase_norm(const Params& p) {
    const int tid = threadIdx.x, lane = tid & 63, wave = tid >> 6, G = gridDim.x;
    const float* SSQ = (const float*)(p.ws + WS_SSQ);
    f32x4 gn[4];
#pragma unroll
    for (int j = 0; j < 4; ++j) gn[j] = *((const f32x4*)p.final_gain + lane + 64 * j);
    for (int row = blockIdx.x * 8 + wave; row < NTOK; row += 8 * G) {
        float s = 0.f;
#pragma unroll
        for (int i = 0; i < 16; ++i) s += SSQ[row * 16 + i];
        const float rinv = 1.0f / sqrtf(s * (1.f / DM) + 1e-6f);
        f32x4* o = (f32x4*)(p.out + (size_t)row * DM) + lane;
#pragma unroll
        for (int j = 0; j < 4; ++j) { f32x4 v = o[64 * j]; v = v * rinv * gn[j]; o[64 * j] = v; }
    }
}

__global__ __launch_bounds__(512, 2) void hymba_fwd(Params p) {
    extern __shared__ __attribute__((aligned(16))) unsigned char shm_raw[];
    LAS unsigned char* lds = (LAS unsigned char*)shm_raw;
    cg::grid_group grid = cg::this_grid();
    constexpr int G = 256;
    const int bid = blockIdx.x;
    unsigned char* ws = p.ws;
#if N_LAUNCH == 1
    constexpr int lo = 0, hi = NPH;
#else
    const int lo = p.ph_lo, hi = p.ph_hi;
#endif
    if (threadIdx.x < 4) ((LAS unsigned*)(lds + 131072))[threadIdx.x] = 0u;
    __syncthreads();
    XcdBarrier xbar = xcd_barrier_post((unsigned*)(ws + WS_BAR), (volatile LAS unsigned*)(lds + 131072));
    if (hi > 1000) grid.sync();
#define IN(k) (PH_ON(k) && lo <= (k) && (k) < hi)
#define SEAM(k) do { if (lo <= (k) && (k) + 1 < hi) xcd_barrier(xbar); } while (0)
    if (IN(0)) { phase_prep(p, lds); }
    SEAM(0);
    if (IN(1)) {
        pg8::Gemm g{(const bf16_t*)(ws + WS_XB), (const bf16_t*)(ws + WS_WINT)};
        pg8::StaticOrder<NTOK, NPROJ> S{bid};
        EpiInProj E{(const float*)(ws + WS_RS), (const float*)(ws + WS_COS), (const float*)(ws + WS_SIN),
                    (bf16_t*)(ws + WS_Q), (bf16_t*)(ws + WS_K), (bf16_t*)(ws + WS_VT), (bf16_t*)(ws + WS_SZA), (bf16_t*)(ws + WS_SZS), (bf16_t*)(ws + WS_XU), (float*)(ws + WS_KSUM)};
        pg8::gemm_phase<DM, DM, DM>(lds, g, S, E);
    }
    SEAM(1);
    if (IN(2)) {
        unsigned* cnt = (unsigned*)(ws + WS_BAR) + XCD_BAR_WORDS;
        if (bid < 128) {
            const int L = bid;
            {
                pg8::Gemm g{(const bf16_t*)(ws + WS_XU) + 128, (const bf16_t*)(ws + WS_WST)};
                pg8::OneUnit S{L, L >> 2};
                EpiS E{(float*)(ws + WS_SST)};
                pg8::gemm_phase<384, 256, 256, false, true, false>(lds, g, S, E);
            }
            asm volatile("s_waitcnt vmcnt(0)" ::: "memory");
            __syncthreads();
            scan_unit(p, lds, L);
            asm volatile("s_waitcnt vmcnt(0)" ::: "memory");
            __syncthreads();
            {
                pg8::Gemm g{(const bf16_t*)(ws + WS_XU), (const bf16_t*)(ws + WS_WCAT)};
                pg8::OneUnit S{L, L >> 2};
                EpiY E{(bf16_t*)(ws + WS_YG)};
                pg8::gemm_phase<384, 384, 384, false, true, false>(lds, g, S, E);
            }
            asm volatile("s_waitcnt vmcnt(0)" ::: "memory");
            __syncthreads();
            if (threadIdx.x == 0) {
                __builtin_amdgcn_fence(__ATOMIC_RELEASE, "agent");
                asm volatile("s_waitcnt vmcnt(0)" ::: "memory");
                __hip_atomic_fetch_add(cnt + 64 * (L & 3), 1u, __ATOMIC_RELAXED, __HIP_MEMORY_SCOPE_AGENT);
            }
        }
        if (bid < 128) {
            const int U = bid;
            const int pm = U >> 1, pn = U & 1;
            if (threadIdx.x == 0) {
                unsigned sp = 0;
                while (__hip_atomic_load(cnt + 64 * (pm >> 4), __ATOMIC_RELAXED, __HIP_MEMORY_SCOPE_AGENT) < 32u) { __builtin_amdgcn_s_sleep(2); if (++sp > (1u << 22)) break; }
                __builtin_amdgcn_fence(__ATOMIC_ACQUIRE, "agent");
                asm volatile("s_waitcnt vmcnt(0)" ::: "memory");
            }
            __syncthreads();
            pg8::Gemm g{(const bf16_t*)(ws + WS_YG), (const bf16_t*)(ws + WS_WGLUT)};
            pg8::OneUnit S{pm, pn};
            EpiGlu E{(const bf16_t*)(ws + WS_YG), (const bf16_t*)(ws + WS_SZS), p.b_glu, (bf16_t*)(ws + WS_XB)};
            pg8::gemm_phase<512, 512, 512, false, true, false>(lds, g, S, E);
        }
        phase_attn(p, lds, cnt + 256);
    }
    SEAM(2);
    if (G == 256) {
        if (IN(6)) {
            pg8::Gemm g{(const bf16_t*)(ws + WS_XB), (const bf16_t*)(ws + WS_WOUTT)};
            pg8::StaticOrder<NTOK, DM> S{bid};
            EpiOutFused E{p.x, p.out, (float*)(ws + WS_SSQ), p.final_gain, xbar};
            pg8::gemm_phase<DM, DM, DM, true, true, true>(lds, g, S, E);
        }
    } else {
        if (IN(6)) {
            pg8::Gemm g{(const bf16_t*)(ws + WS_XB), (const bf16_t*)(ws + WS_WOUTT)};
            pg8::StaticOrder<NTOK, DM> S{bid};
            EpiOut E{p.x, p.out, (float*)(ws + WS_SSQ)};
            pg8::gemm_phase<DM, DM, DM>(lds, g, S, E);
        }
        SEAM(6);
        if (IN(7)) { phase_norm(p); }
    }
#undef IN
#undef SEAM
}

extern "C" void kernel_launch(void* const* d_in, const int* in_sizes, int n_in, void* d_out, int out_size, void* d_ws, size_t ws_size, hipStream_t stream) {
    static int grid = 0;
    if (grid == 0) {
        if (n_in != 15 || in_sizes[0] != NTOK * DM || out_size != NTOK * DM || ws_size < WS_END) { fprintf(stderr, "kernel_launch: unexpected shapes (n_in %d, in0 %d, out %d, ws %zu)\n", n_in, n_in > 0 ? in_sizes[0] : -1, out_size, ws_size); grid = -1; return; }
        int dev = 0, cus = 0, per_cu = 0;
        (void)hipGetDevice(&dev); (void)hipDeviceGetAttribute(&cus, hipDeviceAttributeMultiprocessorCount, dev);
        if (hipFuncSetAttribute((const void*)hymba_fwd, hipFuncAttributeMaxDynamicSharedMemorySize, LDS_BYTES) != hipSuccess) { fprintf(stderr, "kernel_launch: hipFuncSetAttribute failed\n"); grid = -1; return; }
        if (hipOccupancyMaxActiveBlocksPerMultiprocessor(&per_cu, (const void*)hymba_fwd, 512, LDS_BYTES) != hipSuccess || per_cu < 1) { fprintf(stderr, "kernel_launch: occupancy query says %d\n", per_cu); per_cu = 1; }
        (void)hipGetLastError();
        if (cus != 256) { fprintf(stderr, "kernel_launch: built for a 256-CU device (one workgroup per CU), found %d CUs; nothing launched\n", cus); grid = -1; return; }
        grid = 256;
    }
    if (grid < 0) return;
    if (hipMemsetAsync((char*)d_ws + WS_BAR, 0, (XCD_BAR_WORDS + 512) * 4, stream) != hipSuccess) { fprintf(stderr, "kernel_launch: memset of barrier words failed\n"); return; }
    Params p{};
    p.x = (const float*)d_in[0]; p.norm_gain = (const float*)d_in[1]; p.w_in = (const float*)d_in[2]; p.w_out = (const float*)d_in[3];
    p.lam_re = (const float*)d_in[4]; p.lam_im = (const float*)d_in[5]; p.b_re = (const float*)d_in[6]; p.b_im = (const float*)d_in[7];
    p.c_re = (const float*)d_in[8]; p.c_im = (const float*)d_in[9]; p.d_skip = (const float*)d_in[10]; p.log_dt = (const float*)d_in[11];
    p.w_glu = (const float*)d_in[12]; p.b_glu = (const float*)d_in[13]; p.final_gain = (const float*)d_in[14];
    p.out = (float*)d_out; p.ws = (unsigned char*)d_ws;
#if N_LAUNCH == 1
    p.ph_lo = 0; p.ph_hi = NPH;
    void* args[] = {&p};
    hipError_t e = hipLaunchCooperativeKernel((const void*)hymba_fwd, dim3(grid), dim3(512), args, LDS_BYTES, stream);
    if (e != hipSuccess) fprintf(stderr, "cooperative launch failed: %s (grid %d)\n", hipGetErrorString(e), grid);
#else
    for (int ph = 0; ph < NPH; ++ph) {
        p.ph_lo = ph; p.ph_hi = ph + 1;
        hipLaunchKernelGGL(hymba_fwd, dim3(grid), dim3(512), LDS_BYTES, stream, p);
    }
#endif
}
```

```cpp
#include <hip/hip_runtime.h>
#include <hip/hip_cooperative_groups.h>
#include <cstdio>
#include <cstdint>
namespace cg = cooperative_groups;

#ifndef ONLY_PH
#define ONLY_PH -1
#endif
#define PH_ON(x) (ONLY_PH < 0 || ONLY_PH == (x))
#ifndef N_LAUNCH
#define N_LAUNCH 1
#endif

#define LAS __attribute__((address_space(3)))
typedef unsigned short bf16_t;
typedef short bf16x8 __attribute__((ext_vector_type(8)));
typedef float f32x4 __attribute__((ext_vector_type(4)));
typedef float f32x16 __attribute__((ext_vector_type(16)));
typedef unsigned u32x2 __attribute__((ext_vector_type(2)));
typedef unsigned u32x4 __attribute__((ext_vector_type(4)));

constexpr int NTOK = 16384, DM = 1024, SEQ = 2048, NPROJ = 3072;
constexpr int NPH = 8;
constexpr size_t MBy = 1u << 20;
constexpr size_t WS_XB = 0;
constexpr size_t WS_WINT = 32 * MBy;
constexpr size_t WS_WOUTT = 38 * MBy;
constexpr size_t WS_WGLUT = 40 * MBy;
constexpr size_t WS_WST = 41 * MBy;
constexpr size_t WS_WCAT = 45 * MBy;
constexpr size_t WS_LAM16 = 51 * MBy;
constexpr size_t WS_RS = WS_LAM16 + 64 * 1024;
constexpr size_t WS_COS = WS_RS + 64 * 1024;
constexpr size_t WS_SIN = WS_COS + 256 * 1024;
constexpr size_t WS_KSUM = WS_SIN + 256 * 1024;
constexpr size_t WS_Q = 52 * MBy;
constexpr size_t WS_K = 68 * MBy;
constexpr size_t WS_VT = 84 * MBy;
constexpr size_t WS_SZA = 100 * MBy;
constexpr size_t WS_SZS = 116 * MBy;
constexpr size_t WS_XU = 132 * MBy;
constexpr size_t WS_SST = 156 * MBy;
constexpr size_t WS_YG = 172 * MBy;
constexpr size_t WS_SSQ = 188 * MBy;
constexpr size_t WS_BAR = 189 * MBy;
constexpr size_t WS_END = 190 * MBy;
constexpr int LDS_BYTES = 131072 + 16;

struct Params {
    const float *x, *norm_gain, *w_in, *w_out, *lam_re, *lam_im, *b_re, *b_im, *c_re, *c_im, *d_skip, *log_dt, *w_glu, *b_glu, *final_gain;
    float* out; unsigned char* ws;
    int ph_lo, ph_hi;
};

typedef float f32x2c_t __attribute__((ext_vector_type(2)));
typedef __bf16 bf16x2c_t __attribute__((ext_vector_type(2)));
__device__ __forceinline__ unsigned pk2(float lo, float hi) { const f32x2c_t v = {lo, hi}; return __builtin_bit_cast(unsigned, __builtin_convertvector(v, bf16x2c_t)); }
__device__ __forceinline__ float bf2f(unsigned short b) { return __uint_as_float(((unsigned)b) << 16); }
__device__ __forceinline__ float bflo(unsigned w) { return __uint_as_float(w << 16); }
__device__ __forceinline__ float bfhi(unsigned w) { return __uint_as_float(w & 0xffff0000u); }
__device__ __forceinline__ float wave_sum(float v) {
#pragma unroll
    for (int o = 1; o < 64; o <<= 1) v += __shfl_xor(v, o);
    return v;
}
__device__ __forceinline__ float sigmoidf_(float v) { return __builtin_amdgcn_rcpf(1.f + __expf(-v)); }
__device__ __forceinline__ float siluf_(float v) { return v * sigmoidf_(v); }
__device__ __forceinline__ float gelu_tanh(float y) { const float t = 1.5957691216f * (y + 0.044715f * y * y * y); return y * sigmoidf_(t); }


#define XB_TMO      128
#define XB_XCNT(j)  (256  + 64 * (j))
#define XB_XSUB(j)  (1280 + 64 * (j))
#define XB_XGEN(j)  (2304 + 64 * (j))
#define XB_TOP      3328
#define XB_TOPGEN   3392
#define XCD_BAR_WORDS 3456
#define XB_SPIN_CAP (1u << 18)
__device__ __forceinline__ unsigned xb_ld(unsigned* p)              { return __hip_atomic_load(p, __ATOMIC_RELAXED, __HIP_MEMORY_SCOPE_AGENT); }
__device__ __forceinline__ unsigned xb_add(unsigned* p, unsigned v) { return __hip_atomic_fetch_add(p, v, __ATOMIC_RELAXED, __HIP_MEMORY_SCOPE_AGENT); }
__device__ __forceinline__ unsigned xb_xcc_id() { return (unsigned)__builtin_amdgcn_s_getreg((3 << 11) | 20) & 0xFu; }
#define XB_SPIN(cond, bar) do { unsigned _sp = 0; while (cond) { __builtin_amdgcn_s_sleep(1); \
    if ((++_sp & 255u) == 0u) { if (xb_ld(&(bar)[XB_TMO])) break; if (_sp > XB_SPIN_CAP) { atomicAdd(&(bar)[XB_TMO], 1u); break; } } } } while (0)
struct XcdBarrier { unsigned* bar; unsigned x; volatile LAS unsigned* st; };
__device__ __forceinline__ XcdBarrier xcd_barrier_post(unsigned* bar, volatile LAS unsigned* st) {
    XcdBarrier b; b.bar = bar; b.x = xb_xcc_id(); b.st = st;
    if (threadIdx.x == 0) (void)xb_add(&bar[XB_XCNT(b.x)], 1u);
    return b;
}
__device__ __forceinline__ void xcd_barrier_complete(unsigned* bar, unsigned x, unsigned& nloc, unsigned& nx) {
    const unsigned G = 256u;
    unsigned sum, cnt, mine, sp = 0u;
    for (;;) {
        sum = 0u; cnt = 0u; mine = 0u;
#pragma unroll
        for (unsigned j = 0; j < 16; ++j) { const unsigned c = xb_ld(&bar[XB_XCNT(j)]); sum += c; cnt += (c > 0u) ? 1u : 0u; mine = (j == x) ? c : mine; }
        if (sum == G) break;
        __builtin_amdgcn_s_sleep(1);
        if ((++sp & 255u) == 0u) { if (xb_ld(&bar[XB_TMO])) break; if (sp > XB_SPIN_CAP) { atomicAdd(&bar[XB_TMO], 1u); break; } }
    }
    nloc = mine > 0u ? mine : 1u; nx = cnt > 0u ? cnt : 1u;
}
__device__ __forceinline__ void xcd_barrier(const XcdBarrier& b) {
    asm volatile("s_waitcnt vmcnt(0)" ::: "memory");
    __syncthreads();
    if (threadIdx.x == 0) {
        unsigned* bar = b.bar;
        __builtin_amdgcn_s_waitcnt(0);
        unsigned nloc = b.st[0], nx = b.st[1];
        if (nloc == 0u) { xcd_barrier_complete(bar, b.x, nloc, nx); b.st[0] = nloc; b.st[1] = nx; }
        const unsigned old = xb_add(&bar[XB_XSUB(b.x)], 1u);
        const unsigned gen = old / nloc;
        if (old + 1u == (gen + 1u) * nloc) {
            __builtin_amdgcn_fence(__ATOMIC_RELEASE, "agent");
            asm volatile("s_waitcnt vmcnt(0)" ::: "memory");
            const unsigned og = xb_add(&bar[XB_TOP], 1u);
            const unsigned tg = og / nx;
            if (og + 1u == (tg + 1u) * nx) xb_add(&bar[XB_TOPGEN], 1u);
            else XB_SPIN(xb_ld(&bar[XB_TOPGEN]) == tg, bar);
            __builtin_amdgcn_fence(__ATOMIC_ACQUIRE, "agent");
            xb_add(&bar[XB_XGEN(b.x)], 1u);
            asm volatile("s_waitcnt vmcnt(0)" ::: "memory");
        } else {
            XB_SPIN(xb_ld(&bar[XB_XGEN(b.x)]) == gen, bar);
            __builtin_amdgcn_fence(__ATOMIC_ACQUIRE, "agent");
            asm volatile("s_waitcnt vmcnt(0)" ::: "memory");
        }
    }
    __syncthreads();
}

namespace pg8 {
constexpr int BM = 256, BK = 64, HALF = 128, HTB = HALF * BK * 2, STAGE_BYTES = 8 * HTB, NXCD = 8, WGM = 8;
__device__ __forceinline__ int lds_byte(int r, int c) { const int st = (r >> 4) * 2 + (c >> 5), rr = r & 15, cc = c & 31, ob = rr * 64 + cc * 2; return st * 1024 + (ob ^ (((ob >> 9) & 1) << 5)); }
__device__ __forceinline__ void stage_rc(int b, int& R, int& C) { const int st = b / 1024, sb = b % 1024, swz = sb ^ (((sb >> 9) & 1) << 5); R = (st >> 1) * 16 + swz / 64; C = (st & 1) * 32 + (swz % 64) / 2; }
struct Unit { int pm, pn; };
struct Gemm { const bf16_t* A; const bf16_t* Bt; };

template <int M, int N>
struct StaticOrder {
    static constexpr int nM = M / BM, nN = N / BM, nwg = nM * nN, G = 256;
    int c;
    __device__ bool next(int i, Unit& u) const {
        const int L = i * G + c; if (L >= nwg) return false;
        int wgid = L; { constexpr int q = nwg / NXCD, r = nwg % NXCD; const int xcd = wgid % NXCD, off = wgid / NXCD; wgid = (xcd < r ? xcd * (q + 1) : r * (q + 1) + (xcd - r) * q) + off; }
        constexpr int nig = WGM * nN; const int gid = wgid / nig, fm = gid * WGM, gsz = (nM - fm) < WGM ? (nM - fm) : WGM;
        u.pm = fm + ((wgid % nig) % gsz); u.pn = (wgid % nig) / gsz; return true;
    }
};
struct GroupOrder {
    int G, c;
    __device__ bool next(int i, Unit& u) const { const int L = i * G + c; if (L >= 128) return false; u.pm = L; u.pn = L >> 2; return true; }
};

struct OneUnit {
    int pm, pn;
    __device__ bool next(int i, Unit& u) const { if (i) return false; u.pm = pm; u.pn = pn; return true; }
};

template <int LDA, int LDB, int KK, bool AFTER = false, bool ALIGN_EPI = true, bool SP2 = true, class Epi, class Sched>
__device__ __forceinline__ void gemm_phase(LAS unsigned char* lds, const Gemm g, const Sched& S, const Epi& E) {
    const int tid = threadIdx.x, wid = __builtin_amdgcn_readfirstlane(tid >> 6), lane = tid & 63, wr = wid >> 2, wc = wid & 3, fr = lane & 15, fq = lane >> 4;
    constexpr int K = KK, nt = K / BK;
    unsigned voffA[2], voffB[2];
#pragma unroll
    for (int i = 0; i < 2; ++i) { int R, C; stage_rc(tid * 16 + i * 8192, R, C); voffA[i] = (unsigned)(R * LDA + C) * 2u; voffB[i] = (unsigned)(R * LDB + C) * 2u; }
    constexpr size_t kstep = (size_t)(BK * 2);
    constexpr size_t hstepA = (size_t)HALF * LDA * 2, hstepB = (size_t)HALF * LDB * 2;
    constexpr size_t tstepA = 2 * hstepA, tstepB = 2 * hstepB;
    const unsigned ldsw = (unsigned)wid * 1024u;
    const int aoff = lds_byte(wr * 64 + fr, fq * 8), boff = lds_byte(wc * 32 + fr, fq * 8);
#define PG8_SA(b, h) (((b) * 2 + (h)) * HTB)
#define PG8_SB(b, h) ((4 + (b) * 2 + (h)) * HTB)
#define PG8_STAGE(bufoff, gbase, voff) do { _Pragma("unroll") for (int _i = 0; _i < 2; ++_i) \
        __builtin_amdgcn_global_load_lds((const unsigned*)((const char*)(gbase) + (voff)[_i]), (LAS unsigned*)(lds + (bufoff) + ldsw + _i * 8192), 16, 0, 0); } while (0)
#define PG8_LDA(dst, b, h) do { _Pragma("unroll") for (int m = 0; m < 4; ++m) _Pragma("unroll") for (int k = 0; k < 2; ++k) dst[m][k] = *(const LAS bf16x8*)(lds + PG8_SA(b, h) + aoff + m * 2048 + k * 1024); } while (0)
#define PG8_LDB(dst, b, h) do { _Pragma("unroll") for (int n = 0; n < 2; ++n) _Pragma("unroll") for (int k = 0; k < 2; ++k) dst[n][k] = *(const LAS bf16x8*)(lds + PG8_SB(b, h) + boff + n * 2048 + k * 1024); } while (0)
#define PG8_MMA(ai, bj, At, Bt) do { __builtin_amdgcn_s_setprio(1); _Pragma("unroll") for (int m = 0; m < 4; ++m) _Pragma("unroll") for (int n = 0; n < 2; ++n) _Pragma("unroll") for (int k = 0; k < 2; ++k) \
        acc[ai][bj][m][n] = __builtin_amdgcn_mfma_f32_16x16x32_bf16(Bt[n][k], At[m][k], acc[ai][bj][m][n], 0, 0, 0); __builtin_amdgcn_s_setprio(0); } while (0)
#define PG8_WAIT_V(n) asm volatile("s_waitcnt vmcnt(" #n ")" ::: "memory")
#define PG8_WAIT_L(n) asm volatile("s_waitcnt lgkmcnt(" #n ")" ::: "memory")
#define PG8_BAR __builtin_amdgcn_s_barrier()
#define PG8_SCHED __builtin_amdgcn_sched_barrier(0)
    Unit cur, nxt; int ui = 0;
    if (!S.next(0, cur)) return;
    f32x4 acc[2][2][4][2];
#pragma unroll
    for (int a = 0; a < 2; ++a)
#pragma unroll
        for (int b = 0; b < 2; ++b)
#pragma unroll
            for (int m = 0; m < 4; ++m)
#pragma unroll
                for (int n = 0; n < 2; ++n) acc[a][b][m][n] = (f32x4){0.f, 0.f, 0.f, 0.f};
    bf16x8 At[4][2], B0[2][2], B1[2][2];
    const char* cA = (const char*)g.A + (size_t)cur.pm * tstepA; const char* cB = (const char*)g.Bt + (size_t)cur.pn * tstepB;
    if constexpr (SP2) {
        PG8_STAGE(PG8_SB(0, 0), cB, voffB); PG8_STAGE(PG8_SB(0, 1), cB + hstepB, voffB); PG8_STAGE(PG8_SA(0, 0), cA, voffA); PG8_STAGE(PG8_SA(0, 1), cA + hstepA, voffA);
        if (wr == 1) PG8_BAR;
        PG8_WAIT_V(2); PG8_BAR;
        PG8_STAGE(PG8_SB(1, 0), cB + kstep, voffB); PG8_STAGE(PG8_SA(1, 0), cA + kstep, voffA); PG8_STAGE(PG8_SB(1, 1), cB + hstepB + kstep, voffB);
        PG8_WAIT_V(6); PG8_BAR;
    } else {
        PG8_STAGE(PG8_SB(0, 0), cB, voffB); PG8_STAGE(PG8_SA(0, 0), cA, voffA); PG8_STAGE(PG8_SB(0, 1), cB + hstepB, voffB); PG8_STAGE(PG8_SA(0, 1), cA + hstepA, voffA);
        if (wr == 1) PG8_BAR;
        PG8_WAIT_V(4); PG8_BAR;
        PG8_STAGE(PG8_SB(1, 0), cB + kstep, voffB); PG8_STAGE(PG8_SA(1, 0), cA + kstep, voffA); PG8_STAGE(PG8_SB(1, 1), cB + hstepB + kstep, voffB);
        PG8_WAIT_V(6); PG8_BAR;
    }
    for (;;) {
        const bool has_next = S.next(ui + 1, nxt);
        const char* nA = has_next ? (const char*)g.A + (size_t)nxt.pm * tstepA : cA; const char* nB = has_next ? (const char*)g.Bt + (size_t)nxt.pn * tstepB : cB;
        for (int t = 0; t < nt; t += 2) {
            const bool last = (t == nt - 2);
            const char* a1 = cA + (size_t)(t + 1) * kstep;
            const char* a2 = last ? nA : cA + (size_t)(t + 2) * kstep; const char* b2 = last ? nB : cB + (size_t)(t + 2) * kstep;
            const char* a3 = a2 + kstep; const char* b3 = b2 + kstep;
            if constexpr (SP2) {
            PG8_LDB(B0, 0, 0); PG8_LDB(B1, 0, 1); PG8_SCHED; PG8_LDA(At, 0, 0); PG8_STAGE(PG8_SA(1, 1), a1 + hstepA, voffA);
            PG8_WAIT_V(8); PG8_WAIT_L(0); PG8_BAR; PG8_MMA(0, 0, At, B0); PG8_MMA(0, 1, At, B1); PG8_BAR; PG8_SCHED;
            PG8_LDA(At, 0, 1); PG8_STAGE(PG8_SB(0, 0), b2, voffB); PG8_STAGE(PG8_SB(0, 1), b2 + hstepB, voffB); PG8_STAGE(PG8_SA(0, 0), a2, voffA);
            PG8_WAIT_V(8); PG8_WAIT_L(0); PG8_BAR; PG8_MMA(1, 0, At, B0); PG8_MMA(1, 1, At, B1); PG8_BAR; PG8_SCHED;
            PG8_LDB(B0, 1, 0); PG8_LDB(B1, 1, 1); PG8_SCHED; PG8_LDA(At, 1, 0); PG8_STAGE(PG8_SA(0, 1), a2 + hstepA, voffA);
            PG8_WAIT_V(8); PG8_WAIT_L(0); PG8_BAR; PG8_MMA(0, 0, At, B0); PG8_MMA(0, 1, At, B1); PG8_BAR; PG8_SCHED;
            PG8_LDA(At, 1, 1); PG8_STAGE(PG8_SB(1, 0), b3, voffB); PG8_STAGE(PG8_SB(1, 1), b3 + hstepB, voffB); PG8_STAGE(PG8_SA(1, 0), a3, voffA);
            PG8_WAIT_V(8); PG8_WAIT_L(0); PG8_BAR; PG8_MMA(1, 0, At, B0); PG8_MMA(1, 1, At, B1); PG8_BAR; PG8_SCHED;
            } else {
            PG8_LDB(B0, 0, 0); PG8_SCHED; PG8_LDA(At, 0, 0); PG8_STAGE(PG8_SA(1, 1), a1 + hstepA, voffA);
            PG8_WAIT_L(8); PG8_BAR; PG8_WAIT_L(0); PG8_MMA(0, 0, At, B0); PG8_BAR; PG8_SCHED;
            PG8_LDB(B1, 0, 1); PG8_STAGE(PG8_SB(0, 0), b2, voffB);
            PG8_BAR; PG8_WAIT_L(0); PG8_MMA(0, 1, At, B1); PG8_BAR;
            PG8_LDA(At, 0, 1); PG8_STAGE(PG8_SA(0, 0), a2, voffA);
            PG8_BAR; PG8_WAIT_L(0); PG8_MMA(1, 0, At, B0); PG8_BAR; PG8_SCHED;
            PG8_STAGE(PG8_SB(0, 1), b2 + hstepB, voffB);
            PG8_WAIT_V(6); PG8_BAR; PG8_MMA(1, 1, At, B1); PG8_BAR;
            PG8_LDB(B0, 1, 0); PG8_SCHED; PG8_LDA(At, 1, 0); PG8_STAGE(PG8_SA(0, 1), a2 + hstepA, voffA);
            PG8_WAIT_L(8); PG8_BAR; PG8_WAIT_L(0); PG8_MMA(0, 0, At, B0); PG8_BAR; PG8_SCHED;
            PG8_LDB(B1, 1, 1); PG8_STAGE(PG8_SB(1, 0), b3, voffB);
            PG8_BAR; PG8_WAIT_L(0); PG8_MMA(0, 1, At, B1); PG8_BAR;
            PG8_LDA(At, 1, 1); PG8_STAGE(PG8_SA(1, 0), a3, voffA);
            PG8_BAR; PG8_WAIT_L(0); PG8_MMA(1, 0, At, B0); PG8_BAR; PG8_SCHED;
            PG8_STAGE(PG8_SB(1, 1), b3 + hstepB, voffB);
            PG8_WAIT_V(6); PG8_BAR; PG8_MMA(1, 1, At, B1); PG8_BAR;
                    }
        }
        if constexpr (ALIGN_EPI) { if (wr == 0) PG8_BAR; }
        E(acc, cur, wr, wc, fr, fq);
        if (!has_next) break;
#pragma unroll
        for (int a = 0; a < 2; ++a)
#pragma unroll
            for (int b = 0; b < 2; ++b)
#pragma unroll
                for (int m = 0; m < 4; ++m)
#pragma unroll
                    for (int n = 0; n < 2; ++n) acc[a][b][m][n] = (f32x4){0.f, 0.f, 0.f, 0.f};
        cur = nxt; cA = nA; cB = nB; ++ui;
        if constexpr (ALIGN_EPI) { if (wr == 1) PG8_BAR; }
    }
    PG8_WAIT_V(0);
    if constexpr (!ALIGN_EPI) { if (wr == 0) PG8_BAR; }
    PG8_BAR;
    if constexpr (AFTER) E.after(acc, cur, wr, wc, fr, fq);
#undef PG8_SA
#undef PG8_SB
#undef PG8_STAGE
#undef PG8_LDA
#undef PG8_LDB
#undef PG8_MMA
#undef PG8_WAIT_V
#undef PG8_WAIT_L
#undef PG8_BAR
#undef PG8_SCHED
}
}
using pg8::Unit;


__device__ __forceinline__ int inproj_row(int e) {
    const int pn = e >> 8, o = e & 255;
    const int wc = o >> 6, bj = (o >> 5) & 1, fq = (o >> 3) & 3, n = (o >> 2) & 1, i = o & 3;
    return 256 * pn + 128 * bj + 32 * wc + 16 * n + 4 * fq + i;
}

struct EpiInProj {
    const float *rs, *cosT, *sinT;
    bf16_t *Q, *Kk, *VT, *SZA, *SZS, *XU; float* KSUM;
    __device__ __forceinline__ void operator()(const f32x4 (&acc)[2][2][4][2], const Unit& u, int wr, int wc, int fr, int fq) const {
        const int seg = u.pn >> 1, half = u.pn & 1;
        const int b = u.pm >> 3, blk = u.pm & 7;
        const int lbase = blk * 256 + wr * 64 + fr;
        if (seg <= 1) {
            bf16_t* dst = seg == 0 ? Q : Kk; const float qs = seg == 0 ? 0.18033688011112042f : 1.0f;
            const int head = 4 * half + wc;
            f32x4 cl[2], ch[2];
#pragma unroll
            for (int n = 0; n < 2; ++n) { cl[n] = (f32x4){0.f, 0.f, 0.f, 0.f}; ch[n] = (f32x4){0.f, 0.f, 0.f, 0.f}; }
            bf16_t* obase = dst + ((size_t)((b * 8 + head) * 2048)) * 64 + 8 * fq;
#pragma unroll
            for (int ai = 0; ai < 2; ++ai)
#pragma unroll
                for (int m = 0; m < 4; ++m) {
                    const int l = lbase + 128 * ai + 16 * m; const float rsv = rs[b * 2048 + l] * qs;
                    unsigned wl[4], wh[4];
#pragma unroll
                    for (int n = 0; n < 2; ++n) {
                        const f32x4 c4 = *(const f32x4*)(cosT + l * 32 + 8 * fq + 4 * n), s4 = *(const f32x4*)(sinT + l * 32 + 8 * fq + 4 * n);
                        const f32x4 t1 = acc[ai][0][m][n] * rsv, t2 = acc[ai][1][m][n] * rsv;
                        const f32x4 lo = t1 * c4 - t2 * s4, hi = t2 * c4 + t1 * s4;
                        wl[2 * n] = pk2(lo[0], lo[1]); wl[2 * n + 1] = pk2(lo[2], lo[3]); wh[2 * n] = pk2(hi[0], hi[1]); wh[2 * n + 1] = pk2(hi[2], hi[3]);
                        cl[n] += lo; ch[n] += hi;
                    }
                    bf16_t* o = obase + (unsigned)l * 64u;
                    *(u32x4*)o = (u32x4){wl[0], wl[1], wl[2], wl[3]};
                    *(u32x4*)(o + 32) = (u32x4){wh[0], wh[1], wh[2], wh[3]};
                }
            if (seg == 1) {
#pragma unroll
                for (int n = 0; n < 2; ++n)
#pragma unroll
                    for (int i = 0; i < 4; ++i) {
                        float v = cl[n][i], v2 = ch[n][i];
                        v += __shfl_xor(v, 1); v += __shfl_xor(v, 2); v += __shfl_xor(v, 4); v += __shfl_xor(v, 8);
                        v2 += __shfl_xor(v2, 1); v2 += __shfl_xor(v2, 2); v2 += __shfl_xor(v2, 4); v2 += __shfl_xor(v2, 8);
                        if (fr == 0) { float* kp = KSUM + ((b * 8 + head) * 8 + blk) * 64 + 8 * fq + 4 * n + i; atomicAdd(kp, v); atomicAdd(kp + 32, v2); }
                    }
            }
        } else if (seg == 2) {
            const int head = 4 * half + wc;
#pragma unroll
            for (int ai = 0; ai < 2; ++ai)
#pragma unroll
                for (int m = 0; m < 4; ++m) {
                    const int l = lbase + 128 * ai + 16 * m; const float rsv = rs[b * 2048 + l];
#pragma unroll
                    for (int bj = 0; bj < 2; ++bj)
#pragma unroll
                        for (int n = 0; n < 2; ++n) {
                            const int d0 = 32 * bj + 8 * fq + 4 * n;
                            const f32x4 v = acc[ai][bj][m][n] * rsv;
                            bf16_t* o = VT + ((size_t)((b * 8 + head) * 64 + d0)) * 2048 + l;
                            const unsigned p0 = pk2(v[0], v[1]), p1 = pk2(v[2], v[3]);
                            o[0] = (bf16_t)(p0 & 0xffffu); o[2048] = (bf16_t)(p0 >> 16); o[4096] = (bf16_t)(p1 & 0xffffu); o[6144] = (bf16_t)(p1 >> 16);
                        }
                }
        } else if (seg == 4) {
#pragma unroll
            for (int ai = 0; ai < 2; ++ai)
#pragma unroll
                for (int m = 0; m < 4; ++m) {
                    const int l = lbase + 128 * ai + 16 * m; const float rsv = rs[b * 2048 + l];
                    const int c = l >> 4, t = l & 15;
#pragma unroll
                    for (int bj = 0; bj < 2; ++bj) {
                        const int g = 16 * half + 4 * wc + 2 * bj + (fq >> 1);
                        const f32x4 v0 = acc[ai][bj][m][0] * rsv, v1 = acc[ai][bj][m][1] * rsv;
                        bf16_t* o = XU + ((size_t)(1024 * g + b * 128 + c)) * 384 + 128 + t * 16 + 8 * (fq & 1);
                        *(u32x4*)o = (u32x4){pk2(v0[0], v0[1]), pk2(v0[2], v0[3]), pk2(v1[0], v1[1]), pk2(v1[2], v1[3])};
                    }
                }
        } else {
            bf16_t* dst = seg == 3 ? SZA : SZS;
#pragma unroll
            for (int ai = 0; ai < 2; ++ai)
#pragma unroll
                for (int m = 0; m < 4; ++m) {
                    const int l = lbase + 128 * ai + 16 * m; const int row = b * 2048 + l; const float rsv = rs[row];
#pragma unroll
                    for (int bj = 0; bj < 2; ++bj) {
                        const int col = 256 * half + 64 * wc + 32 * bj + 8 * fq;
                        const f32x4 v0 = acc[ai][bj][m][0] * rsv, v1 = acc[ai][bj][m][1] * rsv;
                        *(u32x4*)(dst + (size_t)row * 512 + col) = (u32x4){pk2(siluf_(v0[0]), siluf_(v0[1])), pk2(siluf_(v0[2]), siluf_(v0[3])), pk2(siluf_(v1[0]), siluf_(v1[1])), pk2(siluf_(v1[2]), siluf_(v1[3]))};
                    }
                }
        }
    }
};

struct EpiS {
    float* SST;
    __device__ __forceinline__ void operator()(const f32x4 (&acc)[2][2][4][2], const Unit& u, int wr, int wc, int fr, int fq) const {
#pragma unroll
        for (int ai = 0; ai < 2; ++ai)
#pragma unroll
            for (int m = 0; m < 4; ++m) {
                const int R = 256 * u.pm + 128 * ai + 64 * wr + 16 * m + fr;
#pragma unroll
                for (int n = 0; n < 2; ++n) *(f32x4*)(SST + (size_t)R * 128 + 32 * wc + 16 * n + 4 * fq) = acc[ai][0][m][n];
            }
    }
};

struct EpiY {
    bf16_t* YG;
    __device__ __forceinline__ void operator()(const f32x4 (&acc)[2][2][4][2], const Unit& u, int wr, int wc, int fr, int fq) const {
        const int g = u.pn, t = 4 * wc + fq;
#pragma unroll
        for (int ai = 0; ai < 2; ++ai)
#pragma unroll
            for (int m = 0; m < 4; ++m) {
                const int rr = 256 * (u.pm & 3) + 128 * ai + 64 * wr + 16 * m + fr;
                const int b = rr >> 7, c = rr & 127; const int token = b * 2048 + 16 * c + t;
                bf16_t* ob = YG + (size_t)token * 512 + 16 * g;
#pragma unroll
                for (int bj = 0; bj < 2; ++bj) {
                    const f32x4 v0 = acc[ai][bj][m][0], v1 = acc[ai][bj][m][1];
                    *(u32x4*)(ob + 8 * bj) = (u32x4){pk2(gelu_tanh(v0[0]), gelu_tanh(v0[1])), pk2(gelu_tanh(v0[2]), gelu_tanh(v0[3])), pk2(gelu_tanh(v1[0]), gelu_tanh(v1[1])), pk2(gelu_tanh(v1[2]), gelu_tanh(v1[3]))};
                }
            }
    }
};

struct EpiGlu {
    const bf16_t *YG, *SZS; const float* bglu; bf16_t* MIXED;
    __device__ __forceinline__ void operator()(const f32x4 (&acc)[2][2][4][2], const Unit& u, int wr, int wc, int fr, int fq) const {
        f32x4 bias[2][2];
#pragma unroll
        for (int bj = 0; bj < 2; ++bj)
#pragma unroll
            for (int n = 0; n < 2; ++n) bias[bj][n] = *(const f32x4*)(bglu + 256 * u.pn + 64 * wc + 32 * bj + 8 * fq + 4 * n);
#pragma unroll
        for (int ai = 0; ai < 2; ++ai) {
            u32x4 y4[4][2], z4[4][2];
#pragma unroll
            for (int m = 0; m < 4; ++m) {
                const int row = 256 * u.pm + 128 * ai + 64 * wr + 16 * m + fr;
#pragma unroll
                for (int bj = 0; bj < 2; ++bj) {
                    const unsigned off = (unsigned)row * 512u + (unsigned)(256 * u.pn + 64 * wc + 32 * bj + 8 * fq);
                    y4[m][bj] = *(const u32x4*)(YG + off); z4[m][bj] = *(const u32x4*)(SZS + off);
                }
            }
#pragma unroll
            for (int m = 0; m < 4; ++m) {
                const int row = 256 * u.pm + 128 * ai + 64 * wr + 16 * m + fr;
#pragma unroll
                for (int bj = 0; bj < 2; ++bj) {
                    const int col = 256 * u.pn + 64 * wc + 32 * bj + 8 * fq;
                    unsigned w[4];
#pragma unroll
                    for (int n = 0; n < 2; ++n) {
                        const f32x4 a = acc[ai][bj][m][n] + bias[bj][n];
                        const unsigned ya = y4[m][bj][2 * n], yb = y4[m][bj][2 * n + 1], za = z4[m][bj][2 * n], zb = z4[m][bj][2 * n + 1];
                        const float o0 = bflo(ya) * sigmoidf_(a[0]) * bflo(za), o1 = bfhi(ya) * sigmoidf_(a[1]) * bfhi(za);
                        const float o2 = bflo(yb) * sigmoidf_(a[2]) * bflo(zb), o3 = bfhi(yb) * sigmoidf_(a[3]) * bfhi(zb);
                        w[2 * n] = pk2(o0, o1); w[2 * n + 1] = pk2(o2, o3);
                    }
                    *(u32x4*)(MIXED + (size_t)row * 1024 + 512 + col) = (u32x4){w[0], w[1], w[2], w[3]};
                }
            }
        }
    }
};

struct EpiOut {
    const float* x; float* out; float* SSQ;
    __device__ __forceinline__ void operator()(const f32x4 (&acc)[2][2][4][2], const Unit& u, int wr, int wc, int fr, int fq) const {
#pragma unroll
        for (int ai = 0; ai < 2; ++ai) {
            f32x4 xv[4][2][2];
#pragma unroll
            for (int m = 0; m < 4; ++m) {
                const int row = 256 * u.pm + 128 * ai + 64 * wr + 16 * m + fr;
#pragma unroll
                for (int bj = 0; bj < 2; ++bj)
#pragma unroll
                    for (int n = 0; n < 2; ++n) xv[m][bj][n] = __builtin_nontemporal_load((const f32x4*)(x + (size_t)row * 1024 + 256 * u.pn + 64 * wc + 32 * bj + 8 * fq + 4 * n));
            }
#pragma unroll
            for (int m = 0; m < 4; ++m) {
                const int row = 256 * u.pm + 128 * ai + 64 * wr + 16 * m + fr;
                float ss = 0.f;
#pragma unroll
                for (int bj = 0; bj < 2; ++bj)
#pragma unroll
                    for (int n = 0; n < 2; ++n) {
                        const int col = 256 * u.pn + 64 * wc + 32 * bj + 8 * fq + 4 * n;
                        const f32x4 v = acc[ai][bj][m][n] + xv[m][bj][n];
                        *(f32x4*)(out + (size_t)row * 1024 + col) = v;
                        ss += (v[0] * v[0] + v[1] * v[1]) + (v[2] * v[2] + v[3] * v[3]);
                    }
                ss += __shfl_xor(ss, 16); ss += __shfl_xor(ss, 32);
                if (fq == 0) SSQ[row * 16 + 4 * u.pn + wc] = ss;
            }
        }
    }
};

struct EpiOutFused {
    const float* x; float* out; float* SSQ; const float* gain; XcdBarrier xbar;
    __device__ __forceinline__ void operator()(f32x4 (&acc)[2][2][4][2], const Unit& u, int wr, int wc, int fr, int fq) const {
#pragma unroll
        for (int ai = 0; ai < 2; ++ai) {
            f32x4 xv[4][2][2];
#pragma unroll
            for (int m = 0; m < 4; ++m) {
                const int row = 256 * u.pm + 128 * ai + 64 * wr + 16 * m + fr;
#pragma unroll
                for (int bj = 0; bj < 2; ++bj)
#pragma unroll
                    for (int n = 0; n < 2; ++n) xv[m][bj][n] = __builtin_nontemporal_load((const f32x4*)(x + (size_t)row * 1024 + 256 * u.pn + 64 * wc + 32 * bj + 8 * fq + 4 * n));
            }
#pragma unroll
            for (int m = 0; m < 4; ++m) {
                const int row = 256 * u.pm + 128 * ai + 64 * wr + 16 * m + fr;
                float ss = 0.f;
#pragma unroll
                for (int bj = 0; bj < 2; ++bj)
#pragma unroll
                    for (int n = 0; n < 2; ++n) {
                        const f32x4 v = acc[ai][bj][m][n] + xv[m][bj][n];
                        acc[ai][bj][m][n] = v;
                        ss += (v[0] * v[0] + v[1] * v[1]) + (v[2] * v[2] + v[3] * v[3]);
                    }
                ss += __shfl_xor(ss, 16); ss += __shfl_xor(ss, 32);
                if (fq == 0) SSQ[row * 16 + 4 * u.pn + wc] = ss;
            }
        }
    }
    __device__ __forceinline__ void after(f32x4 (&acc)[2][2][4][2], const Unit& u, int wr, int wc, int fr, int fq) const {
        xcd_barrier(xbar);
        f32x4 gn[2][2];
#pragma unroll
        for (int bj = 0; bj < 2; ++bj)
#pragma unroll
            for (int n = 0; n < 2; ++n) gn[bj][n] = *(const f32x4*)(gain + 256 * u.pn + 64 * wc + 32 * bj + 8 * fq + 4 * n);
#pragma unroll
        for (int ai = 0; ai < 2; ++ai)
#pragma unroll
            for (int m = 0; m < 4; ++m) {
                const int row = 256 * u.pm + 128 * ai + 64 * wr + 16 * m + fr;
                const f32x4* sp = (const f32x4*)(SSQ + row * 16);
                const f32x4 s0 = sp[0], s1 = sp[1], s2 = sp[2], s3 = sp[3];
                const float tot = ((s0[0] + s0[1]) + (s0[2] + s0[3])) + ((s1[0] + s1[1]) + (s1[2] + s1[3])) + ((s2[0] + s2[1]) + (s2[2] + s2[3])) + ((s3[0] + s3[1]) + (s3[2] + s3[3]));
                const float rinv = 1.0f / sqrtf(tot * (1.f / DM) + 1e-6f);
#pragma unroll
                for (int bj = 0; bj < 2; ++bj)
#pragma unroll
                    for (int n = 0; n < 2; ++n) {
                        const int col = 256 * u.pn + 64 * wc + 32 * bj + 8 * fq + 4 * n;
                        *(f32x4*)(out + (size_t)row * 1024 + col) = acc[ai][bj][m][n] * rinv * gn[bj][n];
                    }
            }
    }
};

template <int MODE>
__device__ __forceinline__ void transpose_item(const float* W, int K, int N, bf16_t* WT, const float* gain, LAS float* scr, int item, int lane) {
    const int nblk = N / 32, kb = item / nblk, nb = item % nblk, k0 = 64 * kb, n0 = 32 * nb;
#pragma unroll 8
    for (int i = 0; i < 32; ++i) { const int kk = 2 * i + (lane >> 5); float w = W[(size_t)(k0 + kk) * N + n0 + (lane & 31)]; if (MODE == 0) w *= gain[k0 + kk]; scr[kk * 33 + (lane & 31)] = w; }
    const int c = lane & 7;
#pragma unroll
    for (int j = 0; j < 4; ++j) { const int n = (lane >> 3) + 8 * j; const LAS float* s = scr + (8 * c) * 33 + n;
        u32x4 o; o.x = pk2(s[0 * 33], s[1 * 33]); o.y = pk2(s[2 * 33], s[3 * 33]); o.z = pk2(s[4 * 33], s[5 * 33]); o.w = pk2(s[6 * 33], s[7 * 33]);
        const int drow = inproj_row(n0 + n);
        *(u32x4*)(WT + (size_t)drow * K + k0 + 8 * c) = o; }
}

__device__ __forceinline__ void ssm_group_prep(const Params& p, int item, LAS float* L) {
    LAS float* lkr = L; LAS float* lki = L + 1088; LAS float* bbr = L + 2176; LAS float* bbi = L + 3200; LAS float* cr = L + 4224; LAS float* ci = L + 5248; LAS float* Kt = L + 6272;
    const int tid = threadIdx.x, g = item >> 3, sub = item & 7;
    const float dt = expf(p.log_dt[g]);
    for (int t = tid; t < 17 * 64; t += 512) {
        const int pp = t & 63, k = t >> 6;
        const float a = p.lam_re[g * 64 + pp] * dt, th = p.lam_im[g * 64 + pp] * dt;
        const float mag = expf((float)k * a); float sn, cs; sincosf((float)k * th, &sn, &cs);
        lkr[k * 64 + pp] = mag * cs; lki[k * 64 + pp] = mag * sn;
    }
    for (int t = tid; t < 1024; t += 512) {
        const int pp = t >> 4, h = t & 15;
        const float lr = p.lam_re[g * 64 + pp], li = p.lam_im[g * 64 + pp];
        const float a = lr * dt, th = li * dt;
        float sn, cs; sincosf(th, &sn, &cs); const float sh = sinf(0.5f * th);
        const float em1 = expm1f(a), ea = em1 + 1.f;
        const float xr = em1 * cs - 2.f * sh * sh, xi = ea * sn;
        const float den = 1.f / (lr * lr + li * li);
        const float cfr = (xr * lr + xi * li) * den, cfi = (xi * lr - xr * li) * den;
        const float br = p.b_re[(g * 64 + pp) * 16 + h], bi = p.b_im[(g * 64 + pp) * 16 + h];
        bbr[pp * 16 + h] = cfr * br - cfi * bi; bbi[pp * 16 + h] = cfr * bi + cfi * br;
        cr[h * 64 + pp] = p.c_re[(g * 16 + h) * 64 + pp]; ci[h * 64 + pp] = p.c_im[(g * 16 + h) * 64 + pp];
    }
    __syncthreads();
    {
        const int k = tid >> 5, hl = (tid >> 4) & 1, h2 = tid & 15, h = 2 * sub + hl;
        float sacc = 0.f;
        for (int pp = 0; pp < 64; ++pp) {
            const float c_r = cr[h * 64 + pp], c_i = ci[h * 64 + pp], l_r = lkr[k * 64 + pp], l_i = lki[k * 64 + pp];
            const float er = c_r * l_r - c_i * l_i, ei = c_r * l_i + c_i * l_r;
            sacc += er * bbr[pp * 16 + h2] - ei * bbi[pp * 16 + h2];
        }
        if (k == 0 && h == h2) sacc += p.d_skip[g * 16 + h];
        Kt[tid] = sacc;
    }
    __syncthreads();
    bf16_t* WCAT = (bf16_t*)(p.ws + WS_WCAT) + (size_t)g * 256 * 384;
    bf16_t* WST = (bf16_t*)(p.ws + WS_WST) + (size_t)g * 256 * 256;
    for (int e = tid; e < 32 * 192; e += 512) {
        const int rl = e / 192, kk = (e - rl * 192) * 2;
        const int t = rl >> 1, hl = rl & 1, h = 2 * sub + hl;
        const int row = 128 * (h >> 3) + 32 * (t >> 2) + 16 * ((h >> 2) & 1) + 4 * (t & 3) + (h & 3);
        float v[2];
#pragma unroll
        for (int q = 0; q < 2; ++q) {
            const int k2 = kk + q;
            if (k2 < 128) { const int pp = k2 & 63; const float c_r = cr[h * 64 + pp], c_i = ci[h * 64 + pp], l_r = lkr[(t + 1) * 64 + pp], l_i = lki[(t + 1) * 64 + pp];
                v[q] = k2 < 64 ? (c_r * l_r - c_i * l_i) : -(c_r * l_i + c_i * l_r); }
            else { const int s2 = (k2 - 128) >> 4, h2 = (k2 - 128) & 15; v[q] = s2 <= t ? Kt[((t - s2) * 2 + hl) * 16 + h2] : 0.f; }
        }
        *(unsigned*)(WCAT + (size_t)row * 384 + kk) = pk2(v[0], v[1]);
    }
    for (int e = tid; e < 32 * 128; e += 512) {
        const int rl = e >> 7, kk = (e & 127) * 2;
        const int row = rl < 16 ? 16 * sub + rl : 128 + 16 * sub + (rl - 16);
        float v[2] = {0.f, 0.f};
        if (row < 128) {
            const int pp = row & 63;
#pragma unroll
            for (int q = 0; q < 2; ++q) { const int s2 = (kk + q) >> 4, h = (kk + q) & 15; const float l_r = lkr[(15 - s2) * 64 + pp], l_i = lki[(15 - s2) * 64 + pp], b_r = bbr[pp * 16 + h], b_i = bbi[pp * 16 + h];
                v[q] = row < 64 ? (l_r * b_r - l_i * b_i) : (l_r * b_i + l_i * b_r); }
        }
        *(unsigned*)(WST + (size_t)row * 256 + kk) = pk2(v[0], v[1]);
    }
    if (sub == 0 && tid < 64) { float* L16 = (float*)(p.ws + WS_LAM16) + (g * 64 + tid) * 2; L16[0] = lkr[16 * 64 + tid]; L16[1] = lki[16 * 64 + tid]; }
    __syncthreads();
}

__device__ __forceinline__ void phase_prep(const Params& p, LAS unsigned char* lds) {
    const int tid = threadIdx.x, lane = tid & 63, wave = tid >> 6, G = 256, bid = blockIdx.x;
    for (int item = bid; item < 256; item += G) ssm_group_prep(p, item, (LAS float*)lds);
    const int gw = bid * 8 + wave, NGW = G * 8;
    {
        bf16_t* XB = (bf16_t*)(p.ws + WS_XB); float* RS = (float*)(p.ws + WS_RS);
        for (int row = gw; row < NTOK; row += NGW) {
            const f32x4* xr = (const f32x4*)(p.x + (size_t)row * DM) + lane;
            f32x4 v[4]; float s = 0.f;
#pragma unroll
            for (int j = 0; j < 4; ++j) { v[j] = __builtin_nontemporal_load(xr + 64 * j); s += (v[j][0] * v[j][0] + v[j][1] * v[j][1]) + (v[j][2] * v[j][2] + v[j][3] * v[j][3]); }
            s = wave_sum(s);
            if (lane == 0) RS[row] = 1.0f / sqrtf(s * (1.f / DM) + 1e-6f);
            u32x2* o = (u32x2*)(XB + (size_t)row * DM) + lane;
#pragma unroll
            for (int j = 0; j < 4; ++j) o[64 * j] = (u32x2){pk2(v[j][0], v[j][1]), pk2(v[j][2], v[j][3])};
        }
    }
    {
        LAS float* scr = (LAS float*)(lds + 49152) + wave * (64 * 33);
        constexpr int I_IN = (DM / 64) * (NPROJ / 32), I_OUT = (DM / 64) * (DM / 32), I_GLU = (512 / 64) * (512 / 32);
        for (int it = gw; it < I_IN + I_OUT + I_GLU; it += NGW) {
            int r = it;
            if (r < I_IN) { transpose_item<0>(p.w_in, DM, NPROJ, (bf16_t*)(p.ws + WS_WINT), p.norm_gain, scr, r, lane); continue; } r -= I_IN;
            if (r < I_OUT) { transpose_item<1>(p.w_out, DM, DM, (bf16_t*)(p.ws + WS_WOUTT), nullptr, scr, r, lane); continue; } r -= I_OUT;
            transpose_item<1>(p.w_glu, 512, 512, (bf16_t*)(p.ws + WS_WGLUT), nullptr, scr, r, lane);
        }
    }
    {
        float* COS = (float*)(p.ws + WS_COS); float* SIN = (float*)(p.ws + WS_SIN); float* KSUM = (float*)(p.ws + WS_KSUM);
        for (int i = bid * 512 + tid; i < SEQ * 32; i += G * 512) {
            const int pos = i >> 5, f = i & 31;
            const float inv = 1.0f / powf(10000.0f, (float)f * (1.f / 32.f));
            const float ang = (float)pos * inv; float sn, cs; sincosf(ang, &sn, &cs);
            COS[i] = cs; SIN[i] = sn;
        }
        for (int i = bid * 512 + tid; i < 4096; i += G * 512) KSUM[i] = 0.f;
    }
}

__device__ __forceinline__ int swap23(int r) { return (r & ~12) | ((r & 4) << 1) | ((r & 8) >> 1); }

typedef float f32x2 __attribute__((ext_vector_type(2)));
__device__ __forceinline__ float max3f(float a, float b, float c) { float r; asm("v_max3_f32 %0, %1, %2, %3" : "=v"(r) : "v"(a), "v"(b), "v"(c)); return r; }
template <bool DIAG>
__device__ __forceinline__ void attn_tile(LAS unsigned char* B, unsigned kf_off, unsigned vf_off, const bf16x8 (&qf)[4], f32x16& O0, f32x16& O1, float& mrun, float& lrun,
                                          bool on, int kpos0, int qpos, int hh) {
    constexpr int ROWB = 144;
    const float cinit = on ? -mrun : -1e30f;
    f32x16 st0, st1;
#pragma unroll
    for (int i = 0; i < 16; ++i) { st0[i] = cinit; st1[i] = cinit; }
#pragma unroll
    for (int s = 0; s < 4; ++s) {
        const bf16x8 k0 = *(const LAS bf16x8*)(B + kf_off + s * 32), k1 = *(const LAS bf16x8*)(B + kf_off + 32 * ROWB + s * 32);
        st0 = __builtin_amdgcn_mfma_f32_32x32x16_bf16(k0, qf[s], st0, 0, 0, 0);
        st1 = __builtin_amdgcn_mfma_f32_32x32x16_bf16(k1, qf[s], st1, 0, 0, 0);
    }
    if (DIAG) {
#pragma unroll
        for (int i = 0; i < 16; ++i) {
            const int key = kpos0 + (i & 7) + 8 * hh + 16 * (i >> 3);
            if (key > qpos) st0[i] = -1e30f;
            if (key + 32 > qpos) st1[i] = -1e30f;
        }
    }
    float mx = max3f(st0[0], st0[1], st0[2]);
#pragma unroll
    for (int i = 3; i < 15; i += 2) mx = max3f(mx, st0[i], st0[i + 1]);
    mx = max3f(mx, st0[15], st1[0]);
#pragma unroll
    for (int i = 1; i < 15; i += 2) mx = max3f(mx, st1[i], st1[i + 1]);
    mx = fmaxf(mx, st1[15]);
    mx = fmaxf(mx, __shfl_xor(mx, 32));
    const bool grow = on && (mx > 8.f);
    if (__ballot(grow) != 0ull) {
        const float d = grow ? mx : 0.f;
        const float alpha = __builtin_amdgcn_exp2f(-d);
        lrun *= alpha; mrun += d;
#pragma unroll
        for (int i = 0; i < 16; ++i) { O0[i] *= alpha; O1[i] *= alpha; st0[i] -= d; st1[i] -= d; }
    }
    float rsum = 0.f;
#pragma unroll
    for (int i = 0; i < 16; ++i) { const float p0 = __builtin_amdgcn_exp2f(st0[i]), p1 = __builtin_amdgcn_exp2f(st1[i]); st0[i] = p0; st1[i] = p1; rsum += p0; rsum += p1; }
    rsum += __shfl_xor(rsum, 32);
    lrun += rsum;
#pragma unroll
    for (int s4 = 0; s4 < 4; ++s4) {
        u32x4 t4;
        if (s4 < 2) t4 = (u32x4){pk2(st0[8 * s4], st0[8 * s4 + 1]), pk2(st0[8 * s4 + 2], st0[8 * s4 + 3]), pk2(st0[8 * s4 + 4], st0[8 * s4 + 5]), pk2(st0[8 * s4 + 6], st0[8 * s4 + 7])};
        else { const int s = s4 - 2; t4 = (u32x4){pk2(st1[8 * s], st1[8 * s + 1]), pk2(st1[8 * s + 2], st1[8 * s + 3]), pk2(st1[8 * s + 4], st1[8 * s + 5]), pk2(st1[8 * s + 6], st1[8 * s + 7])}; }
        const bf16x8 pf = __builtin_bit_cast(bf16x8, t4);
        const bf16x8 v0 = *(const LAS bf16x8*)(B + vf_off + s4 * 32), v1 = *(const LAS bf16x8*)(B + vf_off + 32 * ROWB + s4 * 32);
        O0 = __builtin_amdgcn_mfma_f32_32x32x16_bf16(v0, pf, O0, 0, 0, 0);
        O1 = __builtin_amdgcn_mfma_f32_32x32x16_bf16(v1, pf, O1, 0, 0, 0);
    }
}

__device__ __forceinline__ void attn_tile2(LAS unsigned char* BA, LAS unsigned char* BB, unsigned kf_off, unsigned vf_off, const bf16x8 (&qf)[4], f32x16& O0, f32x16& O1, float& mrun, float& lrun, bool on) {
    constexpr int ROWB = 144;
    const float cinit = on ? -mrun : -1e30f;
    f32x16 sa0, sa1, sb0, sb1;
#pragma unroll
    for (int i = 0; i < 16; ++i) { sa0[i] = cinit; sa1[i] = cinit; sb0[i] = cinit; sb1[i] = cinit; }
#pragma unroll
    for (int s = 0; s < 4; ++s) {
        const bf16x8 k0 = *(const LAS bf16x8*)(BA + kf_off + s * 32), k1 = *(const LAS bf16x8*)(BA + kf_off + 32 * ROWB + s * 32);
        const bf16x8 k2 = *(const LAS bf16x8*)(BB + kf_off + s * 32), k3 = *(const LAS bf16x8*)(BB + kf_off + 32 * ROWB + s * 32);
        sa0 = __builtin_amdgcn_mfma_f32_32x32x16_bf16(k0, qf[s], sa0, 0, 0, 0);
        sa1 = __builtin_amdgcn_mfma_f32_32x32x16_bf16(k1, qf[s], sa1, 0, 0, 0);
        sb0 = __builtin_amdgcn_mfma_f32_32x32x16_bf16(k2, qf[s], sb0, 0, 0, 0);
        sb1 = __builtin_amdgcn_mfma_f32_32x32x16_bf16(k3, qf[s], sb1, 0, 0, 0);
    }
    float mx = max3f(sa0[0], sa0[1], sa0[2]), my = max3f(sb0[0], sb0[1], sb0[2]);
#pragma unroll
    for (int i = 3; i < 15; i += 2) { mx = max3f(mx, sa0[i], sa0[i + 1]); my = max3f(my, sb0[i], sb0[i + 1]); }
    mx = max3f(mx, sa0[15], sa1[0]); my = max3f(my, sb0[15], sb1[0]);
#pragma unroll
    for (int i = 1; i < 15; i += 2) { mx = max3f(mx, sa1[i], sa1[i + 1]); my = max3f(my, sb1[i], sb1[i + 1]); }
    mx = max3f(mx, sa1[15], fmaxf(my, sb1[15]));
    mx = fmaxf(mx, __shfl_xor(mx, 32));
    const bool grow = on && (mx > 8.f);
    if (__ballot(grow) != 0ull) {
        const float d = grow ? mx : 0.f;
        const float alpha = __builtin_amdgcn_exp2f(-d);
        lrun *= alpha; mrun += d;
#pragma unroll
        for (int i = 0; i < 16; ++i) { O0[i] *= alpha; O1[i] *= alpha; sa0[i] -= d; sa1[i] -= d; sb0[i] -= d; sb1[i] -= d; }
    }
    float rsum = 0.f;
#define AT2_EXP(S0, S1) _Pragma("unroll") for (int i = 0; i < 16; ++i) { const float p0 = __builtin_amdgcn_exp2f(S0[i]), p1 = __builtin_amdgcn_exp2f(S1[i]); S0[i] = p0; S1[i] = p1; rsum += p0; rsum += p1; }
#define AT2_PV(S0, S1, BUF) _Pragma("unroll") for (int s4 = 0; s4 < 4; ++s4) { \
        u32x4 t4; \
        if (s4 < 2) t4 = (u32x4){pk2(S0[8 * s4], S0[8 * s4 + 1]), pk2(S0[8 * s4 + 2], S0[8 * s4 + 3]), pk2(S0[8 * s4 + 4], S0[8 * s4 + 5]), pk2(S0[8 * s4 + 6], S0[8 * s4 + 7])}; \
        else { const int s_ = s4 - 2; t4 = (u32x4){pk2(S1[8 * s_], S1[8 * s_ + 1]), pk2(S1[8 * s_ + 2], S1[8 * s_ + 3]), pk2(S1[8 * s_ + 4], S1[8 * s_ + 5]), pk2(S1[8 * s_ + 6], S1[8 * s_ + 7])}; } \
        const bf16x8 pf = __builtin_bit_cast(bf16x8, t4); \
        const bf16x8 v0 = *(const LAS bf16x8*)(BUF + vf_off + s4 * 32), v1 = *(const LAS bf16x8*)(BUF + vf_off + 32 * ROWB + s4 * 32); \
        O0 = __builtin_amdgcn_mfma_f32_32x32x16_bf16(v0, pf, O0, 0, 0, 0); \
        O1 = __builtin_amdgcn_mfma_f32_32x32x16_bf16(v1, pf, O1, 0, 0, 0); }
    AT2_EXP(sa0, sa1)
    AT2_PV(sa0, sa1, BA)
    AT2_EXP(sb0, sb1)
    AT2_PV(sb0, sb1, BB)
#undef AT2_EXP
#undef AT2_PV
    rsum += __shfl_xor(rsum, 32);
    lrun += rsum;
}

__device__ __forceinline__ void phase_attn(const Params& p, LAS unsigned char* lds, unsigned* queue) {
    const int tid = threadIdx.x, lane = tid & 63, w = __builtin_amdgcn_readfirstlane(tid >> 6), r = lane & 31, hh = lane >> 5;
    const bf16_t* Qg = (const bf16_t*)(p.ws + WS_Q); const bf16_t* Kg = (const bf16_t*)(p.ws + WS_K); const bf16_t* VTg = (const bf16_t*)(p.ws + WS_VT);
    const bf16_t* SZA = (const bf16_t*)(p.ws + WS_SZA); const float* KSUM = (const float*)(p.ws + WS_KSUM);
    bf16_t* MIXED = (bf16_t*)(p.ws + WS_XB);
    constexpr int ROWB = 144, TILEB = 64 * ROWB, BUFB = 2 * TILEB;
    const int srow = tid >> 3, sch = tid & 7;
    const unsigned st_off = (unsigned)(srow * ROWB + sch * 16);
    const unsigned kf_off = (unsigned)(swap23(r) * ROWB + hh * 16);
    const unsigned vf_off = (unsigned)(TILEB + r * ROWB + hh * 16);
    volatile LAS unsigned* tick = (volatile LAS unsigned*)(lds + 131072 + 8);
    for (;;) {
        if (tid == 0) *tick = __hip_atomic_fetch_add(queue, 1u, __ATOMIC_RELAXED, __HIP_MEMORY_SCOPE_AGENT);
        __syncthreads();
        const int idx = (int)*tick;
        if (idx >= 512) break;
        const int blk = 7 - (idx >> 6), bh = idx & 63, b = bh >> 3, h = bh & 7;
        const int qpos = blk * 256 + w * 32 + r;
        const bf16_t* Qp = Qg + ((size_t)bh * 2048 + qpos) * 64 + 8 * hh;
        bf16x8 qf[4];
#pragma unroll
        for (int s = 0; s < 4; ++s) qf[s] = *(const bf16x8*)(Qp + 16 * s);
        unsigned selmask;
        if (blk <= 3) selmask = (1u << blk) - 1u;
        else {
            float v1 = -3e38f, v2 = -3e38f, v3 = -3e38f; int i1 = 0, i2 = 0, i3 = 0;
#pragma unroll
            for (int j = 0; j < 7; ++j) {
                if (j < blk) {
                    const float* ks = KSUM + ((size_t)bh * 8 + j) * 64 + 8 * hh;
                    float gsum = 0.f;
#pragma unroll
                    for (int s = 0; s < 4; ++s) {
                        const f32x4 k0 = *(const f32x4*)(ks + 16 * s), k1 = *(const f32x4*)(ks + 16 * s + 4);
                        gsum += bf2f((unsigned short)qf[s][0]) * k0[0] + bf2f((unsigned short)qf[s][1]) * k0[1] + bf2f((unsigned short)qf[s][2]) * k0[2] + bf2f((unsigned short)qf[s][3]) * k0[3]
                              + bf2f((unsigned short)qf[s][4]) * k1[0] + bf2f((unsigned short)qf[s][5]) * k1[1] + bf2f((unsigned short)qf[s][6]) * k1[2] + bf2f((unsigned short)qf[s][7]) * k1[3];
                    }
                    gsum += __shfl_xor(gsum, 32);
                    if (gsum > v1) { v3 = v2; i3 = i2; v2 = v1; i2 = i1; v1 = gsum; i1 = j; }
                    else if (gsum > v2) { v3 = v2; i3 = i2; v2 = gsum; i2 = j; }
                    else if (gsum > v3) { v3 = gsum; i3 = j; }
                }
            }
            selmask = (1u << i1) | (1u << i2) | (1u << i3);
        }
        f32x16 O0, O1;
#pragma unroll
        for (int i = 0; i < 16; ++i) { O0[i] = 0.f; O1[i] = 0.f; }
        float mrun = 0.f, lrun = 0.f;
        const int ntile = 4 + 4 * blk;
        const bf16_t* Kst = Kg + ((size_t)bh * 2048 + srow) * 64 + sch * 8;
        const bf16_t* Vst = VTg + ((size_t)bh * 64 + srow) * 2048 + sch * 8;
        u32x4 kreg[2], vreg[2];
#pragma unroll
        for (int q = 0; q < 2; ++q) { const int kp = blk * 256 + 64 * q; kreg[q] = *(const u32x4*)(Kst + (size_t)kp * 64); vreg[q] = *(const u32x4*)(Vst + kp); }
#pragma unroll
        for (int q = 0; q < 2; ++q) { *(LAS u32x4*)(lds + q * BUFB + st_off) = kreg[q]; *(LAS u32x4*)(lds + q * BUFB + TILEB + st_off) = vreg[q]; }
        __syncthreads();
        for (int n = 0; n < ntile; n += 2) {
            if (n + 2 < ntile) {
#pragma unroll
                for (int q = 0; q < 2; ++q) { const int m = n + 2 + q; const int kp = m < 4 ? blk * 256 + 64 * m : ((m - 4) >> 2) * 256 + 64 * ((m - 4) & 3);
                    kreg[q] = *(const u32x4*)(Kst + (size_t)kp * 64); vreg[q] = *(const u32x4*)(Vst + kp); }
            }
            LAS unsigned char* SB = lds + ((n >> 1) & 1) * (2 * BUFB);
            if (n >= 4) {
                const bool on = (selmask >> ((n - 4) >> 2)) & 1u;
                if (__ballot(on) != 0ull) attn_tile2(SB, SB + BUFB, kf_off, vf_off, qf, O0, O1, mrun, lrun, on);
            } else {
#pragma unroll
                for (int q = 0; q < 2; ++q) {
                    const int nn = n + q;
                    const int kpos0 = blk * 256 + 64 * nn;
                    LAS unsigned char* B = SB + q * BUFB;
                    const int dt_ = w >> 1;
                    if (nn == dt_) attn_tile<true>(B, kf_off, vf_off, qf, O0, O1, mrun, lrun, true, kpos0, qpos, hh);
                    else if (nn < dt_) attn_tile<false>(B, kf_off, vf_off, qf, O0, O1, mrun, lrun, true, kpos0, qpos, hh);
                }
            }
            if (n + 2 < ntile) { LAS unsigned char* Bn = lds + (((n >> 1) + 1) & 1) * (2 * BUFB);
#pragma unroll
                for (int q = 0; q < 2; ++q) { *(LAS u32x4*)(Bn + q * BUFB + st_off) = kreg[q]; *(LAS u32x4*)(Bn + q * BUFB + TILEB + st_off) = vreg[q]; } }
            __syncthreads();
        }
        const float inv = 1.f / lrun;
        const size_t row = (size_t)b * 2048 + qpos;
#pragma unroll
        for (int dt = 0; dt < 2; ++dt)
#pragma unroll
            for (int g4 = 0; g4 < 4; ++g4) {
                const int d0 = 32 * dt + 8 * g4 + 4 * hh;
                const u32x2 z2 = *(const u32x2*)(SZA + row * 512 + h * 64 + d0);
                float o0, o1, o2, o3;
                if (dt == 0) { o0 = O0[4 * g4]; o1 = O0[4 * g4 + 1]; o2 = O0[4 * g4 + 2]; o3 = O0[4 * g4 + 3]; }
                else { o0 = O1[4 * g4]; o1 = O1[4 * g4 + 1]; o2 = O1[4 * g4 + 2]; o3 = O1[4 * g4 + 3]; }
                o0 *= inv * bflo(z2[0]); o1 *= inv * bfhi(z2[0]); o2 *= inv * bflo(z2[1]); o3 *= inv * bfhi(z2[1]);
                *(u32x2*)(MIXED + row * 1024 + h * 64 + d0) = (u32x2){pk2(o0, o1), pk2(o2, o3)};
            }
    }
}

__device__ __forceinline__ void scan_unit(const Params& p, LAS unsigned char* lds, int L) {
    const int tid = threadIdx.x, lane = tid & 63, wave = __builtin_amdgcn_readfirstlane(tid >> 6);
    float* SST = (float*)(p.ws + WS_SST); bf16_t* XU = (bf16_t*)(p.ws + WS_XU); const float* L16 = (const float*)(p.ws + WS_LAM16);
    LAS float* E = (LAS float*)lds;
    const int g = L >> 2;
    const float lr = L16[(g * 64 + lane) * 2], li = L16[(g * 64 + lane) * 2 + 1];
    float pr = lr, pi = li;
#pragma unroll
    for (int q = 0; q < 4; ++q) { const float nr = pr * pr - pi * pi, ni = 2.f * pr * pi; pr = nr; pi = ni; }
    for (int bb = 0; bb < 2; ++bb) {
        const size_t base = (size_t)256 * L + 128 * bb + 16 * wave;
        float sr[16], si[16];
#pragma unroll
        for (int c = 0; c < 16; ++c) { sr[c] = __hip_atomic_load(SST + (base + c) * 128 + lane, __ATOMIC_RELAXED, __HIP_MEMORY_SCOPE_AGENT); si[c] = __hip_atomic_load(SST + (base + c) * 128 + 64 + lane, __ATOMIC_RELAXED, __HIP_MEMORY_SCOPE_AGENT); }
        float er = 0.f, ei = 0.f;
#pragma unroll
        for (int c = 0; c < 16; ++c) { const float nr = lr * er - li * ei + sr[c], ni = lr * ei + li * er + si[c]; er = nr; ei = ni; }
        E[(wave * 2) * 64 + lane] = er; E[(wave * 2 + 1) * 64 + lane] = ei;
        __syncthreads();
        float Xr = 0.f, Xi = 0.f;
        for (int s2 = 0; s2 < wave; ++s2) { const float e_r = E[(s2 * 2) * 64 + lane], e_i = E[(s2 * 2 + 1) * 64 + lane]; const float nr = pr * Xr - pi * Xi + e_r, ni = pr * Xi + pi * Xr + e_i; Xr = nr; Xi = ni; }
#pragma unroll
        for (int c = 0; c < 16; ++c) {
            const size_t R = base + c;
            XU[R * 384 + lane] = (bf16_t)(pk2(Xr, 0.f) & 0xffffu); XU[R * 384 + 64 + lane] = (bf16_t)(pk2(Xi, 0.f) & 0xffffu);
            const float nr = lr * Xr - li * Xi + sr[c], ni = lr * Xi + li * Xr + si[c]; Xr = nr; Xi = ni;
        }
        __syncthreads();
    }
}

__device__ __forceinline__ void phase_norm(const Params& p) {
    const int tid = threadIdx.x, lane = tid & 63, wave = tid >> 6, G = gridDim.x;
    const float* SSQ = (const float*)(p.ws + WS_SSQ);
    f32x4 gn[4];
#pragma unroll
    for (int j = 0; j < 4; ++j) gn[j] = *((const f32x4*)p.final_gain + lane + 64 * j);
    for (int row = blockIdx.x * 8 + wave; row < NTOK; row += 8 * G) {
        float s = 0.f;
#pragma unroll
        for (int i = 0; i < 16; ++i) s += SSQ[row * 16 + i];
        const float rinv = 1.0f / sqrtf(s * (1.f / DM) + 1e-6f);
        f32x4* o = (f32x4*)(p.out + (size_t)row * DM) + lane;
#pragma unroll
        for (int j = 0; j < 4; ++j) { f32x4 v = o[64 * j]; v = v * rinv * gn[j]; o[64 * j] = v; }
    }
}

__global__ __launch_bounds__(512, 2) void hymba_fwd(Params p) {
    extern __shared__ __attribute__((aligned(16))) unsigned char shm_raw[];
    LAS unsigned char* lds = (LAS unsigned char*)shm_raw;
    cg::grid_group grid = cg::this_grid();
    constexpr int G = 256;
    const int bid = blockIdx.x;
    unsigned char* ws = p.ws;
#if N_LAUNCH == 1
    constexpr int lo = 0, hi = NPH;
#else
    const int lo = p.ph_lo, hi = p.ph_hi;
#endif
    if (threadIdx.x < 4) ((LAS unsigned*)(lds + 131072))[threadIdx.x] = 0u;
    __syncthreads();
    XcdBarrier xbar = xcd_barrier_post((unsigned*)(ws + WS_BAR), (volatile LAS unsigned*)(lds + 131072));
    if (hi > 1000) grid.sync();
#define IN(k) (PH_ON(k) && lo <= (k) && (k) < hi)
#define SEAM(k) do { if (lo <= (k) && (k) + 1 < hi) xcd_barrier(xbar); } while (0)
    if (IN(0)) { phase_prep(p, lds); }
    SEAM(0);
    if (IN(1)) {
        pg8::Gemm g{(const bf16_t*)(ws + WS_XB), (const bf16_t*)(ws + WS_WINT)};
        pg8::StaticOrder<NTOK, NPROJ> S{bid};
        EpiInProj E{(const float*)(ws + WS_RS), (const float*)(ws + WS_COS), (const float*)(ws + WS_SIN),
                    (bf16_t*)(ws + WS_Q), (bf16_t*)(ws + WS_K), (bf16_t*)(ws + WS_VT), (bf16_t*)(ws + WS_SZA), (bf16_t*)(ws + WS_SZS), (bf16_t*)(ws + WS_XU), (float*)(ws + WS_KSUM)};
        pg8::gemm_phase<DM, DM, DM>(lds, g, S, E);
    }
    SEAM(1);
    if (IN(2)) {
        unsigned* cnt = (unsigned*)(ws + WS_BAR) + XCD_BAR_WORDS;
        if (bid < 128) {
            const int L = bid;
            {
                pg8::Gemm g{(const bf16_t*)(ws + WS_XU) + 128, (const bf16_t*)(ws + WS_WST)};
                pg8::OneUnit S{L, L >> 2};
                EpiS E{(float*)(ws + WS_SST)};
                pg8::gemm_phase<384, 256, 256, false, true, false>(lds, g, S, E);
            }
            asm volatile("s_waitcnt vmcnt(0)" ::: "memory");
            __syncthreads();
            scan_unit(p, lds, L);
            asm volatile("s_waitcnt vmcnt(0)" ::: "memory");
            __syncthreads();
            {
                pg8::Gemm g{(const bf16_t*)(ws + WS_XU), (const bf16_t*)(ws + WS_WCAT)};
                pg8::OneUnit S{L, L >> 2};
                EpiY E{(bf16_t*)(ws + WS_YG)};
                pg8::gemm_phase<384, 384, 384, false, true, false>(lds, g, S, E);
            }
            asm volatile("s_waitcnt vmcnt(0)" ::: "memory");
            __syncthreads();
            if (threadIdx.x == 0) {
                __builtin_amdgcn_fence(__ATOMIC_RELEASE, "agent");
                asm volatile("s_waitcnt vmcnt(0)" ::: "memory");
                __hip_atomic_fetch_add(cnt + 64 * (L & 3), 1u, __ATOMIC_RELAXED, __HIP_MEMORY_SCOPE_AGENT);
            }
        }
        if (bid < 128) {
            const int U = bid;
            const int pm = U >> 1, pn = U & 1;
            if (threadIdx.x == 0) {
                unsigned sp = 0;
                while (__hip_atomic_load(cnt + 64 * (pm >> 4), __ATOMIC_RELAXED, __HIP_MEMORY_SCOPE_AGENT) < 32u) { __builtin_amdgcn_s_sleep(2); if (++sp > (1u << 22)) break; }
                __builtin_amdgcn_fence(__ATOMIC_ACQUIRE, "agent");
                asm volatile("s_waitcnt vmcnt(0)" ::: "memory");
            }
            __syncthreads();
            pg8::Gemm g{(const bf16_t*)(ws + WS_YG), (const bf16_t*)(ws + WS_WGLUT)};
            pg8::OneUnit S{pm, pn};
            EpiGlu E{(const bf16_t*)(ws + WS_YG), (const bf16_t*)(ws + WS_SZS), p.b_glu, (bf16_t*)(ws + WS_XB)};
            pg8::gemm_phase<512, 512, 512, false, true, false>(lds, g, S, E);
        }
        phase_attn(p, lds, cnt + 256);
    }
    SEAM(2);
    if (G == 256) {
        if (IN(6)) {
            pg8::Gemm g{(const bf16_t*)(ws + WS_XB), (const bf16_t*)(ws + WS_WOUTT)};
            pg8::StaticOrder<NTOK, DM> S{bid};
            EpiOutFused E{p.x, p.out, (float*)(ws + WS_SSQ), p.final_gain, xbar};
            pg8::gemm_phase<DM, DM, DM, true, true, true>(lds, g, S, E);
        }
    } else {
        if (IN(6)) {
            pg8::Gemm g{(const bf16_t*)(ws + WS_XB), (const bf16_t*)(ws + WS_WOUTT)};
            pg8::StaticOrder<NTOK, DM> S{bid};
            EpiOut E{p.x, p.out, (float*)(ws + WS_SSQ)};
            pg8::gemm_phase<DM, DM, DM>(lds, g, S, E);
        }
        SEAM(6);
        if (IN(7)) { phase_norm(p); }
    }
#undef IN
#undef SEAM
}

extern "C" void kernel_launch(void* const* d_in, const int* in_sizes, int n_in, void* d_out, int out_size, void* d_ws, size_t ws_size, hipStream_t stream) {
    static int grid = 0;
    if (grid == 0) {
        if (n_in != 15 || in_sizes[0] != NTOK * DM || out_size != NTOK * DM || ws_size < WS_END) { fprintf(stderr, "kernel_launch: unexpected shapes (n_in %d, in0 %d, out %d, ws %zu)\n", n_in, n_in > 0 ? in_sizes[0] : -1, out_size, ws_size); grid = -1; return; }
        int dev = 0, cus = 0, per_cu = 0;
        (void)hipGetDevice(&dev); (void)hipDeviceGetAttribute(&cus, hipDeviceAttributeMultiprocessorCount, dev);
        if (hipFuncSetAttribute((const void*)hymba_fwd, hipFuncAttributeMaxDynamicSharedMemorySize, LDS_BYTES) != hipSuccess) { fprintf(stderr, "kernel_launch: hipFuncSetAttribute failed\n"); grid = -1; return; }
        if (hipOccupancyMaxActiveBlocksPerMultiprocessor(&per_cu, (const void*)hymba_fwd, 512, LDS_BYTES) != hipSuccess || per_cu < 1) { fprintf(stderr, "kernel_launch: occupancy query says %d\n", per_cu); per_cu = 1; }
        (void)hipGetLastError();
        if (cus != 256) { fprintf(stderr, "kernel_launch: built for a 256-CU device (one workgroup per CU), found %d CUs; nothing launched\n", cus); grid = -1; return; }
        grid = 256;
    }
    if (grid < 0) return;
    if (hipMemsetAsync((char*)d_ws + WS_BAR, 0, (XCD_BAR_WORDS + 512) * 4, stream) != hipSuccess) { fprintf(stderr, "kernel_launch: memset of barrier words failed\n"); return; }
    Params p{};
    p.x = (const float*)d_in[0]; p.norm_gain = (const float*)d_in[1]; p.w_in = (const float*)d_in[2]; p.w_out = (const float*)d_in[3];
    p.lam_re = (const float*)d_in[4]; p.lam_im = (const float*)d_in[5]; p.b_re = (const float*)d_in[6]; p.b_im = (const float*)d_in[7];
    p.c_re = (const float*)d_in[8]; p.c_im = (const float*)d_in[9]; p.d_skip = (const float*)d_in[10]; p.log_dt = (const float*)d_in[11];
    p.w_glu = (const float*)d_in[12]; p.b_glu = (const float*)d_in[13]; p.final_gain = (const float*)d_in[14];
    p.out = (float*)d_out; p.ws = (unsigned char*)d_ws;
#if N_LAUNCH == 1
    p.ph_lo = 0; p.ph_hi = NPH;
    void* args[] = {&p};
    hipError_t e = hipLaunchCooperativeKernel((const void*)hymba_fwd, dim3(grid), dim3(512), args, LDS_BYTES, stream);
    if (e != hipSuccess) fprintf(stderr, "cooperative launch failed: %s (grid %d)\n", hipGetErrorString(e), grid);
#else
    for (int ph = 0; ph < NPH; ++ph) {
        p.ph_lo = ph; p.ph_hi = ph + 1;
        hipLaunchKernelGGL(hymba_fwd, dim3(grid), dim3(512), LDS_BYTES, stream, p);
    }
#endif
}
```

```cpp
#include <hip/hip_runtime.h>
#include <hip/hip_cooperative_groups.h>
#include <cstdio>
#include <cstdint>
namespace cg = cooperative_groups;

#ifndef ONLY_PH
#define ONLY_PH -1
#endif
#define PH_ON(x) (ONLY_PH < 0 || ONLY_PH == (x))
#ifndef N_LAUNCH
#define N_LAUNCH 1
#endif

#define LAS __attribute__((address_space(3)))
typedef unsigned short bf16_t;
typedef short bf16x8 __attribute__((ext_vector_type(8)));
typedef float f32x4 __attribute__((ext_vector_type(4)));
typedef float f32x16 __attribute__((ext_vector_type(16)));
typedef unsigned u32x2 __attribute__((ext_vector_type(2)));
typedef unsigned u32x4 __attribute__((ext_vector_type(4)));

constexpr int NTOK = 16384, DM = 1024, SEQ = 2048, NPROJ = 3072;
constexpr int NPH = 8;
constexpr size_t MBy = 1u << 20;
constexpr size_t WS_XB = 0;
constexpr size_t WS_WINT = 32 * MBy;
constexpr size_t WS_WOUTT = 38 * MBy;
constexpr size_t WS_WGLUT = 40 * MBy;
constexpr size_t WS_WST = 41 * MBy;
constexpr size_t WS_WCAT = 45 * MBy;
constexpr size_t WS_LAM16 = 51 * MBy;
constexpr size_t WS_RS = WS_LAM16 + 64 * 1024;
constexpr size_t WS_COS = WS_RS + 64 * 1024;
constexpr size_t WS_SIN = WS_COS + 256 * 1024;
constexpr size_t WS_KSUM = WS_SIN + 256 * 1024;
constexpr size_t WS_Q = 52 * MBy;
constexpr size_t WS_K = 68 * MBy;
constexpr size_t WS_VT = 84 * MBy;
constexpr size_t WS_SZA = 100 * MBy;
constexpr size_t WS_SZS = 116 * MBy;
constexpr size_t WS_XU = 132 * MBy;
constexpr size_t WS_SST = 156 * MBy;
constexpr size_t WS_YG = 172 * MBy;
constexpr size_t WS_SSQ = 188 * MBy;
constexpr size_t WS_BAR = 189 * MBy;
constexpr size_t WS_END = 190 * MBy;
constexpr int LDS_SROW = 528;
constexpr int LDS_SCANX = 256 * LDS_SROW;
constexpr int LDS_CTL = LDS_SCANX + 4096;
constexpr int LDS_BYTES = LDS_CTL + 16;

struct Params {
    const float *x, *norm_gain, *w_in, *w_out, *lam_re, *lam_im, *b_re, *b_im, *c_re, *c_im, *d_skip, *log_dt, *w_glu, *b_glu, *final_gain;
    float* out; unsigned char* ws;
    int ph_lo, ph_hi;
};

typedef float f32x2c_t __attribute__((ext_vector_type(2)));
typedef __bf16 bf16x2c_t __attribute__((ext_vector_type(2)));
__device__ __forceinline__ unsigned pk2(float lo, float hi) { const f32x2c_t v = {lo, hi}; return __builtin_bit_cast(unsigned, __builtin_convertvector(v, bf16x2c_t)); }
__device__ __forceinline__ float bf2f(unsigned short b) { return __uint_as_float(((unsigned)b) << 16); }
__device__ __forceinline__ float bflo(unsigned w) { return __uint_as_float(w << 16); }
__device__ __forceinline__ float bfhi(unsigned w) { return __uint_as_float(w & 0xffff0000u); }
__device__ __forceinline__ float wave_sum(float v) {
#pragma unroll
    for (int o = 1; o < 64; o <<= 1) v += __shfl_xor(v, o);
    return v;
}
__device__ __forceinline__ float sigmoidf_(float v) { return __builtin_amdgcn_rcpf(1.f + __expf(-v)); }
__device__ __forceinline__ float siluf_(float v) { return v * sigmoidf_(v); }
__device__ __forceinline__ float gelu_tanh(float y) { const float t = 1.5957691216f * (y + 0.044715f * y * y * y); return y * sigmoidf_(t); }


#define XB_TMO      128
#define XB_XCNT(j)  (256  + 64 * (j))
#define XB_XSUB(j)  (1280 + 64 * (j))
#define XB_XGEN(j)  (2304 + 64 * (j))
#define XB_TOP      3328
#define XB_TOPGEN   3392
#define XCD_BAR_WORDS 3456
#define XB_SPIN_CAP (1u << 18)
__device__ __forceinline__ unsigned xb_ld(unsigned* p)              { return __hip_atomic_load(p, __ATOMIC_RELAXED, __HIP_MEMORY_SCOPE_AGENT); }
__device__ __forceinline__ unsigned xb_add(unsigned* p, unsigned v) { return __hip_atomic_fetch_add(p, v, __ATOMIC_RELAXED, __HIP_MEMORY_SCOPE_AGENT); }
__device__ __forceinline__ unsigned xb_xcc_id() { return (unsigned)__builtin_amdgcn_s_getreg((3 << 11) | 20) & 0xFu; }
#define XB_SPIN(cond, bar) do { unsigned _sp = 0; while (cond) { __builtin_amdgcn_s_sleep(1); \
    if ((++_sp & 255u) == 0u) { if (xb_ld(&(bar)[XB_TMO])) break; if (_sp > XB_SPIN_CAP) { atomicAdd(&(bar)[XB_TMO], 1u); break; } } } } while (0)
struct XcdBarrier { unsigned* bar; unsigned x; volatile LAS unsigned* st; };
__device__ __forceinline__ XcdBarrier xcd_barrier_post(unsigned* bar, volatile LAS unsigned* st) {
    XcdBarrier b; b.bar = bar; b.x = xb_xcc_id(); b.st = st;
    if (threadIdx.x == 0) (void)xb_add(&bar[XB_XCNT(b.x)], 1u);
    return b;
}
__device__ __forceinline__ void xcd_barrier_complete(unsigned* bar, unsigned x, unsigned& nloc, unsigned& nx) {
    const unsigned G = 256u;
    unsigned sum, cnt, mine, sp = 0u;
    for (;;) {
        sum = 0u; cnt = 0u; mine = 0u;
#pragma unroll
        for (unsigned j = 0; j < 16; ++j) { const unsigned c = xb_ld(&bar[XB_XCNT(j)]); sum += c; cnt += (c > 0u) ? 1u : 0u; mine = (j == x) ? c : mine; }
        if (sum == G) break;
        __builtin_amdgcn_s_sleep(1);
        if ((++sp & 255u) == 0u) { if (xb_ld(&bar[XB_TMO])) break; if (sp > XB_SPIN_CAP) { atomicAdd(&bar[XB_TMO], 1u); break; } }
    }
    nloc = mine > 0u ? mine : 1u; nx = cnt > 0u ? cnt : 1u;
}
__device__ __forceinline__ void xcd_barrier(const XcdBarrier& b) {
    asm volatile("s_waitcnt vmcnt(0)" ::: "memory");
    __syncthreads();
    if (threadIdx.x == 0) {
        unsigned* bar = b.bar;
        __builtin_amdgcn_s_waitcnt(0);
        unsigned nloc = b.st[0], nx = b.st[1];
        if (nloc == 0u) { xcd_barrier_complete(bar, b.x, nloc, nx); b.st[0] = nloc; b.st[1] = nx; }
        const unsigned old = xb_add(&bar[XB_XSUB(b.x)], 1u);
        const unsigned gen = old / nloc;
        if (old + 1u == (gen + 1u) * nloc) {
            __builtin_amdgcn_fence(__ATOMIC_RELEASE, "agent");
            asm volatile("s_waitcnt vmcnt(0)" ::: "memory");
            const unsigned og = xb_add(&bar[XB_TOP], 1u);
            const unsigned tg = og / nx;
            if (og + 1u == (tg + 1u) * nx) xb_add(&bar[XB_TOPGEN], 1u);
            else XB_SPIN(xb_ld(&bar[XB_TOPGEN]) == tg, bar);
            __builtin_amdgcn_fence(__ATOMIC_ACQUIRE, "agent");
            xb_add(&bar[XB_XGEN(b.x)], 1u);
            asm volatile("s_waitcnt vmcnt(0)" ::: "memory");
        } else {
            XB_SPIN(xb_ld(&bar[XB_XGEN(b.x)]) == gen, bar);
            __builtin_amdgcn_fence(__ATOMIC_ACQUIRE, "agent");
            asm volatile("s_waitcnt vmcnt(0)" ::: "memory");
        }
    }
    __syncthreads();
}

namespace pg8 {
constexpr int BM = 256, BK = 64, HALF = 128, HTB = HALF * BK * 2, STAGE_BYTES = 8 * HTB, NXCD = 8, WGM = 8;
__device__ __forceinline__ int lds_byte(int r, int c) { const int st = (r >> 4) * 2 + (c >> 5), rr = r & 15, cc = c & 31, ob = rr * 64 + cc * 2; return st * 1024 + (ob ^ (((ob >> 9) & 1) << 5)); }
__device__ __forceinline__ void stage_rc(int b, int& R, int& C) { const int st = b / 1024, sb = b % 1024, swz = sb ^ (((sb >> 9) & 1) << 5); R = (st >> 1) * 16 + swz / 64; C = (st & 1) * 32 + (swz % 64) / 2; }
struct Unit { int pm, pn; };
struct Gemm { const bf16_t* A; const bf16_t* Bt; };

template <int M, int N>
struct StaticOrder {
    static constexpr int nM = M / BM, nN = N / BM, nwg = nM * nN, G = 256;
    int c;
    __device__ bool next(int i, Unit& u) const {
        const int L = i * G + c; if (L >= nwg) return false;
        int wgid = L; { constexpr int q = nwg / NXCD, r = nwg % NXCD; const int xcd = wgid % NXCD, off = wgid / NXCD; wgid = (xcd < r ? xcd * (q + 1) : r * (q + 1) + (xcd - r) * q) + off; }
        constexpr int nig = WGM * nN; const int gid = wgid / nig, fm = gid * WGM, gsz = (nM - fm) < WGM ? (nM - fm) : WGM;
        u.pm = fm + ((wgid % nig) % gsz); u.pn = (wgid % nig) / gsz; return true;
    }
};
struct GroupOrder {
    int G, c;
    __device__ bool next(int i, Unit& u) const { const int L = i * G + c; if (L >= 128) return false; u.pm = L; u.pn = L >> 2; return true; }
};

struct OneUnit {
    int pm, pn;
    __device__ bool next(int i, Unit& u) const { if (i) return false; u.pm = pm; u.pn = pn; return true; }
};

template <int LDA, int LDB, int KK, bool AFTER = false, bool ALIGN_EPI = true, bool SP2 = true, class Epi, class Sched>
__device__ __forceinline__ void gemm_phase(LAS unsigned char* lds, const Gemm g, const Sched& S, const Epi& E) {
    const int tid = threadIdx.x, wid = __builtin_amdgcn_readfirstlane(tid >> 6), lane = tid & 63, wr = wid >> 2, wc = wid & 3, fr = lane & 15, fq = lane >> 4;
    constexpr int K = KK, nt = K / BK;
    unsigned voffA[2], voffB[2];
#pragma unroll
    for (int i = 0; i < 2; ++i) { int R, C; stage_rc(tid * 16 + i * 8192, R, C); voffA[i] = (unsigned)(R * LDA + C) * 2u; voffB[i] = (unsigned)(R * LDB + C) * 2u; }
    constexpr size_t kstep = (size_t)(BK * 2);
    constexpr size_t hstepA = (size_t)HALF * LDA * 2, hstepB = (size_t)HALF * LDB * 2;
    constexpr size_t tstepA = 2 * hstepA, tstepB = 2 * hstepB;
    const unsigned ldsw = (unsigned)wid * 1024u;
    const int aoff = lds_byte(wr * 64 + fr, fq * 8), boff = lds_byte(wc * 32 + fr, fq * 8);
#define PG8_SA(b, h) (((b) * 2 + (h)) * HTB)
#define PG8_SB(b, h) ((4 + (b) * 2 + (h)) * HTB)
#define PG8_STAGE(bufoff, gbase, voff) do { _Pragma("unroll") for (int _i = 0; _i < 2; ++_i) \
        __builtin_amdgcn_global_load_lds((const unsigned*)((const char*)(gbase) + (voff)[_i]), (LAS unsigned*)(lds + (bufoff) + ldsw + _i * 8192), 16, 0, 0); } while (0)
#define PG8_LDA(dst, b, h) do { _Pragma("unroll") for (int m = 0; m < 4; ++m) _Pragma("unroll") for (int k = 0; k < 2; ++k) dst[m][k] = *(const LAS bf16x8*)(lds + PG8_SA(b, h) + aoff + m * 2048 + k * 1024); } while (0)
#define PG8_LDB(dst, b, h) do { _Pragma("unroll") for (int n = 0; n < 2; ++n) _Pragma("unroll") for (int k = 0; k < 2; ++k) dst[n][k] = *(const LAS bf16x8*)(lds + PG8_SB(b, h) + boff + n * 2048 + k * 1024); } while (0)
#define PG8_MMA(ai, bj, At, Bt) do { __builtin_amdgcn_s_setprio(1); _Pragma("unroll") for (int m = 0; m < 4; ++m) _Pragma("unroll") for (int n = 0; n < 2; ++n) _Pragma("unroll") for (int k = 0; k < 2; ++k) \
        acc[ai][bj][m][n] = __builtin_amdgcn_mfma_f32_16x16x32_bf16(Bt[n][k], At[m][k], acc[ai][bj][m][n], 0, 0, 0); __builtin_amdgcn_s_setprio(0); } while (0)
#define PG8_WAIT_V(n) asm volatile("s_waitcnt vmcnt(" #n ")" ::: "memory")
#define PG8_WAIT_L(n) asm volatile("s_waitcnt lgkmcnt(" #n ")" ::: "memory")
#define PG8_BAR __builtin_amdgcn_s_barrier()
#define PG8_SCHED __builtin_amdgcn_sched_barrier(0)
    Unit cur, nxt; int ui = 0;
    if (!S.next(0, cur)) return;
    f32x4 acc[2][2][4][2];
#pragma unroll
    for (int a = 0; a < 2; ++a)
#pragma unroll
        for (int b = 0; b < 2; ++b)
#pragma unroll
            for (int m = 0; m < 4; ++m)
#pragma unroll
                for (int n = 0; n < 2; ++n) acc[a][b][m][n] = (f32x4){0.f, 0.f, 0.f, 0.f};
    bf16x8 At[4][2], B0[2][2], B1[2][2];
    const char* cA = (const char*)g.A + (size_t)cur.pm * tstepA; const char* cB = (const char*)g.Bt + (size_t)cur.pn * tstepB;
    if constexpr (SP2) {
        PG8_STAGE(PG8_SB(0, 0), cB, voffB); PG8_STAGE(PG8_SB(0, 1), cB + hstepB, voffB); PG8_STAGE(PG8_SA(0, 0), cA, voffA); PG8_STAGE(PG8_SA(0, 1), cA + hstepA, voffA);
        if (wr == 1) PG8_BAR;
        PG8_WAIT_V(2); PG8_BAR;
        PG8_STAGE(PG8_SB(1, 0), cB + kstep, voffB); PG8_STAGE(PG8_SA(1, 0), cA + kstep, voffA); PG8_STAGE(PG8_SB(1, 1), cB + hstepB + kstep, voffB);
        PG8_WAIT_V(6); PG8_BAR;
    } else {
        PG8_STAGE(PG8_SB(0, 0), cB, voffB); PG8_STAGE(PG8_SA(0, 0), cA, voffA); PG8_STAGE(PG8_SB(0, 1), cB + hstepB, voffB); PG8_STAGE(PG8_SA(0, 1), cA + hstepA, voffA);
        if (wr == 1) PG8_BAR;
        PG8_WAIT_V(4); PG8_BAR;
        PG8_STAGE(PG8_SB(1, 0), cB + kstep, voffB); PG8_STAGE(PG8_SA(1, 0), cA + kstep, voffA); PG8_STAGE(PG8_SB(1, 1), cB + hstepB + kstep, voffB);
        PG8_WAIT_V(6); PG8_BAR;
    }
    for (;;) {
        const bool has_next = S.next(ui + 1, nxt);
        const char* nA = has_next ? (const char*)g.A + (size_t)nxt.pm * tstepA : cA; const char* nB = has_next ? (const char*)g.Bt + (size_t)nxt.pn * tstepB : cB;
        for (int t = 0; t < nt; t += 2) {
            const bool last = (t == nt - 2);
            const char* a1 = cA + (size_t)(t + 1) * kstep;
            const char* a2 = last ? nA : cA + (size_t)(t + 2) * kstep; const char* b2 = last ? nB : cB + (size_t)(t + 2) * kstep;
            const char* a3 = a2 + kstep; const char* b3 = b2 + kstep;
            if constexpr (SP2) {
            PG8_LDB(B0, 0, 0); PG8_LDB(B1, 0, 1); PG8_SCHED; PG8_LDA(At, 0, 0); PG8_STAGE(PG8_SA(1, 1), a1 + hstepA, voffA);
            PG8_WAIT_V(8); PG8_WAIT_L(0); PG8_BAR; PG8_MMA(0, 0, At, B0); PG8_MMA(0, 1, At, B1); PG8_BAR; PG8_SCHED;
            PG8_LDA(At, 0, 1); PG8_STAGE(PG8_SB(0, 0), b2, voffB); PG8_STAGE(PG8_SB(0, 1), b2 + hstepB, voffB); PG8_STAGE(PG8_SA(0, 0), a2, voffA);
            PG8_WAIT_V(8); PG8_WAIT_L(0); PG8_BAR; PG8_MMA(1, 0, At, B0); PG8_MMA(1, 1, At, B1); PG8_BAR; PG8_SCHED;
            PG8_LDB(B0, 1, 0); PG8_LDB(B1, 1, 1); PG8_SCHED; PG8_LDA(At, 1, 0); PG8_STAGE(PG8_SA(0, 1), a2 + hstepA, voffA);
            PG8_WAIT_V(8); PG8_WAIT_L(0); PG8_BAR; PG8_MMA(0, 0, At, B0); PG8_MMA(0, 1, At, B1); PG8_BAR; PG8_SCHED;
            PG8_LDA(At, 1, 1); PG8_STAGE(PG8_SB(1, 0), b3, voffB); PG8_STAGE(PG8_SB(1, 1), b3 + hstepB, voffB); PG8_STAGE(PG8_SA(1, 0), a3, voffA);
            PG8_WAIT_V(8); PG8_WAIT_L(0); PG8_BAR; PG8_MMA(1, 0, At, B0); PG8_MMA(1, 1, At, B1); PG8_BAR; PG8_SCHED;
            } else {
            PG8_LDB(B0, 0, 0); PG8_SCHED; PG8_LDA(At, 0, 0); PG8_STAGE(PG8_SA(1, 1), a1 + hstepA, voffA);
            PG8_WAIT_L(8); PG8_BAR; PG8_WAIT_L(0); PG8_MMA(0, 0, At, B0); PG8_BAR; PG8_SCHED;
            PG8_LDB(B1, 0, 1); PG8_STAGE(PG8_SB(0, 0), b2, voffB);
            PG8_BAR; PG8_WAIT_L(0); PG8_MMA(0, 1, At, B1); PG8_BAR;
            PG8_LDA(At, 0, 1); PG8_STAGE(PG8_SA(0, 0), a2, voffA);
            PG8_BAR; PG8_WAIT_L(0); PG8_MMA(1, 0, At, B0); PG8_BAR; PG8_SCHED;
            PG8_STAGE(PG8_SB(0, 1), b2 + hstepB, voffB);
            PG8_WAIT_V(6); PG8_BAR; PG8_MMA(1, 1, At, B1); PG8_BAR;
            PG8_LDB(B0, 1, 0); PG8_SCHED; PG8_LDA(At, 1, 0); PG8_STAGE(PG8_SA(0, 1), a2 + hstepA, voffA);
            PG8_WAIT_L(8); PG8_BAR; PG8_WAIT_L(0); PG8_MMA(0, 0, At, B0); PG8_BAR; PG8_SCHED;
            PG8_LDB(B1, 1, 1); PG8_STAGE(PG8_SB(1, 0), b3, voffB);
            PG8_BAR; PG8_WAIT_L(0); PG8_MMA(0, 1, At, B1); PG8_BAR;
            PG8_LDA(At, 1, 1); PG8_STAGE(PG8_SA(1, 0), a3, voffA);
            PG8_BAR; PG8_WAIT_L(0); PG8_MMA(1, 0, At, B0); PG8_BAR; PG8_SCHED;
            PG8_STAGE(PG8_SB(1, 1), b3 + hstepB, voffB);
            PG8_WAIT_V(6); PG8_BAR; PG8_MMA(1, 1, At, B1); PG8_BAR;
                    }
        }
        if constexpr (ALIGN_EPI) { if (wr == 0) PG8_BAR; }
        E(acc, cur, wr, wc, fr, fq);
        if (!has_next) break;
#pragma unroll
        for (int a = 0; a < 2; ++a)
#pragma unroll
            for (int b = 0; b < 2; ++b)
#pragma unroll
                for (int m = 0; m < 4; ++m)
#pragma unroll
                    for (int n = 0; n < 2; ++n) acc[a][b][m][n] = (f32x4){0.f, 0.f, 0.f, 0.f};
        cur = nxt; cA = nA; cB = nB; ++ui;
        if constexpr (ALIGN_EPI) { if (wr == 1) PG8_BAR; }
    }
    PG8_WAIT_V(0);
    if constexpr (!ALIGN_EPI) { if (wr == 0) PG8_BAR; }
    PG8_BAR;
    if constexpr (AFTER) E.after(acc, cur, wr, wc, fr, fq);
#undef PG8_SA
#undef PG8_SB
#undef PG8_STAGE
#undef PG8_LDA
#undef PG8_LDB
#undef PG8_MMA
#undef PG8_WAIT_V
#undef PG8_WAIT_L
#undef PG8_BAR
#undef PG8_SCHED
}
}
using pg8::Unit;


__device__ __forceinline__ int inproj_row(int e) {
    const int pn = e >> 8, o = e & 255;
    const int wc = o >> 6, bj = (o >> 5) & 1, fq = (o >> 3) & 3, n = (o >> 2) & 1, i = o & 3;
    return 256 * pn + 128 * bj + 32 * wc + 16 * n + 4 * fq + i;
}

struct EpiInProj {
    const float *rs, *cosT, *sinT;
    bf16_t *Q, *Kk, *VT, *SZA, *SZS, *XU; float* KSUM;
    __device__ __forceinline__ void operator()(const f32x4 (&acc)[2][2][4][2], const Unit& u, int wr, int wc, int fr, int fq) const {
        const int seg = u.pn >> 1, half = u.pn & 1;
        const int b = u.pm >> 3, blk = u.pm & 7;
        const int lbase = blk * 256 + wr * 64 + fr;
        if (seg <= 1) {
            bf16_t* dst = seg == 0 ? Q : Kk; const float qs = seg == 0 ? 0.18033688011112042f : 1.0f;
            const int head = 4 * half + wc;
            f32x4 cl[2], ch[2];
#pragma unroll
            for (int n = 0; n < 2; ++n) { cl[n] = (f32x4){0.f, 0.f, 0.f, 0.f}; ch[n] = (f32x4){0.f, 0.f, 0.f, 0.f}; }
            bf16_t* obase = dst + ((size_t)((b * 8 + head) * 2048)) * 64 + 8 * fq;
#pragma unroll
            for (int ai = 0; ai < 2; ++ai)
#pragma unroll
                for (int m = 0; m < 4; ++m) {
                    const int l = lbase + 128 * ai + 16 * m; const float rsv = rs[b * 2048 + l] * qs;
                    unsigned wl[4], wh[4];
#pragma unroll
                    for (int n = 0; n < 2; ++n) {
                        const f32x4 c4 = *(const f32x4*)(cosT + l * 32 + 8 * fq + 4 * n), s4 = *(const f32x4*)(sinT + l * 32 + 8 * fq + 4 * n);
                        const f32x4 t1 = acc[ai][0][m][n] * rsv, t2 = acc[ai][1][m][n] * rsv;
                        const f32x4 lo = t1 * c4 - t2 * s4, hi = t2 * c4 + t1 * s4;
                        wl[2 * n] = pk2(lo[0], lo[1]); wl[2 * n + 1] = pk2(lo[2], lo[3]); wh[2 * n] = pk2(hi[0], hi[1]); wh[2 * n + 1] = pk2(hi[2], hi[3]);
                        cl[n] += lo; ch[n] += hi;
                    }
                    bf16_t* o = obase + (unsigned)l * 64u;
                    *(u32x4*)o = (u32x4){wl[0], wl[1], wl[2], wl[3]};
                    *(u32x4*)(o + 32) = (u32x4){wh[0], wh[1], wh[2], wh[3]};
                }
            if (seg == 1) {
#pragma unroll
                for (int n = 0; n < 2; ++n)
#pragma unroll
                    for (int i = 0; i < 4; ++i) {
                        float v = cl[n][i], v2 = ch[n][i];
                        v += __shfl_xor(v, 1); v += __shfl_xor(v, 2); v += __shfl_xor(v, 4); v += __shfl_xor(v, 8);
                        v2 += __shfl_xor(v2, 1); v2 += __shfl_xor(v2, 2); v2 += __shfl_xor(v2, 4); v2 += __shfl_xor(v2, 8);
                        if (fr == 0) { float* kp = KSUM + ((b * 8 + head) * 8 + blk) * 64 + 8 * fq + 4 * n + i; atomicAdd(kp, v); atomicAdd(kp + 32, v2); }
                    }
            }
        } else if (seg == 2) {
            const int head = 4 * half + wc;
#pragma unroll
            for (int ai = 0; ai < 2; ++ai)
#pragma unroll
                for (int m = 0; m < 4; ++m) {
                    const int l = lbase + 128 * ai + 16 * m; const float rsv = rs[b * 2048 + l];
#pragma unroll
                    for (int bj = 0; bj < 2; ++bj)
#pragma unroll
                        for (int n = 0; n < 2; ++n) {
                            const int d0 = 32 * bj + 8 * fq + 4 * n;
                            const f32x4 v = acc[ai][bj][m][n] * rsv;
                            bf16_t* o = VT + ((size_t)((b * 8 + head) * 64 + d0)) * 2048 + l;
                            const unsigned p0 = pk2(v[0], v[1]), p1 = pk2(v[2], v[3]);
                            o[0] = (bf16_t)(p0 & 0xffffu); o[2048] = (bf16_t)(p0 >> 16); o[4096] = (bf16_t)(p1 & 0xffffu); o[6144] = (bf16_t)(p1 >> 16);
                        }
                }
        } else if (seg == 4) {
#pragma unroll
            for (int ai = 0; ai < 2; ++ai)
#pragma unroll
                for (int m = 0; m < 4; ++m) {
                    const int l = lbase + 128 * ai + 16 * m; const float rsv = rs[b * 2048 + l];
                    const int c = l >> 4, t = l & 15;
#pragma unroll
                    for (int bj = 0; bj < 2; ++bj) {
                        const int g = 16 * half + 4 * wc + 2 * bj + (fq >> 1);
                        const f32x4 v0 = acc[ai][bj][m][0] * rsv, v1 = acc[ai][bj][m][1] * rsv;
                        bf16_t* o = XU + ((size_t)(1024 * g + b * 128 + c)) * 384 + 128 + t * 16 + 8 * (fq & 1);
                        *(u32x4*)o = (u32x4){pk2(v0[0], v0[1]), pk2(v0[2], v0[3]), pk2(v1[0], v1[1]), pk2(v1[2], v1[3])};
                    }
                }
        } else {
            bf16_t* dst = seg == 3 ? SZA : SZS;
#pragma unroll
            for (int ai = 0; ai < 2; ++ai)
#pragma unroll
                for (int m = 0; m < 4; ++m) {
                    const int l = lbase + 128 * ai + 16 * m; const int row = b * 2048 + l; const float rsv = rs[row];
#pragma unroll
                    for (int bj = 0; bj < 2; ++bj) {
                        const int col = 256 * half + 64 * wc + 32 * bj + 8 * fq;
                        const f32x4 v0 = acc[ai][bj][m][0] * rsv, v1 = acc[ai][bj][m][1] * rsv;
                        *(u32x4*)(dst + (size_t)row * 512 + col) = (u32x4){pk2(siluf_(v0[0]), siluf_(v0[1])), pk2(siluf_(v0[2]), siluf_(v0[3])), pk2(siluf_(v1[0]), siluf_(v1[1])), pk2(siluf_(v1[2]), siluf_(v1[3]))};
                    }
                }
        }
    }
};

struct EpiS {
    LAS unsigned char* lds;
    __device__ __forceinline__ void operator()(const f32x4 (&acc)[2][2][4][2], const Unit& u, int wr, int wc, int fr, int fq) const {}
    __device__ __forceinline__ void after(const f32x4 (&acc)[2][2][4][2], const Unit& u, int wr, int wc, int fr, int fq) const {
#pragma unroll
        for (int ai = 0; ai < 2; ++ai)
#pragma unroll
            for (int m = 0; m < 4; ++m) {
                const int r = 128 * ai + 64 * wr + 16 * m + fr;
#pragma unroll
                for (int n = 0; n < 2; ++n) *(LAS f32x4*)(lds + r * LDS_SROW + (32 * wc + 16 * n + 4 * fq) * 4) = acc[ai][0][m][n];
            }
    }
};

struct EpiY {
    bf16_t* YG;
    __device__ __forceinline__ void operator()(const f32x4 (&acc)[2][2][4][2], const Unit& u, int wr, int wc, int fr, int fq) const {
        const int g = u.pn, t = 4 * wc + fq;
#pragma unroll
        for (int ai = 0; ai < 2; ++ai)
#pragma unroll
            for (int m = 0; m < 4; ++m) {
                const int rr = 256 * (u.pm & 3) + 128 * ai + 64 * wr + 16 * m + fr;
                const int b = rr >> 7, c = rr & 127; const int token = b * 2048 + 16 * c + t;
                bf16_t* ob = YG + (size_t)token * 512 + 16 * g;
#pragma unroll
                for (int bj = 0; bj < 2; ++bj) {
                    const f32x4 v0 = acc[ai][bj][m][0], v1 = acc[ai][bj][m][1];
                    *(u32x4*)(ob + 8 * bj) = (u32x4){pk2(gelu_tanh(v0[0]), gelu_tanh(v0[1])), pk2(gelu_tanh(v0[2]), gelu_tanh(v0[3])), pk2(gelu_tanh(v1[0]), gelu_tanh(v1[1])), pk2(gelu_tanh(v1[2]), gelu_tanh(v1[3]))};
                }
            }
    }
};

struct EpiGlu {
    const bf16_t *YG, *SZS; const float* bglu; bf16_t* MIXED;
    __device__ __forceinline__ void operator()(const f32x4 (&acc)[2][2][4][2], const Unit& u, int wr, int wc, int fr, int fq) const {
        f32x4 bias[2][2];
#pragma unroll
        for (int bj = 0; bj < 2; ++bj)
#pragma unroll
            for (int n = 0; n < 2; ++n) bias[bj][n] = *(const f32x4*)(bglu + 256 * u.pn + 64 * wc + 32 * bj + 8 * fq + 4 * n);
#pragma unroll
        for (int ai = 0; ai < 2; ++ai) {
            u32x4 y4[4][2], z4[4][2];
#pragma unroll
            for (int m = 0; m < 4; ++m) {
                const int row = 256 * u.pm + 128 * ai + 64 * wr + 16 * m + fr;
#pragma unroll
                for (int bj = 0; bj < 2; ++bj) {
                    const unsigned off = (unsigned)row * 512u + (unsigned)(256 * u.pn + 64 * wc + 32 * bj + 8 * fq);
                    y4[m][bj] = *(const u32x4*)(YG + off); z4[m][bj] = *(const u32x4*)(SZS + off);
                }
            }
#pragma unroll
            for (int m = 0; m < 4; ++m) {
                const int row = 256 * u.pm + 128 * ai + 64 * wr + 16 * m + fr;
#pragma unroll
                for (int bj = 0; bj < 2; ++bj) {
                    const int col = 256 * u.pn + 64 * wc + 32 * bj + 8 * fq;
                    unsigned w[4];
#pragma unroll
                    for (int n = 0; n < 2; ++n) {
                        const f32x4 a = acc[ai][bj][m][n] + bias[bj][n];
                        const unsigned ya = y4[m][bj][2 * n], yb = y4[m][bj][2 * n + 1], za = z4[m][bj][2 * n], zb = z4[m][bj][2 * n + 1];
                        const float o0 = bflo(ya) * sigmoidf_(a[0]) * bflo(za), o1 = bfhi(ya) * sigmoidf_(a[1]) * bfhi(za);
                        const float o2 = bflo(yb) * sigmoidf_(a[2]) * bflo(zb), o3 = bfhi(yb) * sigmoidf_(a[3]) * bfhi(zb);
                        w[2 * n] = pk2(o0, o1); w[2 * n + 1] = pk2(o2, o3);
                    }
                    *(u32x4*)(MIXED + (size_t)row * 1024 + 512 + col) = (u32x4){w[0], w[1], w[2], w[3]};
                }
            }
        }
    }
};

struct EpiOut {
    const float* x; float* out; float* SSQ;
    __device__ __forceinline__ void operator()(const f32x4 (&acc)[2][2][4][2], const Unit& u, int wr, int wc, int fr, int fq) const {
#pragma unroll
        for (int ai = 0; ai < 2; ++ai) {
            f32x4 xv[4][2][2];
#pragma unroll
            for (int m = 0; m < 4; ++m) {
                const int row = 256 * u.pm + 128 * ai + 64 * wr + 16 * m + fr;
#pragma unroll
                for (int bj = 0; bj < 2; ++bj)
#pragma unroll
                    for (int n = 0; n < 2; ++n) xv[m][bj][n] = __builtin_nontemporal_load((const f32x4*)(x + (size_t)row * 1024 + 256 * u.pn + 64 * wc + 32 * bj + 8 * fq + 4 * n));
            }
#pragma unroll
            for (int m = 0; m < 4; ++m) {
                const int row = 256 * u.pm + 128 * ai + 64 * wr + 16 * m + fr;
                float ss = 0.f;
#pragma unroll
                for (int bj = 0; bj < 2; ++bj)
#pragma unroll
                    for (int n = 0; n < 2; ++n) {
                        const int col = 256 * u.pn + 64 * wc + 32 * bj + 8 * fq + 4 * n;
                        const f32x4 v = acc[ai][bj][m][n] + xv[m][bj][n];
                        *(f32x4*)(out + (size_t)row * 1024 + col) = v;
                        ss += (v[0] * v[0] + v[1] * v[1]) + (v[2] * v[2] + v[3] * v[3]);
                    }
                ss += __shfl_xor(ss, 16); ss += __shfl_xor(ss, 32);
                if (fq == 0) SSQ[row * 16 + 4 * u.pn + wc] = ss;
            }
        }
    }
};

struct EpiOutFused {
    const float* x; float* out; float* SSQ; const float* gain; XcdBarrier xbar;
    __device__ __forceinline__ void operator()(f32x4 (&acc)[2][2][4][2], const Unit& u, int wr, int wc, int fr, int fq) const {
#pragma unroll
        for (int ai = 0; ai < 2; ++ai) {
            f32x4 xv[4][2][2];
#pragma unroll
            for (int m = 0; m < 4; ++m) {
                const int row = 256 * u.pm + 128 * ai + 64 * wr + 16 * m + fr;
#pragma unroll
                for (int bj = 0; bj < 2; ++bj)
#pragma unroll
                    for (int n = 0; n < 2; ++n) xv[m][bj][n] = __builtin_nontemporal_load((const f32x4*)(x + (size_t)row * 1024 + 256 * u.pn + 64 * wc + 32 * bj + 8 * fq + 4 * n));
            }
#pragma unroll
            for (int m = 0; m < 4; ++m) {
                const int row = 256 * u.pm + 128 * ai + 64 * wr + 16 * m + fr;
                float ss = 0.f;
#pragma unroll
                for (int bj = 0; bj < 2; ++bj)
#pragma unroll
                    for (int n = 0; n < 2; ++n) {
                        const f32x4 v = acc[ai][bj][m][n] + xv[m][bj][n];
                        acc[ai][bj][m][n] = v;
                        ss += (v[0] * v[0] + v[1] * v[1]) + (v[2] * v[2] + v[3] * v[3]);
                    }
                ss += __shfl_xor(ss, 16); ss += __shfl_xor(ss, 32);
                if (fq == 0) SSQ[row * 16 + 4 * u.pn + wc] = ss;
            }
        }
    }
    __device__ __forceinline__ void after(f32x4 (&acc)[2][2][4][2], const Unit& u, int wr, int wc, int fr, int fq) const {
        xcd_barrier(xbar);
        f32x4 gn[2][2];
#pragma unroll
        for (int bj = 0; bj < 2; ++bj)
#pragma unroll
            for (int n = 0; n < 2; ++n) gn[bj][n] = *(const f32x4*)(gain + 256 * u.pn + 64 * wc + 32 * bj + 8 * fq + 4 * n);
#pragma unroll
        for (int ai = 0; ai < 2; ++ai)
#pragma unroll
            for (int m = 0; m < 4; ++m) {
                const int row = 256 * u.pm + 128 * ai + 64 * wr + 16 * m + fr;
                const f32x4* sp = (const f32x4*)(SSQ + row * 16);
                const f32x4 s0 = sp[0], s1 = sp[1], s2 = sp[2], s3 = sp[3];
                const float tot = ((s0[0] + s0[1]) + (s0[2] + s0[3])) + ((s1[0] + s1[1]) + (s1[2] + s1[3])) + ((s2[0] + s2[1]) + (s2[2] + s2[3])) + ((s3[0] + s3[1]) + (s3[2] + s3[3]));
                const float rinv = 1.0f / sqrtf(tot * (1.f / DM) + 1e-6f);
#pragma unroll
                for (int bj = 0; bj < 2; ++bj)
#pragma unroll
                    for (int n = 0; n < 2; ++n) {
                        const int col = 256 * u.pn + 64 * wc + 32 * bj + 8 * fq + 4 * n;
                        *(f32x4*)(out + (size_t)row * 1024 + col) = acc[ai][bj][m][n] * rinv * gn[bj][n];
                    }
            }
    }
};

template <int MODE>
__device__ __forceinline__ void transpose_item(const float* W, int K, int N, bf16_t* WT, const float* gain, LAS float* scr, int item, int lane) {
    const int nblk = N / 32, kb = item / nblk, nb = item % nblk, k0 = 64 * kb, n0 = 32 * nb;
#pragma unroll 8
    for (int i = 0; i < 32; ++i) { const int kk = 2 * i + (lane >> 5); float w = W[(size_t)(k0 + kk) * N + n0 + (lane & 31)]; if (MODE == 0) w *= gain[k0 + kk]; scr[kk * 33 + (lane & 31)] = w; }
    const int c = lane & 7;
#pragma unroll
    for (int j = 0; j < 4; ++j) { const int n = (lane >> 3) + 8 * j; const LAS float* s = scr + (8 * c) * 33 + n;
        u32x4 o; o.x = pk2(s[0 * 33], s[1 * 33]); o.y = pk2(s[2 * 33], s[3 * 33]); o.z = pk2(s[4 * 33], s[5 * 33]); o.w = pk2(s[6 * 33], s[7 * 33]);
        const int drow = inproj_row(n0 + n);
        *(u32x4*)(WT + (size_t)drow * K + k0 + 8 * c) = o; }
}

__device__ __forceinline__ void ssm_group_prep(const Params& p, int item, LAS float* L) {
    LAS float* lkr = L; LAS float* lki = L + 1088; LAS float* bbr = L + 2176; LAS float* bbi = L + 3200; LAS float* cr = L + 4224; LAS float* ci = L + 5248; LAS float* Kt = L + 6272;
    const int tid = threadIdx.x, g = item >> 3, sub = item & 7;
    const float dt = expf(p.log_dt[g]);
    for (int t = tid; t < 17 * 64; t += 512) {
        const int pp = t & 63, k = t >> 6;
        const float a = p.lam_re[g * 64 + pp] * dt, th = p.lam_im[g * 64 + pp] * dt;
        const float mag = expf((float)k * a); float sn, cs; sincosf((float)k * th, &sn, &cs);
        lkr[k * 64 + pp] = mag * cs; lki[k * 64 + pp] = mag * sn;
    }
    for (int t = tid; t < 1024; t += 512) {
        const int pp = t >> 4, h = t & 15;
        const float lr = p.lam_re[g * 64 + pp], li = p.lam_im[g * 64 + pp];
        const float a = lr * dt, th = li * dt;
        float sn, cs; sincosf(th, &sn, &cs); const float sh = sinf(0.5f * th);
        const float em1 = expm1f(a), ea = em1 + 1.f;
        const float xr = em1 * cs - 2.f * sh * sh, xi = ea * sn;
        const float den = 1.f / (lr * lr + li * li);
        const float cfr = (xr * lr + xi * li) * den, cfi = (xi * lr - xr * li) * den;
        const float br = p.b_re[(g * 64 + pp) * 16 + h], bi = p.b_im[(g * 64 + pp) * 16 + h];
        bbr[pp * 16 + h] = cfr * br - cfi * bi; bbi[pp * 16 + h] = cfr * bi + cfi * br;
        cr[h * 64 + pp] = p.c_re[(g * 16 + h) * 64 + pp]; ci[h * 64 + pp] = p.c_im[(g * 16 + h) * 64 + pp];
    }
    __syncthreads();
    {
        const int k = tid >> 5, hl = (tid >> 4) & 1, h2 = tid & 15, h = 2 * sub + hl;
        float sacc = 0.f;
        for (int pp = 0; pp < 64; ++pp) {
            const float c_r = cr[h * 64 + pp], c_i = ci[h * 64 + pp], l_r = lkr[k * 64 + pp], l_i = lki[k * 64 + pp];
            const float er = c_r * l_r - c_i * l_i, ei = c_r * l_i + c_i * l_r;
            sacc += er * bbr[pp * 16 + h2] - ei * bbi[pp * 16 + h2];
        }
        if (k == 0 && h == h2) sacc += p.d_skip[g * 16 + h];
        Kt[tid] = sacc;
    }
    __syncthreads();
    bf16_t* WCAT = (bf16_t*)(p.ws + WS_WCAT) + (size_t)g * 256 * 384;
    bf16_t* WST = (bf16_t*)(p.ws + WS_WST) + (size_t)g * 256 * 256;
    for (int e = tid; e < 32 * 192; e += 512) {
        const int rl = e / 192, kk = (e - rl * 192) * 2;
        const int t = rl >> 1, hl = rl & 1, h = 2 * sub + hl;
        const int row = 128 * (h >> 3) + 32 * (t >> 2) + 16 * ((h >> 2) & 1) + 4 * (t & 3) + (h & 3);
        float v[2];
#pragma unroll
        for (int q = 0; q < 2; ++q) {
            const int k2 = kk + q;
            if (k2 < 128) { const int pp = k2 & 63; const float c_r = cr[h * 64 + pp], c_i = ci[h * 64 + pp], l_r = lkr[(t + 1) * 64 + pp], l_i = lki[(t + 1) * 64 + pp];
                v[q] = k2 < 64 ? (c_r * l_r - c_i * l_i) : -(c_r * l_i + c_i * l_r); }
            else { const int s2 = (k2 - 128) >> 4, h2 = (k2 - 128) & 15; v[q] = s2 <= t ? Kt[((t - s2) * 2 + hl) * 16 + h2] : 0.f; }
        }
        *(unsigned*)(WCAT + (size_t)row * 384 + kk) = pk2(v[0], v[1]);
    }
    for (int e = tid; e < 32 * 128; e += 512) {
        const int rl = e >> 7, kk = (e & 127) * 2;
        const int row = rl < 16 ? 16 * sub + rl : 128 + 16 * sub + (rl - 16);
        float v[2] = {0.f, 0.f};
        if (row < 128) {
            const int pp = row & 63;
#pragma unroll
            for (int q = 0; q < 2; ++q) { const int s2 = (kk + q) >> 4, h = (kk + q) & 15; const float l_r = lkr[(15 - s2) * 64 + pp], l_i = lki[(15 - s2) * 64 + pp], b_r = bbr[pp * 16 + h], b_i = bbi[pp * 16 + h];
                v[q] = row < 64 ? (l_r * b_r - l_i * b_i) : (l_r * b_i + l_i * b_r); }
        }
        *(unsigned*)(WST + (size_t)row * 256 + kk) = pk2(v[0], v[1]);
    }
    if (sub == 0 && tid < 64) { float* L16 = (float*)(p.ws + WS_LAM16) + (g * 64 + tid) * 2; L16[0] = lkr[16 * 64 + tid]; L16[1] = lki[16 * 64 + tid]; }
    __syncthreads();
}

__device__ __forceinline__ void phase_prep(const Params& p, LAS unsigned char* lds) {
    const int tid = threadIdx.x, lane = tid & 63, wave = tid >> 6, G = 256, bid = blockIdx.x;
    for (int item = bid; item < 256; item += G) ssm_group_prep(p, item, (LAS float*)lds);
    const int gw = bid * 8 + wave, NGW = G * 8;
    {
        bf16_t* XB = (bf16_t*)(p.ws + WS_XB); float* RS = (float*)(p.ws + WS_RS);
        for (int row = gw; row < NTOK; row += NGW) {
            const f32x4* xr = (const f32x4*)(p.x + (size_t)row * DM) + lane;
            f32x4 v[4]; float s = 0.f;
#pragma unroll
            for (int j = 0; j < 4; ++j) { v[j] = __builtin_nontemporal_load(xr + 64 * j); s += (v[j][0] * v[j][0] + v[j][1] * v[j][1]) + (v[j][2] * v[j][2] + v[j][3] * v[j][3]); }
            s = wave_sum(s);
            if (lane == 0) RS[row] = 1.0f / sqrtf(s * (1.f / DM) + 1e-6f);
            u32x2* o = (u32x2*)(XB + (size_t)row * DM) + lane;
#pragma unroll
            for (int j = 0; j < 4; ++j) o[64 * j] = (u32x2){pk2(v[j][0], v[j][1]), pk2(v[j][2], v[j][3])};
        }
    }
    {
        LAS float* scr = (LAS float*)(lds + 49152) + wave * (64 * 33);
        constexpr int I_IN = (DM / 64) * (NPROJ / 32), I_OUT = (DM / 64) * (DM / 32), I_GLU = (512 / 64) * (512 / 32);
        for (int it = gw; it < I_IN + I_OUT + I_GLU; it += NGW) {
            int r = it;
            if (r < I_IN) { transpose_item<0>(p.w_in, DM, NPROJ, (bf16_t*)(p.ws + WS_WINT), p.norm_gain, scr, r, lane); continue; } r -= I_IN;
            if (r < I_OUT) { transpose_item<1>(p.w_out, DM, DM, (bf16_t*)(p.ws + WS_WOUTT), nullptr, scr, r, lane); continue; } r -= I_OUT;
            transpose_item<1>(p.w_glu, 512, 512, (bf16_t*)(p.ws + WS_WGLUT), nullptr, scr, r, lane);
        }
    }
    {
        float* COS = (float*)(p.ws + WS_COS); float* SIN = (float*)(p.ws + WS_SIN); float* KSUM = (float*)(p.ws + WS_KSUM);
        for (int i = bid * 512 + tid; i < SEQ * 32; i += G * 512) {
            const int pos = i >> 5, f = i & 31;
            const float inv = 1.0f / powf(10000.0f, (float)f * (1.f / 32.f));
            const float ang = (float)pos * inv; float sn, cs; sincosf(ang, &sn, &cs);
            COS[i] = cs; SIN[i] = sn;
        }
        for (int i = bid * 512 + tid; i < 4096; i += G * 512) KSUM[i] = 0.f;
    }
}

__device__ __forceinline__ int swap23(int r) { return (r & ~12) | ((r & 4) << 1) | ((r & 8) >> 1); }

typedef float f32x2 __attribute__((ext_vector_type(2)));
__device__ __forceinline__ float max3f(float a, float b, float c) { float r; asm("v_max3_f32 %0, %1, %2, %3" : "=v"(r) : "v"(a), "v"(b), "v"(c)); return r; }
template <bool DIAG>
__device__ __forceinline__ void attn_tile(LAS unsigned char* B, unsigned kf_off, unsigned vf_off, const bf16x8 (&qf)[4], f32x16& O0, f32x16& O1, float& mrun, float& lrun,
                                          bool on, int kpos0, int qpos, int hh) {
    constexpr int ROWB = 144;
    const float cinit = on ? -mrun : -1e30f;
    f32x16 st0, st1;
#pragma unroll
    for (int i = 0; i < 16; ++i) { st0[i] = cinit; st1[i] = cinit; }
#pragma unroll
    for (int s = 0; s < 4; ++s) {
        const bf16x8 k0 = *(const LAS bf16x8*)(B + kf_off + s * 32), k1 = *(const LAS bf16x8*)(B + kf_off + 32 * ROWB + s * 32);
        st0 = __builtin_amdgcn_mfma_f32_32x32x16_bf16(k0, qf[s], st0, 0, 0, 0);
        st1 = __builtin_amdgcn_mfma_f32_32x32x16_bf16(k1, qf[s], st1, 0, 0, 0);
    }
    if (DIAG) {
#pragma unroll
        for (int i = 0; i < 16; ++i) {
            const int key = kpos0 + (i & 7) + 8 * hh + 16 * (i >> 3);
            if (key > qpos) st0[i] = -1e30f;
            if (key + 32 > qpos) st1[i] = -1e30f;
        }
    }
    float mx = max3f(st0[0], st0[1], st0[2]);
#pragma unroll
    for (int i = 3; i < 15; i += 2) mx = max3f(mx, st0[i], st0[i + 1]);
    mx = max3f(mx, st0[15], st1[0]);
#pragma unroll
    for (int i = 1; i < 15; i += 2) mx = max3f(mx, st1[i], st1[i + 1]);
    mx = fmaxf(mx, st1[15]);
    mx = fmaxf(mx, __shfl_xor(mx, 32));
    const bool grow = on && (mx > 8.f);
    if (__ballot(grow) != 0ull) {
        const float d = grow ? mx : 0.f;
        const float alpha = __builtin_amdgcn_exp2f(-d);
        lrun *= alpha; mrun += d;
#pragma unroll
        for (int i = 0; i < 16; ++i) { O0[i] *= alpha; O1[i] *= alpha; st0[i] -= d; st1[i] -= d; }
    }
    float rsum = 0.f;
#pragma unroll
    for (int i = 0; i < 16; ++i) { const float p0 = __builtin_amdgcn_exp2f(st0[i]), p1 = __builtin_amdgcn_exp2f(st1[i]); st0[i] = p0; st1[i] = p1; rsum += p0; rsum += p1; }
    rsum += __shfl_xor(rsum, 32);
    lrun += rsum;
#pragma unroll
    for (int s4 = 0; s4 < 4; ++s4) {
        u32x4 t4;
        if (s4 < 2) t4 = (u32x4){pk2(st0[8 * s4], st0[8 * s4 + 1]), pk2(st0[8 * s4 + 2], st0[8 * s4 + 3]), pk2(st0[8 * s4 + 4], st0[8 * s4 + 5]), pk2(st0[8 * s4 + 6], st0[8 * s4 + 7])};
        else { const int s = s4 - 2; t4 = (u32x4){pk2(st1[8 * s], st1[8 * s + 1]), pk2(st1[8 * s + 2], st1[8 * s + 3]), pk2(st1[8 * s + 4], st1[8 * s + 5]), pk2(st1[8 * s + 6], st1[8 * s + 7])}; }
        const bf16x8 pf = __builtin_bit_cast(bf16x8, t4);
        const bf16x8 v0 = *(const LAS bf16x8*)(B + vf_off + s4 * 32), v1 = *(const LAS bf16x8*)(B + vf_off + 32 * ROWB + s4 * 32);
        O0 = __builtin_amdgcn_mfma_f32_32x32x16_bf16(v0, pf, O0, 0, 0, 0);
        O1 = __builtin_amdgcn_mfma_f32_32x32x16_bf16(v1, pf, O1, 0, 0, 0);
    }
}

__device__ __forceinline__ void attn_tile2(LAS unsigned char* BA, LAS unsigned char* BB, unsigned kf_off, unsigned vf_off, const bf16x8 (&qf)[4], f32x16& O0, f32x16& O1, float& mrun, float& lrun, bool on) {
    constexpr int ROWB = 144;
    const float cinit = on ? -mrun : -1e30f;
    f32x16 sa0, sa1, sb0, sb1;
#pragma unroll
    for (int i = 0; i < 16; ++i) { sa0[i] = cinit; sa1[i] = cinit; sb0[i] = cinit; sb1[i] = cinit; }
#pragma unroll
    for (int s = 0; s < 4; ++s) {
        const bf16x8 k0 = *(const LAS bf16x8*)(BA + kf_off + s * 32), k1 = *(const LAS bf16x8*)(BA + kf_off + 32 * ROWB + s * 32);
        const bf16x8 k2 = *(const LAS bf16x8*)(BB + kf_off + s * 32), k3 = *(const LAS bf16x8*)(BB + kf_off + 32 * ROWB + s * 32);
        sa0 = __builtin_amdgcn_mfma_f32_32x32x16_bf16(k0, qf[s], sa0, 0, 0, 0);
        sa1 = __builtin_amdgcn_mfma_f32_32x32x16_bf16(k1, qf[s], sa1, 0, 0, 0);
        sb0 = __builtin_amdgcn_mfma_f32_32x32x16_bf16(k2, qf[s], sb0, 0, 0, 0);
        sb1 = __builtin_amdgcn_mfma_f32_32x32x16_bf16(k3, qf[s], sb1, 0, 0, 0);
    }
    float mx = max3f(sa0[0], sa0[1], sa0[2]), my = max3f(sb0[0], sb0[1], sb0[2]);
#pragma unroll
    for (int i = 3; i < 15; i += 2) { mx = max3f(mx, sa0[i], sa0[i + 1]); my = max3f(my, sb0[i], sb0[i + 1]); }
    mx = max3f(mx, sa0[15], sa1[0]); my = max3f(my, sb0[15], sb1[0]);
#pragma unroll
    for (int i = 1; i < 15; i += 2) { mx = max3f(mx, sa1[i], sa1[i + 1]); my = max3f(my, sb1[i], sb1[i + 1]); }
    mx = max3f(mx, sa1[15], fmaxf(my, sb1[15]));
    mx = fmaxf(mx, __shfl_xor(mx, 32));
    const bool grow = on && (mx > 8.f);
    if (__ballot(grow) != 0ull) {
        const float d = grow ? mx : 0.f;
        const float alpha = __builtin_amdgcn_exp2f(-d);
        lrun *= alpha; mrun += d;
#pragma unroll
        for (int i = 0; i < 16; ++i) { O0[i] *= alpha; O1[i] *= alpha; sa0[i] -= d; sa1[i] -= d; sb0[i] -= d; sb1[i] -= d; }
    }
    float rsum = 0.f;
#define AT2_EXP(S0, S1) _Pragma("unroll") for (int i = 0; i < 16; ++i) { const float p0 = __builtin_amdgcn_exp2f(S0[i]), p1 = __builtin_amdgcn_exp2f(S1[i]); S0[i] = p0; S1[i] = p1; rsum += p0; rsum += p1; }
#define AT2_PV(S0, S1, BUF) _Pragma("unroll") for (int s4 = 0; s4 < 4; ++s4) { \
        u32x4 t4; \
        if (s4 < 2) t4 = (u32x4){pk2(S0[8 * s4], S0[8 * s4 + 1]), pk2(S0[8 * s4 + 2], S0[8 * s4 + 3]), pk2(S0[8 * s4 + 4], S0[8 * s4 + 5]), pk2(S0[8 * s4 + 6], S0[8 * s4 + 7])}; \
        else { const int s_ = s4 - 2; t4 = (u32x4){pk2(S1[8 * s_], S1[8 * s_ + 1]), pk2(S1[8 * s_ + 2], S1[8 * s_ + 3]), pk2(S1[8 * s_ + 4], S1[8 * s_ + 5]), pk2(S1[8 * s_ + 6], S1[8 * s_ + 7])}; } \
        const bf16x8 pf = __builtin_bit_cast(bf16x8, t4); \
        const bf16x8 v0 = *(const LAS bf16x8*)(BUF + vf_off + s4 * 32), v1 = *(const LAS bf16x8*)(BUF + vf_off + 32 * ROWB + s4 * 32); \
        O0 = __builtin_amdgcn_mfma_f32_32x32x16_bf16(v0, pf, O0, 0, 0, 0); \
        O1 = __builtin_amdgcn_mfma_f32_32x32x16_bf16(v1, pf, O1, 0, 0, 0); }
    AT2_EXP(sa0, sa1)
    AT2_PV(sa0, sa1, BA)
    AT2_EXP(sb0, sb1)
    AT2_PV(sb0, sb1, BB)
#undef AT2_EXP
#undef AT2_PV
    rsum += __shfl_xor(rsum, 32);
    lrun += rsum;
}

__device__ __forceinline__ void phase_attn(const Params& p, LAS unsigned char* lds, unsigned* queue) {
    const int tid = threadIdx.x, lane = tid & 63, w = __builtin_amdgcn_readfirstlane(tid >> 6), r = lane & 31, hh = lane >> 5;
    const bf16_t* Qg = (const bf16_t*)(p.ws + WS_Q); const bf16_t* Kg = (const bf16_t*)(p.ws + WS_K); const bf16_t* VTg = (const bf16_t*)(p.ws + WS_VT);
    const bf16_t* SZA = (const bf16_t*)(p.ws + WS_SZA); const float* KSUM = (const float*)(p.ws + WS_KSUM);
    bf16_t* MIXED = (bf16_t*)(p.ws + WS_XB);
    constexpr int ROWB = 144, TILEB = 64 * ROWB, BUFB = 2 * TILEB;
    const int srow = tid >> 3, sch = tid & 7;
    const unsigned st_off = (unsigned)(srow * ROWB + sch * 16);
    const unsigned kf_off = (unsigned)(swap23(r) * ROWB + hh * 16);
    const unsigned vf_off = (unsigned)(TILEB + r * ROWB + hh * 16);
    volatile LAS unsigned* tick = (volatile LAS unsigned*)(lds + LDS_CTL + 8);
    for (;;) {
        if (tid == 0) *tick = __hip_atomic_fetch_add(queue, 1u, __ATOMIC_RELAXED, __HIP_MEMORY_SCOPE_AGENT);
        __syncthreads();
        const int idx = (int)*tick;
        if (idx >= 512) break;
        const int blk = 7 - (idx >> 6), bh = idx & 63, b = bh >> 3, h = bh & 7;
        const int qpos = blk * 256 + w * 32 + r;
        const bf16_t* Qp = Qg + ((size_t)bh * 2048 + qpos) * 64 + 8 * hh;
        bf16x8 qf[4];
#pragma unroll
        for (int s = 0; s < 4; ++s) qf[s] = *(const bf16x8*)(Qp + 16 * s);
        unsigned selmask;
        if (blk <= 3) selmask = (1u << blk) - 1u;
        else {
            float v1 = -3e38f, v2 = -3e38f, v3 = -3e38f; int i1 = 0, i2 = 0, i3 = 0;
#pragma unroll
            for (int j = 0; j < 7; ++j) {
                if (j < blk) {
                    const float* ks = KSUM + ((size_t)bh * 8 + j) * 64 + 8 * hh;
                    float gsum = 0.f;
#pragma unroll
                    for (int s = 0; s < 4; ++s) {
                        const f32x4 k0 = *(const f32x4*)(ks + 16 * s), k1 = *(const f32x4*)(ks + 16 * s + 4);
                        gsum += bf2f((unsigned short)qf[s][0]) * k0[0] + bf2f((unsigned short)qf[s][1]) * k0[1] + bf2f((unsigned short)qf[s][2]) * k0[2] + bf2f((unsigned short)qf[s][3]) * k0[3]
                              + bf2f((unsigned short)qf[s][4]) * k1[0] + bf2f((unsigned short)qf[s][5]) * k1[1] + bf2f((unsigned short)qf[s][6]) * k1[2] + bf2f((unsigned short)qf[s][7]) * k1[3];
                    }
                    gsum += __shfl_xor(gsum, 32);
                    if (gsum > v1) { v3 = v2; i3 = i2; v2 = v1; i2 = i1; v1 = gsum; i1 = j; }
                    else if (gsum > v2) { v3 = v2; i3 = i2; v2 = gsum; i2 = j; }
                    else if (gsum > v3) { v3 = gsum; i3 = j; }
                }
            }
            selmask = (1u << i1) | (1u << i2) | (1u << i3);
        }
        f32x16 O0, O1;
#pragma unroll
        for (int i = 0; i < 16; ++i) { O0[i] = 0.f; O1[i] = 0.f; }
        float mrun = 0.f, lrun = 0.f;
        const int ntile = 4 + 4 * blk;
        const bf16_t* Kst = Kg + ((size_t)bh * 2048 + srow) * 64 + sch * 8;
        const bf16_t* Vst = VTg + ((size_t)bh * 64 + srow) * 2048 + sch * 8;
        u32x4 kreg[2], vreg[2];
#pragma unroll
        for (int q = 0; q < 2; ++q) { const int kp = blk * 256 + 64 * q; kreg[q] = *(const u32x4*)(Kst + (size_t)kp * 64); vreg[q] = *(const u32x4*)(Vst + kp); }
#pragma unroll
        for (int q = 0; q < 2; ++q) { *(LAS u32x4*)(lds + q * BUFB + st_off) = kreg[q]; *(LAS u32x4*)(lds + q * BUFB + TILEB + st_off) = vreg[q]; }
        __syncthreads();
        for (int n = 0; n < ntile; n += 2) {
            if (n + 2 < ntile) {
#pragma unroll
                for (int q = 0; q < 2; ++q) { const int m = n + 2 + q; const int kp = m < 4 ? blk * 256 + 64 * m : ((m - 4) >> 2) * 256 + 64 * ((m - 4) & 3);
                    kreg[q] = *(const u32x4*)(Kst + (size_t)kp * 64); vreg[q] = *(const u32x4*)(Vst + kp); }
            }
            LAS unsigned char* SB = lds + ((n >> 1) & 1) * (2 * BUFB);
            if (n >= 4) {
                const bool on = (selmask >> ((n - 4) >> 2)) & 1u;
                if (__ballot(on) != 0ull) attn_tile2(SB, SB + BUFB, kf_off, vf_off, qf, O0, O1, mrun, lrun, on);
            } else {
#pragma unroll
                for (int q = 0; q < 2; ++q) {
                    const int nn = n + q;
                    const int kpos0 = blk * 256 + 64 * nn;
                    LAS unsigned char* B = SB + q * BUFB;
                    const int dt_ = w >> 1;
                    if (nn == dt_) attn_tile<true>(B, kf_off, vf_off, qf, O0, O1, mrun, lrun, true, kpos0, qpos, hh);
                    else if (nn < dt_) attn_tile<false>(B, kf_off, vf_off, qf, O0, O1, mrun, lrun, true, kpos0, qpos, hh);
                }
            }
            if (n + 2 < ntile) { LAS unsigned char* Bn = lds + (((n >> 1) + 1) & 1) * (2 * BUFB);
#pragma unroll
                for (int q = 0; q < 2; ++q) { *(LAS u32x4*)(Bn + q * BUFB + st_off) = kreg[q]; *(LAS u32x4*)(Bn + q * BUFB + TILEB + st_off) = vreg[q]; } }
            __syncthreads();
        }
        const float inv = 1.f / lrun;
        const size_t row = (size_t)b * 2048 + qpos;
#pragma unroll
        for (int dt = 0; dt < 2; ++dt)
#pragma unroll
            for (int g4 = 0; g4 < 4; ++g4) {
                const int d0 = 32 * dt + 8 * g4 + 4 * hh;
                const u32x2 z2 = *(const u32x2*)(SZA + row * 512 + h * 64 + d0);
                float o0, o1, o2, o3;
                if (dt == 0) { o0 = O0[4 * g4]; o1 = O0[4 * g4 + 1]; o2 = O0[4 * g4 + 2]; o3 = O0[4 * g4 + 3]; }
                else { o0 = O1[4 * g4]; o1 = O1[4 * g4 + 1]; o2 = O1[4 * g4 + 2]; o3 = O1[4 * g4 + 3]; }
                o0 *= inv * bflo(z2[0]); o1 *= inv * bfhi(z2[0]); o2 *= inv * bflo(z2[1]); o3 *= inv * bfhi(z2[1]);
                *(u32x2*)(MIXED + row * 1024 + h * 64 + d0) = (u32x2){pk2(o0, o1), pk2(o2, o3)};
            }
    }
}

__device__ __forceinline__ void scan_unit(const Params& p, LAS unsigned char* lds, int L) {
    const int tid = threadIdx.x, lane = tid & 63, wave = __builtin_amdgcn_readfirstlane(tid >> 6);
    bf16_t* XU = (bf16_t*)(p.ws + WS_XU); const float* L16 = (const float*)(p.ws + WS_LAM16);
    LAS float* E = (LAS float*)(lds + LDS_SCANX);
    const int g = L >> 2;
    const float lr = L16[(g * 64 + lane) * 2], li = L16[(g * 64 + lane) * 2 + 1];
    float pr = lr, pi = li;
#pragma unroll
    for (int q = 0; q < 4; ++q) { const float nr = pr * pr - pi * pi, ni = 2.f * pr * pi; pr = nr; pi = ni; }
    for (int bb = 0; bb < 2; ++bb) {
        const size_t base = (size_t)256 * L + 128 * bb + 16 * wave;
        float sr[16], si[16];
#pragma unroll
        for (int c = 0; c < 16; ++c) { const LAS float* rowp = (const LAS float*)(lds + (128 * bb + 16 * wave + c) * LDS_SROW); sr[c] = rowp[lane]; si[c] = rowp[64 + lane]; }
        float er = 0.f, ei = 0.f;
#pragma unroll
        for (int c = 0; c < 16; ++c) { const float nr = lr * er - li * ei + sr[c], ni = lr * ei + li * er + si[c]; er = nr; ei = ni; }
        E[(wave * 2) * 64 + lane] = er; E[(wave * 2 + 1) * 64 + lane] = ei;
        __syncthreads();
        float Xr = 0.f, Xi = 0.f;
        for (int s2 = 0; s2 < wave; ++s2) { const float e_r = E[(s2 * 2) * 64 + lane], e_i = E[(s2 * 2 + 1) * 64 + lane]; const float nr = pr * Xr - pi * Xi + e_r, ni = pr * Xi + pi * Xr + e_i; Xr = nr; Xi = ni; }
#pragma unroll
        for (int c = 0; c < 16; ++c) {
            const size_t R = base + c;
            XU[R * 384 + lane] = (bf16_t)(pk2(Xr, 0.f) & 0xffffu); XU[R * 384 + 64 + lane] = (bf16_t)(pk2(Xi, 0.f) & 0xffffu);
            const float nr = lr * Xr - li * Xi + sr[c], ni = lr * Xi + li * Xr + si[c]; Xr = nr; Xi = ni;
        }
        __syncthreads();
    }
}

__device__ __forceinline__ void phase_norm(const Params& p) {
    const int tid = threadIdx.x, lane = tid & 63, wave = tid >> 6, G = gridDim.x;
    const float* SSQ = (const float*)(p.ws + WS_SSQ);
    f32x4 gn[4];
#pragma unroll
    for (int j = 0; j < 4; ++j) gn[j] = *((const f32x4*)p.final_gain + lane + 64 * j);
    for (int row = blockIdx.x * 8 + wave; row < NTOK; row += 8 * G) {
        float s = 0.f;
#pragma unroll
        for (int i = 0; i < 16; ++i) s += SSQ[row * 16 + i];
        const float rinv = 1.0f / sqrtf(s * (1.f / DM) + 1e-6f);
        f32x4* o = (f32x4*)(p.out + (size_t)row * DM) + lane;
#pragma unroll
        for (int j = 0; j < 4; ++j) { f32x4 v = o[64 * j]; v = v * rinv * gn[j]; o[64 * j] = v; }
    }
}

__global__ __launch_bounds__(512, 2) void hymba_fwd(Params p) {
    extern __shared__ __attribute__((aligned(16))) unsigned char shm_raw[];
    LAS unsigned char* lds = (LAS unsigned char*)shm_raw;
    cg::grid_group grid = cg::this_grid();
    constexpr int G = 256;
    const int bid = blockIdx.x;
    unsigned char* ws = p.ws;
#if N_LAUNCH == 1
    constexpr int lo = 0, hi = NPH;
#else
    const int lo = p.ph_lo, hi = p.ph_hi;
#endif
    if (threadIdx.x < 4) ((LAS unsigned*)(lds + LDS_CTL))[threadIdx.x] = 0u;
    __syncthreads();
    XcdBarrier xbar = xcd_barrier_post((unsigned*)(ws + WS_BAR), (volatile LAS unsigned*)(lds + LDS_CTL));
    if (hi > 1000) grid.sync();
#define IN(k) (PH_ON(k) && lo <= (k) && (k) < hi)
#define SEAM(k) do { if (lo <= (k) && (k) + 1 < hi) xcd_barrier(xbar); } while (0)
    if (IN(0)) { phase_prep(p, lds); }
    SEAM(0);
    if (IN(1)) {
        pg8::Gemm g{(const bf16_t*)(ws + WS_XB), (const bf16_t*)(ws + WS_WINT)};
        pg8::StaticOrder<NTOK, NPROJ> S{bid};
        EpiInProj E{(const float*)(ws + WS_RS), (const float*)(ws + WS_COS), (const float*)(ws + WS_SIN),
                    (bf16_t*)(ws + WS_Q), (bf16_t*)(ws + WS_K), (bf16_t*)(ws + WS_VT), (bf16_t*)(ws + WS_SZA), (bf16_t*)(ws + WS_SZS), (bf16_t*)(ws + WS_XU), (float*)(ws + WS_KSUM)};
        pg8::gemm_phase<DM, DM, DM>(lds, g, S, E);
    }
    SEAM(1);
    if (IN(2)) {
        unsigned* cnt = (unsigned*)(ws + WS_BAR) + XCD_BAR_WORDS;
        if (bid < 128) {
            const int L = bid;
            {
                pg8::Gemm g{(const bf16_t*)(ws + WS_XU) + 128, (const bf16_t*)(ws + WS_WST)};
                pg8::OneUnit S{L, L >> 2};
                EpiS E{lds};
                pg8::gemm_phase<384, 256, 256, true, false, false>(lds, g, S, E);
            }
            asm volatile("s_waitcnt vmcnt(0)" ::: "memory");
            __syncthreads();
            scan_unit(p, lds, L);
            asm volatile("s_waitcnt vmcnt(0)" ::: "memory");
            __syncthreads();
            {
                pg8::Gemm g{(const bf16_t*)(ws + WS_XU), (const bf16_t*)(ws + WS_WCAT)};
                pg8::OneUnit S{L, L >> 2};
                EpiY E{(bf16_t*)(ws + WS_YG)};
                pg8::gemm_phase<384, 384, 384, false, true, false>(lds, g, S, E);
            }
            asm volatile("s_waitcnt vmcnt(0)" ::: "memory");
            __syncthreads();
            if (threadIdx.x == 0) {
                __builtin_amdgcn_fence(__ATOMIC_RELEASE, "agent");
                asm volatile("s_waitcnt vmcnt(0)" ::: "memory");
                __hip_atomic_fetch_add(cnt + 64 * (L & 3), 1u, __ATOMIC_RELAXED, __HIP_MEMORY_SCOPE_AGENT);
            }
        }
        if (bid < 128) {
            const int U = bid;
            const int pm = U >> 1, pn = U & 1;
            if (threadIdx.x == 0) {
                unsigned sp = 0;
                while (__hip_atomic_load(cnt + 64 * (pm >> 4), __ATOMIC_RELAXED, __HIP_MEMORY_SCOPE_AGENT) < 32u) { __builtin_amdgcn_s_sleep(2); if (++sp > (1u << 22)) break; }
                __builtin_amdgcn_fence(__ATOMIC_ACQUIRE, "agent");
                asm volatile("s_waitcnt vmcnt(0)" ::: "memory");
            }
            __syncthreads();
            pg8::Gemm g{(const bf16_t*)(ws + WS_YG), (const bf16_t*)(ws + WS_WGLUT)};
            pg8::OneUnit S{pm, pn};
            EpiGlu E{(const bf16_t*)(ws + WS_YG), (const bf16_t*)(ws + WS_SZS), p.b_glu, (bf16_t*)(ws + WS_XB)};
            pg8::gemm_phase<512, 512, 512, false, true, false>(lds, g, S, E);
        }
        phase_attn(p, lds, cnt + 256);
    }
    SEAM(2);
    if (G == 256) {
        if (IN(6)) {
            pg8::Gemm g{(const bf16_t*)(ws + WS_XB), (const bf16_t*)(ws + WS_WOUTT)};
            pg8::StaticOrder<NTOK, DM> S{bid};
            EpiOutFused E{p.x, p.out, (float*)(ws + WS_SSQ), p.final_gain, xbar};
            pg8::gemm_phase<DM, DM, DM, true, true, true>(lds, g, S, E);
        }
    } else {
        if (IN(6)) {
            pg8::Gemm g{(const bf16_t*)(ws + WS_XB), (const bf16_t*)(ws + WS_WOUTT)};
            pg8::StaticOrder<NTOK, DM> S{bid};
            EpiOut E{p.x, p.out, (float*)(ws + WS_SSQ)};
            pg8::gemm_phase<DM, DM, DM>(lds, g, S, E);
        }
        SEAM(6);
        if (IN(7)) { phase_norm(p); }
    }
#undef IN
#undef SEAM
}

extern "C" void kernel_launch(void* const* d_in, const int* in_sizes, int n_in, void* d_out, int out_size, void* d_ws, size_t ws_size, hipStream_t stream) {
    static int grid = 0;
    if (grid == 0) {
        if (n_in != 15 || in_sizes[0] != NTOK * DM || out_size != NTOK * DM || ws_size < WS_END) { fprintf(stderr, "kernel_launch: unexpected shapes (n_in %d, in0 %d, out %d, ws %zu)\n", n_in, n_in > 0 ? in_sizes[0] : -1, out_size, ws_size); grid = -1; return; }
        int dev = 0, cus = 0, per_cu = 0;
        (void)hipGetDevice(&dev); (void)hipDeviceGetAttribute(&cus, hipDeviceAttributeMultiprocessorCount, dev);
        if (hipFuncSetAttribute((const void*)hymba_fwd, hipFuncAttributeMaxDynamicSharedMemorySize, LDS_BYTES) != hipSuccess) { fprintf(stderr, "kernel_launch: hipFuncSetAttribute failed\n"); grid = -1; return; }
        if (hipOccupancyMaxActiveBlocksPerMultiprocessor(&per_cu, (const void*)hymba_fwd, 512, LDS_BYTES) != hipSuccess || per_cu < 1) { fprintf(stderr, "kernel_launch: occupancy query says %d\n", per_cu); per_cu = 1; }
        (void)hipGetLastError();
        if (cus != 256) { fprintf(stderr, "kernel_launch: built for a 256-CU device (one workgroup per CU), found %d CUs; nothing launched\n", cus); grid = -1; return; }
        grid = 256;
    }
    if (grid < 0) return;
    if (hipMemsetAsync((char*)d_ws + WS_BAR, 0, (XCD_BAR_WORDS + 512) * 4, stream) != hipSuccess) { fprintf(stderr, "kernel_launch: memset of barrier words failed\n"); return; }
    Params p{};
    p.x = (const float*)d_in[0]; p.norm_gain = (const float*)d_in[1]; p.w_in = (const float*)d_in[2]; p.w_out = (const float*)d_in[3];
    p.lam_re = (const float*)d_in[4]; p.lam_im = (const float*)d_in[5]; p.b_re = (const float*)d_in[6]; p.b_im = (const float*)d_in[7];
    p.c_re = (const float*)d_in[8]; p.c_im = (const float*)d_in[9]; p.d_skip = (const float*)d_in[10]; p.log_dt = (const float*)d_in[11];
    p.w_glu = (const float*)d_in[12]; p.b_glu = (const float*)d_in[13]; p.final_gain = (const float*)d_in[14];
    p.out = (float*)d_out; p.ws = (unsigned char*)d_ws;
#if N_LAUNCH == 1
    p.ph_lo = 0; p.ph_hi = NPH;
    void* args[] = {&p};
    hipError_t e = hipLaunchCooperativeKernel((const void*)hymba_fwd, dim3(grid), dim3(512), args, LDS_BYTES, stream);
    if (e != hipSuccess) fprintf(stderr, "cooperative launch failed: %s (grid %d)\n", hipGetErrorString(e), grid);
#else
    for (int ph = 0; ph < NPH; ++ph) {
        p.ph_lo = ph; p.ph_hi = ph + 1;
        hipLaunchKernelGGL(hymba_fwd, dim3(grid), dim3(512), LDS_BYTES, stream, p);
    }
#endif
}
```

```cpp
#include <hip/hip_runtime.h>
#include <hip/hip_cooperative_groups.h>
#include <cstdio>
#include <cstdint>
namespace cg = cooperative_groups;

#ifndef ONLY_PH
#define ONLY_PH -1
#endif
#define PH_ON(x) (ONLY_PH < 0 || ONLY_PH == (x))
#ifndef N_LAUNCH
#define N_LAUNCH 1
#endif

#define LAS __attribute__((address_space(3)))
typedef unsigned short bf16_t;
typedef short bf16x8 __attribute__((ext_vector_type(8)));
typedef float f32x4 __attribute__((ext_vector_type(4)));
typedef float f32x16 __attribute__((ext_vector_type(16)));
typedef unsigned u32x2 __attribute__((ext_vector_type(2)));
typedef unsigned u32x4 __attribute__((ext_vector_type(4)));

constexpr int NTOK = 16384, DM = 1024, SEQ = 2048, NPROJ = 3072;
constexpr int NPH = 8;
constexpr size_t MBy = 1u << 20;
constexpr size_t WS_XB = 0;
constexpr size_t WS_WINT = 32 * MBy;
constexpr size_t WS_WOUTT = 38 * MBy;
constexpr size_t WS_WGLUT = 40 * MBy;
constexpr size_t WS_WST = 41 * MBy;
constexpr size_t WS_WCAT = 45 * MBy;
constexpr size_t WS_LAM16 = 51 * MBy;
constexpr size_t WS_RS = WS_LAM16 + 64 * 1024;
constexpr size_t WS_COS = WS_RS + 64 * 1024;
constexpr size_t WS_SIN = WS_COS + 256 * 1024;
constexpr size_t WS_KSUM = WS_SIN + 256 * 1024;
constexpr size_t WS_Q = 52 * MBy;
constexpr size_t WS_K = 68 * MBy;
constexpr size_t WS_VT = 84 * MBy;
constexpr size_t WS_SZA = 100 * MBy;
constexpr size_t WS_SZS = 116 * MBy;
constexpr size_t WS_XU = 132 * MBy;
constexpr size_t WS_SST = 156 * MBy;
constexpr size_t WS_YG = 172 * MBy;
constexpr size_t WS_SSQ = 188 * MBy;
constexpr size_t WS_BAR = 189 * MBy;
constexpr size_t WS_END = 190 * MBy;
constexpr int LDS_SROW = 528;
constexpr int LDS_SCANX = 256 * LDS_SROW;
constexpr int LDS_CTL = LDS_SCANX + 4096;
constexpr int LDS_BYTES = LDS_CTL + 16;

struct Params {
    const float *x, *norm_gain, *w_in, *w_out, *lam_re, *lam_im, *b_re, *b_im, *c_re, *c_im, *d_skip, *log_dt, *w_glu, *b_glu, *final_gain;
    float* out; unsigned char* ws;
    int ph_lo, ph_hi;
};

typedef float f32x2c_t __attribute__((ext_vector_type(2)));
typedef __bf16 bf16x2c_t __attribute__((ext_vector_type(2)));
__device__ __forceinline__ unsigned pk2(float lo, float hi) { const f32x2c_t v = {lo, hi}; return __builtin_bit_cast(unsigned, __builtin_convertvector(v, bf16x2c_t)); }
__device__ __forceinline__ float bf2f(unsigned short b) { return __uint_as_float(((unsigned)b) << 16); }
__device__ __forceinline__ float bflo(unsigned w) { return __uint_as_float(w << 16); }
__device__ __forceinline__ float bfhi(unsigned w) { return __uint_as_float(w & 0xffff0000u); }
__device__ __forceinline__ float wave_sum(float v) {
#pragma unroll
    for (int o = 1; o < 64; o <<= 1) v += __shfl_xor(v, o);
    return v;
}
__device__ __forceinline__ float sigmoidf_(float v) { return __builtin_amdgcn_rcpf(1.f + __expf(-v)); }
__device__ __forceinline__ float siluf_(float v) { return v * sigmoidf_(v); }
__device__ __forceinline__ float gelu_tanh(float y) { const float t = 1.5957691216f * (y + 0.044715f * y * y * y); return y * sigmoidf_(t); }


#define XB_TMO      128
#define XB_XCNT(j)  (256  + 64 * (j))
#define XB_XSUB(j)  (1280 + 64 * (j))
#define XB_XGEN(j)  (2304 + 64 * (j))
#define XB_TOP      3328
#define XB_TOPGEN   3392
#define XCD_BAR_WORDS 3456
#define XB_SPIN_CAP (1u << 18)
__device__ __forceinline__ unsigned xb_ld(unsigned* p)              { return __hip_atomic_load(p, __ATOMIC_RELAXED, __HIP_MEMORY_SCOPE_AGENT); }
__device__ __forceinline__ unsigned xb_add(unsigned* p, unsigned v) { return __hip_atomic_fetch_add(p, v, __ATOMIC_RELAXED, __HIP_MEMORY_SCOPE_AGENT); }
__device__ __forceinline__ unsigned xb_xcc_id() { return (unsigned)__builtin_amdgcn_s_getreg((3 << 11) | 20) & 0xFu; }
#define XB_SPIN(cond, bar) do { unsigned _sp = 0; while (cond) { __builtin_amdgcn_s_sleep(1); \
    if ((++_sp & 255u) == 0u) { if (xb_ld(&(bar)[XB_TMO])) break; if (_sp > XB_SPIN_CAP) { atomicAdd(&(bar)[XB_TMO], 1u); break; } } } } while (0)
struct XcdBarrier { unsigned* bar; unsigned x; volatile LAS unsigned* st; };
__device__ __forceinline__ XcdBarrier xcd_barrier_post(unsigned* bar, volatile LAS unsigned* st) {
    XcdBarrier b; b.bar = bar; b.x = xb_xcc_id(); b.st = st;
    if (threadIdx.x == 0) (void)xb_add(&bar[XB_XCNT(b.x)], 1u);
    return b;
}
__device__ __forceinline__ void xcd_barrier_complete(unsigned* bar, unsigned x, unsigned& nloc, unsigned& nx) {
    const unsigned G = 256u;
    unsigned sum, cnt, mine, sp = 0u;
    for (;;) {
        sum = 0u; cnt = 0u; mine = 0u;
#pragma unroll
        for (unsigned j = 0; j < 16; ++j) { const unsigned c = xb_ld(&bar[XB_XCNT(j)]); sum += c; cnt += (c > 0u) ? 1u : 0u; mine = (j == x) ? c : mine; }
        if (sum == G) break;
        __builtin_amdgcn_s_sleep(1);
        if ((++sp & 255u) == 0u) { if (xb_ld(&bar[XB_TMO])) break; if (sp > XB_SPIN_CAP) { atomicAdd(&bar[XB_TMO], 1u); break; } }
    }
    nloc = mine > 0u ? mine : 1u; nx = cnt > 0u ? cnt : 1u;
}
__device__ __forceinline__ void xcd_barrier(const XcdBarrier& b) {
    asm volatile("s_waitcnt vmcnt(0)" ::: "memory");
    __syncthreads();
    if (threadIdx.x == 0) {
        unsigned* bar = b.bar;
        __builtin_amdgcn_s_waitcnt(0);
        unsigned nloc = b.st[0], nx = b.st[1];
        if (nloc == 0u) { xcd_barrier_complete(bar, b.x, nloc, nx); b.st[0] = nloc; b.st[1] = nx; }
        const unsigned old = xb_add(&bar[XB_XSUB(b.x)], 1u);
        const unsigned gen = old / nloc;
        if (old + 1u == (gen + 1u) * nloc) {
            __builtin_amdgcn_fence(__ATOMIC_RELEASE, "agent");
            asm volatile("s_waitcnt vmcnt(0)" ::: "memory");
            const unsigned og = xb_add(&bar[XB_TOP], 1u);
            const unsigned tg = og / nx;
            if (og + 1u == (tg + 1u) * nx) xb_add(&bar[XB_TOPGEN], 1u);
            else XB_SPIN(xb_ld(&bar[XB_TOPGEN]) == tg, bar);
            __builtin_amdgcn_fence(__ATOMIC_ACQUIRE, "agent");
            xb_add(&bar[XB_XGEN(b.x)], 1u);
            asm volatile("s_waitcnt vmcnt(0)" ::: "memory");
        } else {
            XB_SPIN(xb_ld(&bar[XB_XGEN(b.x)]) == gen, bar);
            __builtin_amdgcn_fence(__ATOMIC_ACQUIRE, "agent");
            asm volatile("s_waitcnt vmcnt(0)" ::: "memory");
        }
    }
    __syncthreads();
}

namespace pg8 {
constexpr int BM = 256, BK = 64, HALF = 128, HTB = HALF * BK * 2, STAGE_BYTES = 8 * HTB, NXCD = 8, WGM = 8;
__device__ __forceinline__ int lds_byte(int r, int c) { const int st = (r >> 4) * 2 + (c >> 5), rr = r & 15, cc = c & 31, ob = rr * 64 + cc * 2; return st * 1024 + (ob ^ (((ob >> 9) & 1) << 5)); }
__device__ __forceinline__ void stage_rc(int b, int& R, int& C) { const int st = b / 1024, sb = b % 1024, swz = sb ^ (((sb >> 9) & 1) << 5); R = (st >> 1) * 16 + swz / 64; C = (st & 1) * 32 + (swz % 64) / 2; }
struct Unit { int pm, pn; };
struct Gemm { const bf16_t* A; const bf16_t* Bt; };

template <int M, int N>
struct StaticOrder {
    static constexpr int nM = M / BM, nN = N / BM, nwg = nM * nN, G = 256;
    int c;
    __device__ bool next(int i, Unit& u) const {
        const int L = i * G + c; if (L >= nwg) return false;
        int wgid = L; { constexpr int q = nwg / NXCD, r = nwg % NXCD; const int xcd = wgid % NXCD, off = wgid / NXCD; wgid = (xcd < r ? xcd * (q + 1) : r * (q + 1) + (xcd - r) * q) + off; }
        constexpr int nig = WGM * nN; const int gid = wgid / nig, fm = gid * WGM, gsz = (nM - fm) < WGM ? (nM - fm) : WGM;
        u.pm = fm + ((wgid % nig) % gsz); u.pn = (wgid % nig) / gsz; return true;
    }
};
struct GroupOrder {
    int G, c;
    __device__ bool next(int i, Unit& u) const { const int L = i * G + c; if (L >= 128) return false; u.pm = L; u.pn = L >> 2; return true; }
};

struct OneUnit {
    int pm, pn;
    __device__ bool next(int i, Unit& u) const { if (i) return false; u.pm = pm; u.pn = pn; return true; }
};

template <int LDA, int LDB, int KK, bool AFTER = false, bool ALIGN_EPI = true, bool SP2 = true, class Epi, class Sched>
__device__ __forceinline__ void gemm_phase(LAS unsigned char* lds, const Gemm g, const Sched& S, const Epi& E) {
    const int tid = threadIdx.x, wid = __builtin_amdgcn_readfirstlane(tid >> 6), lane = tid & 63, wr = wid >> 2, wc = wid & 3, fr = lane & 15, fq = lane >> 4;
    constexpr int K = KK, nt = K / BK;
    unsigned voffA[2], voffB[2];
#pragma unroll
    for (int i = 0; i < 2; ++i) { int R, C; stage_rc(tid * 16 + i * 8192, R, C); voffA[i] = (unsigned)(R * LDA + C) * 2u; voffB[i] = (unsigned)(R * LDB + C) * 2u; }
    constexpr size_t kstep = (size_t)(BK * 2);
    constexpr size_t hstepA = (size_t)HALF * LDA * 2, hstepB = (size_t)HALF * LDB * 2;
    constexpr size_t tstepA = 2 * hstepA, tstepB = 2 * hstepB;
    const unsigned ldsw = (unsigned)wid * 1024u;
    const int aoff = lds_byte(wr * 64 + fr, fq * 8), boff = lds_byte(wc * 32 + fr, fq * 8);
#define PG8_SA(b, h) (((b) * 2 + (h)) * HTB)
#define PG8_SB(b, h) ((4 + (b) * 2 + (h)) * HTB)
#define PG8_STAGE(bufoff, gbase, voff) do { _Pragma("unroll") for (int _i = 0; _i < 2; ++_i) \
        __builtin_amdgcn_global_load_lds((const unsigned*)((const char*)(gbase) + (voff)[_i]), (LAS unsigned*)(lds + (bufoff) + ldsw + _i * 8192), 16, 0, 0); } while (0)
#define PG8_LDA(dst, b, h) do { _Pragma("unroll") for (int m = 0; m < 4; ++m) _Pragma("unroll") for (int k = 0; k < 2; ++k) dst[m][k] = *(const LAS bf16x8*)(lds + PG8_SA(b, h) + aoff + m * 2048 + k * 1024); } while (0)
#define PG8_LDB(dst, b, h) do { _Pragma("unroll") for (int n = 0; n < 2; ++n) _Pragma("unroll") for (int k = 0; k < 2; ++k) dst[n][k] = *(const LAS bf16x8*)(lds + PG8_SB(b, h) + boff + n * 2048 + k * 1024); } while (0)
#define PG8_MMA(ai, bj, At, Bt) do { __builtin_amdgcn_s_setprio(1); _Pragma("unroll") for (int m = 0; m < 4; ++m) _Pragma("unroll") for (int n = 0; n < 2; ++n) _Pragma("unroll") for (int k = 0; k < 2; ++k) \
        acc[ai][bj][m][n] = __builtin_amdgcn_mfma_f32_16x16x32_bf16(Bt[n][k], At[m][k], acc[ai][bj][m][n], 0, 0, 0); __builtin_amdgcn_s_setprio(0); } while (0)
#define PG8_WAIT_V(n) asm volatile("s_waitcnt vmcnt(" #n ")" ::: "memory")
#define PG8_WAIT_L(n) asm volatile("s_waitcnt lgkmcnt(" #n ")" ::: "memory")
#define PG8_BAR __builtin_amdgcn_s_barrier()
#define PG8_SCHED __builtin_amdgcn_sched_barrier(0)
    Unit cur, nxt; int ui = 0;
    if (!S.next(0, cur)) return;
    f32x4 acc[2][2][4][2];
#pragma unroll
    for (int a = 0; a < 2; ++a)
#pragma unroll
        for (int b = 0; b < 2; ++b)
#pragma unroll
            for (int m = 0; m < 4; ++m)
#pragma unroll
                for (int n = 0; n < 2; ++n) acc[a][b][m][n] = (f32x4){0.f, 0.f, 0.f, 0.f};
    bf16x8 At[4][2], B0[2][2], B1[2][2];
    const char* cA = (const char*)g.A + (size_t)cur.pm * tstepA; const char* cB = (const char*)g.Bt + (size_t)cur.pn * tstepB;
    if constexpr (SP2) {
        PG8_STAGE(PG8_SB(0, 0), cB, voffB); PG8_STAGE(PG8_SB(0, 1), cB + hstepB, voffB); PG8_STAGE(PG8_SA(0, 0), cA, voffA); PG8_STAGE(PG8_SA(0, 1), cA + hstepA, voffA);
        if (wr == 1) PG8_BAR;
        PG8_WAIT_V(2); PG8_BAR;
        PG8_STAGE(PG8_SB(1, 0), cB + kstep, voffB); PG8_STAGE(PG8_SA(1, 0), cA + kstep, voffA); PG8_STAGE(PG8_SB(1, 1), cB + hstepB + kstep, voffB);
        PG8_WAIT_V(6); PG8_BAR;
    } else {
        PG8_STAGE(PG8_SB(0, 0), cB, voffB); PG8_STAGE(PG8_SA(0, 0), cA, voffA); PG8_STAGE(PG8_SB(0, 1), cB + hstepB, voffB); PG8_STAGE(PG8_SA(0, 1), cA + hstepA, voffA);
        if (wr == 1) PG8_BAR;
        PG8_WAIT_V(4); PG8_BAR;
        PG8_STAGE(PG8_SB(1, 0), cB + kstep, voffB); PG8_STAGE(PG8_SA(1, 0), cA + kstep, voffA); PG8_STAGE(PG8_SB(1, 1), cB + hstepB + kstep, voffB);
        PG8_WAIT_V(6); PG8_BAR;
    }
    for (;;) {
        const bool has_next = S.next(ui + 1, nxt);
        const char* nA = has_next ? (const char*)g.A + (size_t)nxt.pm * tstepA : cA; const char* nB = has_next ? (const char*)g.Bt + (size_t)nxt.pn * tstepB : cB;
        for (int t = 0; t < nt; t += 2) {
            const bool last = (t == nt - 2);
            const char* a1 = cA + (size_t)(t + 1) * kstep;
            const char* a2 = last ? nA : cA + (size_t)(t + 2) * kstep; const char* b2 = last ? nB : cB + (size_t)(t + 2) * kstep;
            const char* a3 = a2 + kstep; const char* b3 = b2 + kstep;
            if constexpr (SP2) {
            PG8_LDB(B0, 0, 0); PG8_LDB(B1, 0, 1); PG8_SCHED; PG8_LDA(At, 0, 0); PG8_STAGE(PG8_SA(1, 1), a1 + hstepA, voffA);
            PG8_WAIT_V(8); PG8_WAIT_L(0); PG8_BAR; PG8_MMA(0, 0, At, B0); PG8_MMA(0, 1, At, B1); PG8_BAR; PG8_SCHED;
            PG8_LDA(At, 0, 1); PG8_STAGE(PG8_SB(0, 0), b2, voffB); PG8_STAGE(PG8_SB(0, 1), b2 + hstepB, voffB); PG8_STAGE(PG8_SA(0, 0), a2, voffA);
            PG8_WAIT_V(8); PG8_WAIT_L(0); PG8_BAR; PG8_MMA(1, 0, At, B0); PG8_MMA(1, 1, At, B1); PG8_BAR; PG8_SCHED;
            PG8_LDB(B0, 1, 0); PG8_LDB(B1, 1, 1); PG8_SCHED; PG8_LDA(At, 1, 0); PG8_STAGE(PG8_SA(0, 1), a2 + hstepA, voffA);
            PG8_WAIT_V(8); PG8_WAIT_L(0); PG8_BAR; PG8_MMA(0, 0, At, B0); PG8_MMA(0, 1, At, B1); PG8_BAR; PG8_SCHED;
            PG8_LDA(At, 1, 1); PG8_STAGE(PG8_SB(1, 0), b3, voffB); PG8_STAGE(PG8_SB(1, 1), b3 + hstepB, voffB); PG8_STAGE(PG8_SA(1, 0), a3, voffA);
            PG8_WAIT_V(8); PG8_WAIT_L(0); PG8_BAR; PG8_MMA(1, 0, At, B0); PG8_MMA(1, 1, At, B1); PG8_BAR; PG8_SCHED;
            } else {
            PG8_LDB(B0, 0, 0); PG8_SCHED; PG8_LDA(At, 0, 0); PG8_STAGE(PG8_SA(1, 1), a1 + hstepA, voffA);
            PG8_WAIT_L(8); PG8_BAR; PG8_WAIT_L(0); PG8_MMA(0, 0, At, B0); PG8_BAR; PG8_SCHED;
            PG8_LDB(B1, 0, 1); PG8_STAGE(PG8_SB(0, 0), b2, voffB);
            PG8_BAR; PG8_WAIT_L(0); PG8_MMA(0, 1, At, B1); PG8_BAR;
            PG8_LDA(At, 0, 1); PG8_STAGE(PG8_SA(0, 0), a2, voffA);
            PG8_BAR; PG8_WAIT_L(0); PG8_MMA(1, 0, At, B0); PG8_BAR; PG8_SCHED;
            PG8_STAGE(PG8_SB(0, 1), b2 + hstepB, voffB);
            PG8_WAIT_V(6); PG8_BAR; PG8_MMA(1, 1, At, B1); PG8_BAR;
            PG8_LDB(B0, 1, 0); PG8_SCHED; PG8_LDA(At, 1, 0); PG8_STAGE(PG8_SA(0, 1), a2 + hstepA, voffA);
            PG8_WAIT_L(8); PG8_BAR; PG8_WAIT_L(0); PG8_MMA(0, 0, At, B0); PG8_BAR; PG8_SCHED;
            PG8_LDB(B1, 1, 1); PG8_STAGE(PG8_SB(1, 0), b3, voffB);
            PG8_BAR; PG8_WAIT_L(0); PG8_MMA(0, 1, At, B1); PG8_BAR;
            PG8_LDA(At, 1, 1); PG8_STAGE(PG8_SA(1, 0), a3, voffA);
            PG8_BAR; PG8_WAIT_L(0); PG8_MMA(1, 0, At, B0); PG8_BAR; PG8_SCHED;
            PG8_STAGE(PG8_SB(1, 1), b3 + hstepB, voffB);
            PG8_WAIT_V(6); PG8_BAR; PG8_MMA(1, 1, At, B1); PG8_BAR;
                    }
        }
        if constexpr (ALIGN_EPI) { if (wr == 0) PG8_BAR; }
        E(acc, cur, wr, wc, fr, fq);
        if (!has_next) break;
#pragma unroll
        for (int a = 0; a < 2; ++a)
#pragma unroll
            for (int b = 0; b < 2; ++b)
#pragma unroll
                for (int m = 0; m < 4; ++m)
#pragma unroll
                    for (int n = 0; n < 2; ++n) acc[a][b][m][n] = (f32x4){0.f, 0.f, 0.f, 0.f};
        cur = nxt; cA = nA; cB = nB; ++ui;
        if constexpr (ALIGN_EPI) { if (wr == 1) PG8_BAR; }
    }
    PG8_WAIT_V(0);
    if constexpr (!ALIGN_EPI) { if (wr == 0) PG8_BAR; }
    PG8_BAR;
    if constexpr (AFTER) E.after(acc, cur, wr, wc, fr, fq);
#undef PG8_SA
#undef PG8_SB
#undef PG8_STAGE
#undef PG8_LDA
#undef PG8_LDB
#undef PG8_MMA
#undef PG8_WAIT_V
#undef PG8_WAIT_L
#undef PG8_BAR
#undef PG8_SCHED
}
}
using pg8::Unit;


__device__ __forceinline__ int inproj_row(int e) {
    const int pn = e >> 8, o = e & 255;
    const int wc = o >> 6, bj = (o >> 5) & 1, fq = (o >> 3) & 3, n = (o >> 2) & 1, i = o & 3;
    return 256 * pn + 128 * bj + 32 * wc + 16 * n + 4 * fq + i;
}

struct EpiInProj {
    const float *rs, *cosT, *sinT;
    bf16_t *Q, *Kk, *VT, *SZA, *SZS, *XU; float* KSUM;
    __device__ __forceinline__ void operator()(const f32x4 (&acc)[2][2][4][2], const Unit& u, int wr, int wc, int fr, int fq) const {
        const int seg = u.pn >> 1, half = u.pn & 1;
        const int b = u.pm >> 3, blk = u.pm & 7;
        const int lbase = blk * 256 + wr * 64 + fr;
        if (seg <= 1) {
            bf16_t* dst = seg == 0 ? Q : Kk; const float qs = seg == 0 ? 0.18033688011112042f : 1.0f;
            const int head = 4 * half + wc;
            f32x4 cl[2], ch[2];
#pragma unroll
            for (int n = 0; n < 2; ++n) { cl[n] = (f32x4){0.f, 0.f, 0.f, 0.f}; ch[n] = (f32x4){0.f, 0.f, 0.f, 0.f}; }
            bf16_t* obase = dst + ((size_t)((b * 8 + head) * 2048)) * 64 + 8 * fq;
#pragma unroll
            for (int ai = 0; ai < 2; ++ai)
#pragma unroll
                for (int m = 0; m < 4; ++m) {
                    const int l = lbase + 128 * ai + 16 * m; const float rsv = rs[b * 2048 + l] * qs;
                    unsigned wl[4], wh[4];
#pragma unroll
                    for (int n = 0; n < 2; ++n) {
                        const f32x4 c4 = *(const f32x4*)(cosT + l * 32 + 8 * fq + 4 * n), s4 = *(const f32x4*)(sinT + l * 32 + 8 * fq + 4 * n);
                        const f32x4 t1 = acc[ai][0][m][n] * rsv, t2 = acc[ai][1][m][n] * rsv;
                        const f32x4 lo = t1 * c4 - t2 * s4, hi = t2 * c4 + t1 * s4;
                        wl[2 * n] = pk2(lo[0], lo[1]); wl[2 * n + 1] = pk2(lo[2], lo[3]); wh[2 * n] = pk2(hi[0], hi[1]); wh[2 * n + 1] = pk2(hi[2], hi[3]);
                        cl[n] += lo; ch[n] += hi;
                    }
                    bf16_t* o = obase + (unsigned)l * 64u;
                    *(u32x4*)o = (u32x4){wl[0], wl[1], wl[2], wl[3]};
                    *(u32x4*)(o + 32) = (u32x4){wh[0], wh[1], wh[2], wh[3]};
                }
            if (seg == 1) {
#pragma unroll
                for (int n = 0; n < 2; ++n)
#pragma unroll
                    for (int i = 0; i < 4; ++i) {
                        float v = cl[n][i], v2 = ch[n][i];
                        v += __shfl_xor(v, 1); v += __shfl_xor(v, 2); v += __shfl_xor(v, 4); v += __shfl_xor(v, 8);
                        v2 += __shfl_xor(v2, 1); v2 += __shfl_xor(v2, 2); v2 += __shfl_xor(v2, 4); v2 += __shfl_xor(v2, 8);
                        if (fr == 0) { float* kp = KSUM + ((b * 8 + head) * 8 + blk) * 64 + 8 * fq + 4 * n + i; atomicAdd(kp, v); atomicAdd(kp + 32, v2); }
                    }
            }
        } else if (seg == 2) {
            const int head = 4 * half + wc;
#pragma unroll
            for (int ai = 0; ai < 2; ++ai)
#pragma unroll
                for (int m = 0; m < 4; ++m) {
                    const int l = lbase + 128 * ai + 16 * m; const float rsv = rs[b * 2048 + l];
#pragma unroll
                    for (int bj = 0; bj < 2; ++bj)
#pragma unroll
                        for (int n = 0; n < 2; ++n) {
                            const int d0 = 32 * bj + 8 * fq + 4 * n;
                            const f32x4 v = acc[ai][bj][m][n] * rsv;
                            bf16_t* o = VT + ((size_t)((b * 8 + head) * 64 + d0)) * 2048 + l;
                            const unsigned p0 = pk2(v[0], v[1]), p1 = pk2(v[2], v[3]);
                            o[0] = (bf16_t)(p0 & 0xffffu); o[2048] = (bf16_t)(p0 >> 16); o[4096] = (bf16_t)(p1 & 0xffffu); o[6144] = (bf16_t)(p1 >> 16);
                        }
                }
        } else if (seg == 4) {
#pragma unroll
            for (int ai = 0; ai < 2; ++ai)
#pragma unroll
                for (int m = 0; m < 4; ++m) {
                    const int l = lbase + 128 * ai + 16 * m; const float rsv = rs[b * 2048 + l];
                    const int c = l >> 4, t = l & 15;
#pragma unroll
                    for (int bj = 0; bj < 2; ++bj) {
                        const int g = 16 * half + 4 * wc + 2 * bj + (fq >> 1);
                        const f32x4 v0 = acc[ai][bj][m][0] * rsv, v1 = acc[ai][bj][m][1] * rsv;
                        bf16_t* o = XU + ((size_t)(1024 * g + b * 128 + c)) * 384 + 128 + t * 16 + 8 * (fq & 1);
                        *(u32x4*)o = (u32x4){pk2(v0[0], v0[1]), pk2(v0[2], v0[3]), pk2(v1[0], v1[1]), pk2(v1[2], v1[3])};
                    }
                }
        } else {
            bf16_t* dst = seg == 3 ? SZA : SZS;
#pragma unroll
            for (int ai = 0; ai < 2; ++ai)
#pragma unroll
                for (int m = 0; m < 4; ++m) {
                    const int l = lbase + 128 * ai + 16 * m; const int row = b * 2048 + l; const float rsv = rs[row];
#pragma unroll
                    for (int bj = 0; bj < 2; ++bj) {
                        const int col = 256 * half + 64 * wc + 32 * bj + 8 * fq;
                        const f32x4 v0 = acc[ai][bj][m][0] * rsv, v1 = acc[ai][bj][m][1] * rsv;
                        *(u32x4*)(dst + (size_t)row * 512 + col) = (u32x4){pk2(siluf_(v0[0]), siluf_(v0[1])), pk2(siluf_(v0[2]), siluf_(v0[3])), pk2(siluf_(v1[0]), siluf_(v1[1])), pk2(siluf_(v1[2]), siluf_(v1[3]))};
                    }
                }
        }
    }
};

struct EpiS {
    LAS unsigned char* lds;
    __device__ __forceinline__ void operator()(const f32x4 (&acc)[2][2][4][2], const Unit& u, int wr, int wc, int fr, int fq) const {}
    __device__ __forceinline__ void after(const f32x4 (&acc)[2][2][4][2], const Unit& u, int wr, int wc, int fr, int fq) const {
#pragma unroll
        for (int ai = 0; ai < 2; ++ai)
#pragma unroll
            for (int m = 0; m < 4; ++m) {
                const int r = 128 * ai + 64 * wr + 16 * m + fr;
#pragma unroll
                for (int n = 0; n < 2; ++n) *(LAS f32x4*)(lds + r * LDS_SROW + (32 * wc + 16 * n + 4 * fq) * 4) = acc[ai][0][m][n];
            }
    }
};

struct EpiY {
    bf16_t* YG;
    __device__ __forceinline__ void operator()(const f32x4 (&acc)[2][2][4][2], const Unit& u, int wr, int wc, int fr, int fq) const {
        const int g = u.pn, t = 4 * wc + fq;
#pragma unroll
        for (int ai = 0; ai < 2; ++ai)
#pragma unroll
            for (int m = 0; m < 4; ++m) {
                const int rr = 256 * (u.pm & 3) + 128 * ai + 64 * wr + 16 * m + fr;
                const int b = rr >> 7, c = rr & 127; const int token = b * 2048 + 16 * c + t;
                bf16_t* ob = YG + (size_t)token * 512 + 16 * g;
#pragma unroll
                for (int bj = 0; bj < 2; ++bj) {
                    const f32x4 v0 = acc[ai][bj][m][0], v1 = acc[ai][bj][m][1];
                    *(u32x4*)(ob + 8 * bj) = (u32x4){pk2(gelu_tanh(v0[0]), gelu_tanh(v0[1])), pk2(gelu_tanh(v0[2]), gelu_tanh(v0[3])), pk2(gelu_tanh(v1[0]), gelu_tanh(v1[1])), pk2(gelu_tanh(v1[2]), gelu_tanh(v1[3]))};
                }
            }
    }
};

struct EpiGlu {
    const bf16_t *YG, *SZS; const float* bglu; bf16_t* MIXED;
    __device__ __forceinline__ void operator()(const f32x4 (&acc)[2][2][4][2], const Unit& u, int wr, int wc, int fr, int fq) const {
        f32x4 bias[2][2];
#pragma unroll
        for (int bj = 0; bj < 2; ++bj)
#pragma unroll
            for (int n = 0; n < 2; ++n) bias[bj][n] = *(const f32x4*)(bglu + 256 * u.pn + 64 * wc + 32 * bj + 8 * fq + 4 * n);
#pragma unroll
        for (int ai = 0; ai < 2; ++ai) {
            u32x4 y4[4][2], z4[4][2];
#pragma unroll
            for (int m = 0; m < 4; ++m) {
                const int row = 256 * u.pm + 128 * ai + 64 * wr + 16 * m + fr;
#pragma unroll
                for (int bj = 0; bj < 2; ++bj) {
                    const unsigned off = (unsigned)row * 512u + (unsigned)(256 * u.pn + 64 * wc + 32 * bj + 8 * fq);
                    y4[m][bj] = *(const u32x4*)(YG + off); z4[m][bj] = *(const u32x4*)(SZS + off);
                }
            }
#pragma unroll
            for (int m = 0; m < 4; ++m) {
                const int row = 256 * u.pm + 128 * ai + 64 * wr + 16 * m + fr;
#pragma unroll
                for (int bj = 0; bj < 2; ++bj) {
                    const int col = 256 * u.pn + 64 * wc + 32 * bj + 8 * fq;
                    unsigned w[4];
#pragma unroll
                    for (int n = 0; n < 2; ++n) {
                        const f32x4 a = acc[ai][bj][m][n] + bias[bj][n];
                        const unsigned ya = y4[m][bj][2 * n], yb = y4[m][bj][2 * n + 1], za = z4[m][bj][2 * n], zb = z4[m][bj][2 * n + 1];
                        const float o0 = bflo(ya) * sigmoidf_(a[0]) * bflo(za), o1 = bfhi(ya) * sigmoidf_(a[1]) * bfhi(za);
                        const float o2 = bflo(yb) * sigmoidf_(a[2]) * bflo(zb), o3 = bfhi(yb) * sigmoidf_(a[3]) * bfhi(zb);
                        w[2 * n] = pk2(o0, o1); w[2 * n + 1] = pk2(o2, o3);
                    }
                    *(u32x4*)(MIXED + (size_t)row * 1024 + 512 + col) = (u32x4){w[0], w[1], w[2], w[3]};
                }
            }
        }
    }
};

struct EpiOut {
    const float* x; float* out; float* SSQ;
    __device__ __forceinline__ void operator()(const f32x4 (&acc)[2][2][4][2], const Unit& u, int wr, int wc, int fr, int fq) const {
#pragma unroll
        for (int ai = 0; ai < 2; ++ai) {
            f32x4 xv[4][2][2];
#pragma unroll
            for (int m = 0; m < 4; ++m) {
                const int row = 256 * u.pm + 128 * ai + 64 * wr + 16 * m + fr;
#pragma unroll
                for (int bj = 0; bj < 2; ++bj)
#pragma unroll
                    for (int n = 0; n < 2; ++n) xv[m][bj][n] = __builtin_nontemporal_load((const f32x4*)(x + (size_t)row * 1024 + 256 * u.pn + 64 * wc + 32 * bj + 8 * fq + 4 * n));
            }
#pragma unroll
            for (int m = 0; m < 4; ++m) {
                const int row = 256 * u.pm + 128 * ai + 64 * wr + 16 * m + fr;
                float ss = 0.f;
#pragma unroll
                for (int bj = 0; bj < 2; ++bj)
#pragma unroll
                    for (int n = 0; n < 2; ++n) {
                        const int col = 256 * u.pn + 64 * wc + 32 * bj + 8 * fq + 4 * n;
                        const f32x4 v = acc[ai][bj][m][n] + xv[m][bj][n];
                        *(f32x4*)(out + (size_t)row * 1024 + col) = v;
                        ss += (v[0] * v[0] + v[1] * v[1]) + (v[2] * v[2] + v[3] * v[3]);
                    }
                ss += __shfl_xor(ss, 16); ss += __shfl_xor(ss, 32);
                if (fq == 0) SSQ[row * 16 + 4 * u.pn + wc] = ss;
            }
        }
    }
};

struct EpiOutFused {
    const float* x; float* out; float* SSQ; const float* gain; XcdBarrier xbar;
    __device__ __forceinline__ void operator()(f32x4 (&acc)[2][2][4][2], const Unit& u, int wr, int wc, int fr, int fq) const {
#pragma unroll
        for (int ai = 0; ai < 2; ++ai) {
            f32x4 xv[4][2][2];
#pragma unroll
            for (int m = 0; m < 4; ++m) {
                const int row = 256 * u.pm + 128 * ai + 64 * wr + 16 * m + fr;
#pragma unroll
                for (int bj = 0; bj < 2; ++bj)
#pragma unroll
                    for (int n = 0; n < 2; ++n) xv[m][bj][n] = __builtin_nontemporal_load((const f32x4*)(x + (size_t)row * 1024 + 256 * u.pn + 64 * wc + 32 * bj + 8 * fq + 4 * n));
            }
#pragma unroll
            for (int m = 0; m < 4; ++m) {
                const int row = 256 * u.pm + 128 * ai + 64 * wr + 16 * m + fr;
                float ss = 0.f;
#pragma unroll
                for (int bj = 0; bj < 2; ++bj)
#pragma unroll
                    for (int n = 0; n < 2; ++n) {
                        const f32x4 v = acc[ai][bj][m][n] + xv[m][bj][n];
                        acc[ai][bj][m][n] = v;
                        ss += (v[0] * v[0] + v[1] * v[1]) + (v[2] * v[2] + v[3] * v[3]);
                    }
                ss += __shfl_xor(ss, 16); ss += __shfl_xor(ss, 32);
                if (fq == 0) SSQ[row * 16 + 4 * u.pn + wc] = ss;
            }
        }
    }
    __device__ __forceinline__ void after(f32x4 (&acc)[2][2][4][2], const Unit& u, int wr, int wc, int fr, int fq) const {
        xcd_barrier(xbar);
        f32x4 gn[2][2];
#pragma unroll
        for (int bj = 0; bj < 2; ++bj)
#pragma unroll
            for (int n = 0; n < 2; ++n) gn[bj][n] = *(const f32x4*)(gain + 256 * u.pn + 64 * wc + 32 * bj + 8 * fq + 4 * n);
#pragma unroll
        for (int ai = 0; ai < 2; ++ai)
#pragma unroll
            for (int m = 0; m < 4; ++m) {
                const int row = 256 * u.pm + 128 * ai + 64 * wr + 16 * m + fr;
                const f32x4* sp = (const f32x4*)(SSQ + row * 16);
                const f32x4 s0 = sp[0], s1 = sp[1], s2 = sp[2], s3 = sp[3];
                const float tot = ((s0[0] + s0[1]) + (s0[2] + s0[3])) + ((s1[0] + s1[1]) + (s1[2] + s1[3])) + ((s2[0] + s2[1]) + (s2[2] + s2[3])) + ((s3[0] + s3[1]) + (s3[2] + s3[3]));
                const float rinv = 1.0f / sqrtf(tot * (1.f / DM) + 1e-6f);
#pragma unroll
                for (int bj = 0; bj < 2; ++bj)
#pragma unroll
                    for (int n = 0; n < 2; ++n) {
                        const int col = 256 * u.pn + 64 * wc + 32 * bj + 8 * fq + 4 * n;
                        *(f32x4*)(out + (size_t)row * 1024 + col) = acc[ai][bj][m][n] * rinv * gn[bj][n];
                    }
            }
    }
};

template <int MODE>
__device__ __forceinline__ void transpose_item(const float* W, int K, int N, bf16_t* WT, const float* gain, LAS float* scr, int item, int lane) {
    const int nblk = N / 32, kb = item / nblk, nb = item % nblk, k0 = 64 * kb, n0 = 32 * nb;
#pragma unroll 8
    for (int i = 0; i < 32; ++i) { const int kk = 2 * i + (lane >> 5); float w = W[(size_t)(k0 + kk) * N + n0 + (lane & 31)]; if (MODE == 0) w *= gain[k0 + kk]; scr[kk * 33 + (lane & 31)] = w; }
    const int c = lane & 7;
#pragma unroll
    for (int j = 0; j < 4; ++j) { const int n = (lane >> 3) + 8 * j; const LAS float* s = scr + (8 * c) * 33 + n;
        u32x4 o; o.x = pk2(s[0 * 33], s[1 * 33]); o.y = pk2(s[2 * 33], s[3 * 33]); o.z = pk2(s[4 * 33], s[5 * 33]); o.w = pk2(s[6 * 33], s[7 * 33]);
        const int drow = inproj_row(n0 + n);
        *(u32x4*)(WT + (size_t)drow * K + k0 + 8 * c) = o; }
}

__device__ __forceinline__ void ssm_group_prep(const Params& p, int item, LAS float* L) {
    LAS float* lkr = L; LAS float* lki = L + 1088; LAS float* bbr = L + 2176; LAS float* bbi = L + 3200; LAS float* cr = L + 4224; LAS float* ci = L + 5248; LAS float* Kt = L + 6272;
    const int tid = threadIdx.x, g = item >> 3, sub = item & 7;
    const float dt = expf(p.log_dt[g]);
    for (int t = tid; t < 17 * 64; t += 512) {
        const int pp = t & 63, k = t >> 6;
        const float a = p.lam_re[g * 64 + pp] * dt, th = p.lam_im[g * 64 + pp] * dt;
        const float mag = expf((float)k * a); float sn, cs; sincosf((float)k * th, &sn, &cs);
        lkr[k * 64 + pp] = mag * cs; lki[k * 64 + pp] = mag * sn;
    }
    for (int t = tid; t < 1024; t += 512) {
        const int pp = t >> 4, h = t & 15;
        const float lr = p.lam_re[g * 64 + pp], li = p.lam_im[g * 64 + pp];
        const float a = lr * dt, th = li * dt;
        float sn, cs; sincosf(th, &sn, &cs); const float sh = sinf(0.5f * th);
        const float em1 = expm1f(a), ea = em1 + 1.f;
        const float xr = em1 * cs - 2.f * sh * sh, xi = ea * sn;
        const float den = 1.f / (lr * lr + li * li);
        const float cfr = (xr * lr + xi * li) * den, cfi = (xi * lr - xr * li) * den;
        const float br = p.b_re[(g * 64 + pp) * 16 + h], bi = p.b_im[(g * 64 + pp) * 16 + h];
        bbr[pp * 16 + h] = cfr * br - cfi * bi; bbi[pp * 16 + h] = cfr * bi + cfi * br;
        cr[h * 64 + pp] = p.c_re[(g * 16 + h) * 64 + pp]; ci[h * 64 + pp] = p.c_im[(g * 16 + h) * 64 + pp];
    }
    __syncthreads();
    {
        const int k = tid >> 5, hl = (tid >> 4) & 1, h2 = tid & 15, h = 2 * sub + hl;
        float sacc = 0.f;
        for (int pp = 0; pp < 64; ++pp) {
            const float c_r = cr[h * 64 + pp], c_i = ci[h * 64 + pp], l_r = lkr[k * 64 + pp], l_i = lki[k * 64 + pp];
            const float er = c_r * l_r - c_i * l_i, ei = c_r * l_i + c_i * l_r;
            sacc += er * bbr[pp * 16 + h2] - ei * bbi[pp * 16 + h2];
        }
        if (k == 0 && h == h2) sacc += p.d_skip[g * 16 + h];
        Kt[tid] = sacc;
    }
    __syncthreads();
    bf16_t* WCAT = (bf16_t*)(p.ws + WS_WCAT) + (size_t)g * 256 * 384;
    bf16_t* WST = (bf16_t*)(p.ws + WS_WST) + (size_t)g * 256 * 256;
    for (int e = tid; e < 32 * 192; e += 512) {
        const int rl = e / 192, kk = (e - rl * 192) * 2;
        const int t = rl >> 1, hl = rl & 1, h = 2 * sub + hl;
        const int row = 128 * (h >> 3) + 32 * (t >> 2) + 16 * ((h >> 2) & 1) + 4 * (t & 3) + (h & 3);
        float v[2];
#pragma unroll
        for (int q = 0; q < 2; ++q) {
            const int k2 = kk + q;
            if (k2 < 128) { const int pp = k2 & 63; const float c_r = cr[h * 64 + pp], c_i = ci[h * 64 + pp], l_r = lkr[(t + 1) * 64 + pp], l_i = lki[(t + 1) * 64 + pp];
                v[q] = k2 < 64 ? (c_r * l_r - c_i * l_i) : -(c_r * l_i + c_i * l_r); }
            else { const int s2 = (k2 - 128) >> 4, h2 = (k2 - 128) & 15; v[q] = s2 <= t ? Kt[((t - s2) * 2 + hl) * 16 + h2] : 0.f; }
        }
        *(unsigned*)(WCAT + (size_t)row * 384 + kk) = pk2(v[0], v[1]);
    }
    for (int e = tid; e < 32 * 128; e += 512) {
        const int rl = e >> 7, kk = (e & 127) * 2;
        const int row = rl < 16 ? 16 * sub + rl : 128 + 16 * sub + (rl - 16);
        float v[2] = {0.f, 0.f};
        if (row < 128) {
            const int pp = row & 63;
#pragma unroll
            for (int q = 0; q < 2; ++q) { const int s2 = (kk + q) >> 4, h = (kk + q) & 15; const float l_r = lkr[(15 - s2) * 64 + pp], l_i = lki[(15 - s2) * 64 + pp], b_r = bbr[pp * 16 + h], b_i = bbi[pp * 16 + h];
                v[q] = row < 64 ? (l_r * b_r - l_i * b_i) : (l_r * b_i + l_i * b_r); }
        }
        *(unsigned*)(WST + (size_t)row * 256 + kk) = pk2(v[0], v[1]);
    }
    if (sub == 0 && tid < 64) { float* L16 = (float*)(p.ws + WS_LAM16) + (g * 64 + tid) * 2; L16[0] = lkr[16 * 64 + tid]; L16[1] = lki[16 * 64 + tid]; }
    __syncthreads();
}

__device__ __forceinline__ void phase_prep(const Params& p, LAS unsigned char* lds) {
    const int tid = threadIdx.x, lane = tid & 63, wave = tid >> 6, G = 256, bid = blockIdx.x;
    const int gw = bid * 8 + wave, NGW = G * 8;
    const bool tables_first = ((bid >> 3) & 1) != 0;
    if (tables_first) ssm_group_prep(p, bid, (LAS float*)lds);
    {
        bf16_t* XB = (bf16_t*)(p.ws + WS_XB); float* RS = (float*)(p.ws + WS_RS);
        for (int row = gw; row < NTOK; row += NGW) {
            const f32x4* xr = (const f32x4*)(p.x + (size_t)row * DM) + lane;
            f32x4 v[4]; float s = 0.f;
#pragma unroll
            for (int j = 0; j < 4; ++j) { v[j] = __builtin_nontemporal_load(xr + 64 * j); s += (v[j][0] * v[j][0] + v[j][1] * v[j][1]) + (v[j][2] * v[j][2] + v[j][3] * v[j][3]); }
            s = wave_sum(s);
            if (lane == 0) RS[row] = 1.0f / sqrtf(s * (1.f / DM) + 1e-6f);
            u32x2* o = (u32x2*)(XB + (size_t)row * DM) + lane;
#pragma unroll
            for (int j = 0; j < 4; ++j) o[64 * j] = (u32x2){pk2(v[j][0], v[j][1]), pk2(v[j][2], v[j][3])};
        }
    }
    {
        LAS float* scr = (LAS float*)(lds + 49152) + wave * (64 * 33);
        constexpr int I_IN = (DM / 64) * (NPROJ / 32), I_OUT = (DM / 64) * (DM / 32), I_GLU = (512 / 64) * (512 / 32);
        for (int it = gw; it < I_IN + I_OUT + I_GLU; it += NGW) {
            int r = it;
            if (r < I_IN) { transpose_item<0>(p.w_in, DM, NPROJ, (bf16_t*)(p.ws + WS_WINT), p.norm_gain, scr, r, lane); continue; } r -= I_IN;
            if (r < I_OUT) { transpose_item<1>(p.w_out, DM, DM, (bf16_t*)(p.ws + WS_WOUTT), nullptr, scr, r, lane); continue; } r -= I_OUT;
            transpose_item<1>(p.w_glu, 512, 512, (bf16_t*)(p.ws + WS_WGLUT), nullptr, scr, r, lane);
        }
    }
    {
        float* COS = (float*)(p.ws + WS_COS); float* SIN = (float*)(p.ws + WS_SIN); float* KSUM = (float*)(p.ws + WS_KSUM);
        for (int i = bid * 512 + tid; i < SEQ * 32; i += G * 512) {
            const int pos = i >> 5, f = i & 31;
            const float inv = 1.0f / powf(10000.0f, (float)f * (1.f / 32.f));
            const float ang = (float)pos * inv; float sn, cs; sincosf(ang, &sn, &cs);
            COS[i] = cs; SIN[i] = sn;
        }
        for (int i = bid * 512 + tid; i < 4096; i += G * 512) KSUM[i] = 0.f;
    }
    if (!tables_first) { __syncthreads(); ssm_group_prep(p, bid, (LAS float*)lds); }
}

__device__ __forceinline__ int swap23(int r) { return (r & ~12) | ((r & 4) << 1) | ((r & 8) >> 1); }

typedef float f32x2 __attribute__((ext_vector_type(2)));
__device__ __forceinline__ float max3f(float a, float b, float c) { float r; asm("v_max3_f32 %0, %1, %2, %3" : "=v"(r) : "v"(a), "v"(b), "v"(c)); return r; }
template <bool DIAG>
__device__ __forceinline__ void attn_tile(LAS unsigned char* B, unsigned kf_off, unsigned vf_off, const bf16x8 (&qf)[4], f32x16& O0, f32x16& O1, float& mrun, float& lrun,
                                          bool on, int kpos0, int qpos, int hh) {
    constexpr int ROWB = 144;
    const float cinit = on ? -mrun : -1e30f;
    f32x16 st0, st1;
#pragma unroll
    for (int i = 0; i < 16; ++i) { st0[i] = cinit; st1[i] = cinit; }
#pragma unroll
    for (int s = 0; s < 4; ++s) {
        const bf16x8 k0 = *(const LAS bf16x8*)(B + kf_off + s * 32), k1 = *(const LAS bf16x8*)(B + kf_off + 32 * ROWB + s * 32);
        st0 = __builtin_amdgcn_mfma_f32_32x32x16_bf16(k0, qf[s], st0, 0, 0, 0);
        st1 = __builtin_amdgcn_mfma_f32_32x32x16_bf16(k1, qf[s], st1, 0, 0, 0);
    }
    if (DIAG) {
#pragma unroll
        for (int i = 0; i < 16; ++i) {
            const int key = kpos0 + (i & 7) + 8 * hh + 16 * (i >> 3);
            if (key > qpos) st0[i] = -1e30f;
            if (key + 32 > qpos) st1[i] = -1e30f;
        }
    }
    float mx = max3f(st0[0], st0[1], st0[2]);
#pragma unroll
    for (int i = 3; i < 15; i += 2) mx = max3f(mx, st0[i], st0[i + 1]);
    mx = max3f(mx, st0[15], st1[0]);
#pragma unroll
    for (int i = 1; i < 15; i += 2) mx = max3f(mx, st1[i], st1[i + 1]);
    mx = fmaxf(mx, st1[15]);
    mx = fmaxf(mx, __shfl_xor(mx, 32));
    const bool grow = on && (mx > 8.f);
    if (__ballot(grow) != 0ull) {
        const float d = grow ? mx : 0.f;
        const float alpha = __builtin_amdgcn_exp2f(-d);
        lrun *= alpha; mrun += d;
#pragma unroll
        for (int i = 0; i < 16; ++i) { O0[i] *= alpha; O1[i] *= alpha; st0[i] -= d; st1[i] -= d; }
    }
    float rsum = 0.f;
#pragma unroll
    for (int i = 0; i < 16; ++i) { const float p0 = __builtin_amdgcn_exp2f(st0[i]), p1 = __builtin_amdgcn_exp2f(st1[i]); st0[i] = p0; st1[i] = p1; rsum += p0; rsum += p1; }
    rsum += __shfl_xor(rsum, 32);
    lrun += rsum;
#pragma unroll
    for (int s4 = 0; s4 < 4; ++s4) {
        u32x4 t4;
        if (s4 < 2) t4 = (u32x4){pk2(st0[8 * s4], st0[8 * s4 + 1]), pk2(st0[8 * s4 + 2], st0[8 * s4 + 3]), pk2(st0[8 * s4 + 4], st0[8 * s4 + 5]), pk2(st0[8 * s4 + 6], st0[8 * s4 + 7])};
        else { const int s = s4 - 2; t4 = (u32x4){pk2(st1[8 * s], st1[8 * s + 1]), pk2(st1[8 * s + 2], st1[8 * s + 3]), pk2(st1[8 * s + 4], st1[8 * s + 5]), pk2(st1[8 * s + 6], st1[8 * s + 7])}; }
        const bf16x8 pf = __builtin_bit_cast(bf16x8, t4);
        const bf16x8 v0 = *(const LAS bf16x8*)(B + vf_off + s4 * 32), v1 = *(const LAS bf16x8*)(B + vf_off + 32 * ROWB + s4 * 32);
        O0 = __builtin_amdgcn_mfma_f32_32x32x16_bf16(v0, pf, O0, 0, 0, 0);
        O1 = __builtin_amdgcn_mfma_f32_32x32x16_bf16(v1, pf, O1, 0, 0, 0);
    }
}

__device__ __forceinline__ void attn_tile2(LAS unsigned char* BA, LAS unsigned char* BB, unsigned kf_off, unsigned vf_off, const bf16x8 (&qf)[4], f32x16& O0, f32x16& O1, float& mrun, float& lrun, bool on) {
    constexpr int ROWB = 144;
    const float cinit = on ? -mrun : -1e30f;
    f32x16 sa0, sa1, sb0, sb1;
#pragma unroll
    for (int i = 0; i < 16; ++i) { sa0[i] = cinit; sa1[i] = cinit; sb0[i] = cinit; sb1[i] = cinit; }
#pragma unroll
    for (int s = 0; s < 4; ++s) {
        const bf16x8 k0 = *(const LAS bf16x8*)(BA + kf_off + s * 32), k1 = *(const LAS bf16x8*)(BA + kf_off + 32 * ROWB + s * 32);
        const bf16x8 k2 = *(const LAS bf16x8*)(BB + kf_off + s * 32), k3 = *(const LAS bf16x8*)(BB + kf_off + 32 * ROWB + s * 32);
        sa0 = __builtin_amdgcn_mfma_f32_32x32x16_bf16(k0, qf[s], sa0, 0, 0, 0);
        sa1 = __builtin_amdgcn_mfma_f32_32x32x16_bf16(k1, qf[s], sa1, 0, 0, 0);
        sb0 = __builtin_amdgcn_mfma_f32_32x32x16_bf16(k2, qf[s], sb0, 0, 0, 0);
        sb1 = __builtin_amdgcn_mfma_f32_32x32x16_bf16(k3, qf[s], sb1, 0, 0, 0);
    }
    float mx = max3f(sa0[0], sa0[1], sa0[2]), my = max3f(sb0[0], sb0[1], sb0[2]);
#pragma unroll
    for (int i = 3; i < 15; i += 2) { mx = max3f(mx, sa0[i], sa0[i + 1]); my = max3f(my, sb0[i], sb0[i + 1]); }
    mx = max3f(mx, sa0[15], sa1[0]); my = max3f(my, sb0[15], sb1[0]);
#pragma unroll
    for (int i = 1; i < 15; i += 2) { mx = max3f(mx, sa1[i], sa1[i + 1]); my = max3f(my, sb1[i], sb1[i + 1]); }
    mx = max3f(mx, sa1[15], fmaxf(my, sb1[15]));
    mx = fmaxf(mx, __shfl_xor(mx, 32));
    const bool grow = on && (mx > 8.f);
    if (__ballot(grow) != 0ull) {
        const float d = grow ? mx : 0.f;
        const float alpha = __builtin_amdgcn_exp2f(-d);
        lrun *= alpha; mrun += d;
#pragma unroll
        for (int i = 0; i < 16; ++i) { O0[i] *= alpha; O1[i] *= alpha; sa0[i] -= d; sa1[i] -= d; sb0[i] -= d; sb1[i] -= d; }
    }
    float rsum = 0.f;
#define AT2_EXP(S0, S1) _Pragma("unroll") for (int i = 0; i < 16; ++i) { const float p0 = __builtin_amdgcn_exp2f(S0[i]), p1 = __builtin_amdgcn_exp2f(S1[i]); S0[i] = p0; S1[i] = p1; rsum += p0; rsum += p1; }
#define AT2_PV(S0, S1, BUF) _Pragma("unroll") for (int s4 = 0; s4 < 4; ++s4) { \
        u32x4 t4; \
        if (s4 < 2) t4 = (u32x4){pk2(S0[8 * s4], S0[8 * s4 + 1]), pk2(S0[8 * s4 + 2], S0[8 * s4 + 3]), pk2(S0[8 * s4 + 4], S0[8 * s4 + 5]), pk2(S0[8 * s4 + 6], S0[8 * s4 + 7])}; \
        else { const int s_ = s4 - 2; t4 = (u32x4){pk2(S1[8 * s_], S1[8 * s_ + 1]), pk2(S1[8 * s_ + 2], S1[8 * s_ + 3]), pk2(S1[8 * s_ + 4], S1[8 * s_ + 5]), pk2(S1[8 * s_ + 6], S1[8 * s_ + 7])}; } \
        const bf16x8 pf = __builtin_bit_cast(bf16x8, t4); \
        const bf16x8 v0 = *(const LAS bf16x8*)(BUF + vf_off + s4 * 32), v1 = *(const LAS bf16x8*)(BUF + vf_off + 32 * ROWB + s4 * 32); \
        O0 = __builtin_amdgcn_mfma_f32_32x32x16_bf16(v0, pf, O0, 0, 0, 0); \
        O1 = __builtin_amdgcn_mfma_f32_32x32x16_bf16(v1, pf, O1, 0, 0, 0); }
    AT2_EXP(sa0, sa1)
    AT2_PV(sa0, sa1, BA)
    AT2_EXP(sb0, sb1)
    AT2_PV(sb0, sb1, BB)
#undef AT2_EXP
#undef AT2_PV
    rsum += __shfl_xor(rsum, 32);
    lrun += rsum;
}

__device__ __forceinline__ void phase_attn(const Params& p, LAS unsigned char* lds, unsigned* queue) {
    const int tid = threadIdx.x, lane = tid & 63, w = __builtin_amdgcn_readfirstlane(tid >> 6), r = lane & 31, hh = lane >> 5;
    const bf16_t* Qg = (const bf16_t*)(p.ws + WS_Q); const bf16_t* Kg = (const bf16_t*)(p.ws + WS_K); const bf16_t* VTg = (const bf16_t*)(p.ws + WS_VT);
    const bf16_t* SZA = (const bf16_t*)(p.ws + WS_SZA); const float* KSUM = (const float*)(p.ws + WS_KSUM);
    bf16_t* MIXED = (bf16_t*)(p.ws + WS_XB);
    constexpr int ROWB = 144, TILEB = 64 * ROWB, BUFB = 2 * TILEB;
    const int srow = tid >> 3, sch = tid & 7;
    const unsigned st_off = (unsigned)(srow * ROWB + sch * 16);
    const unsigned kf_off = (unsigned)(swap23(r) * ROWB + hh * 16);
    const unsigned vf_off = (unsigned)(TILEB + r * ROWB + hh * 16);
    volatile LAS unsigned* tick = (volatile LAS unsigned*)(lds + LDS_CTL + 8);
    for (;;) {
        if (tid == 0) *tick = __hip_atomic_fetch_add(queue, 1u, __ATOMIC_RELAXED, __HIP_MEMORY_SCOPE_AGENT);
        __syncthreads();
        const int idx = (int)*tick;
        if (idx >= 512) break;
        const int blk = 7 - (idx >> 6), bh = idx & 63, b = bh >> 3, h = bh & 7;
        const int qpos = blk * 256 + w * 32 + r;
        const bf16_t* Qp = Qg + ((size_t)bh * 2048 + qpos) * 64 + 8 * hh;
        bf16x8 qf[4];
#pragma unroll
        for (int s = 0; s < 4; ++s) qf[s] = *(const bf16x8*)(Qp + 16 * s);
        unsigned selmask;
        if (blk <= 3) selmask = (1u << blk) - 1u;
        else {
            float v1 = -3e38f, v2 = -3e38f, v3 = -3e38f; int i1 = 0, i2 = 0, i3 = 0;
#pragma unroll
            for (int j = 0; j < 7; ++j) {
                if (j < blk) {
                    const float* ks = KSUM + ((size_t)bh * 8 + j) * 64 + 8 * hh;
                    float gsum = 0.f;
#pragma unroll
                    for (int s = 0; s < 4; ++s) {
                        const f32x4 k0 = *(const f32x4*)(ks + 16 * s), k1 = *(const f32x4*)(ks + 16 * s + 4);
                        gsum += bf2f((unsigned short)qf[s][0]) * k0[0] + bf2f((unsigned short)qf[s][1]) * k0[1] + bf2f((unsigned short)qf[s][2]) * k0[2] + bf2f((unsigned short)qf[s][3]) * k0[3]
                              + bf2f((unsigned short)qf[s][4]) * k1[0] + bf2f((unsigned short)qf[s][5]) * k1[1] + bf2f((unsigned short)qf[s][6]) * k1[2] + bf2f((unsigned short)qf[s][7]) * k1[3];
                    }
                    gsum += __shfl_xor(gsum, 32);
                    if (gsum > v1) { v3 = v2; i3 = i2; v2 = v1; i2 = i1; v1 = gsum; i1 = j; }
                    else if (gsum > v2) { v3 = v2; i3 = i2; v2 = gsum; i2 = j; }
                    else if (gsum > v3) { v3 = gsum; i3 = j; }
                }
            }
            selmask = (1u << i1) | (1u << i2) | (1u << i3);
        }
        f32x16 O0, O1;
#pragma unroll
        for (int i = 0; i < 16; ++i) { O0[i] = 0.f; O1[i] = 0.f; }
        float mrun = 0.f, lrun = 0.f;
        const int ntile = 4 + 4 * blk;
        const bf16_t* Kst = Kg + ((size_t)bh * 2048 + srow) * 64 + sch * 8;
        const bf16_t* Vst = VTg + ((size_t)bh * 64 + srow) * 2048 + sch * 8;
        u32x4 kreg[2], vreg[2];
#pragma unroll
        for (int q = 0; q < 2; ++q) { const int kp = blk * 256 + 64 * q; kreg[q] = *(const u32x4*)(Kst + (size_t)kp * 64); vreg[q] = *(const u32x4*)(Vst + kp); }
#pragma unroll
        for (int q = 0; q < 2; ++q) { *(LAS u32x4*)(lds + q * BUFB + st_off) = kreg[q]; *(LAS u32x4*)(lds + q * BUFB + TILEB + st_off) = vreg[q]; }
        __syncthreads();
        for (int n = 0; n < ntile; n += 2) {
            if (n + 2 < ntile) {
#pragma unroll
                for (int q = 0; q < 2; ++q) { const int m = n + 2 + q; const int kp = m < 4 ? blk * 256 + 64 * m : ((m - 4) >> 2) * 256 + 64 * ((m - 4) & 3);
                    kreg[q] = *(const u32x4*)(Kst + (size_t)kp * 64); vreg[q] = *(const u32x4*)(Vst + kp); }
            }
            LAS unsigned char* SB = lds + ((n >> 1) & 1) * (2 * BUFB);
            if (n >= 4) {
                const bool on = (selmask >> ((n - 4) >> 2)) & 1u;
                if (__ballot(on) != 0ull) attn_tile2(SB, SB + BUFB, kf_off, vf_off, qf, O0, O1, mrun, lrun, on);
            } else {
#pragma unroll
                for (int q = 0; q < 2; ++q) {
                    const int nn = n + q;
                    const int kpos0 = blk * 256 + 64 * nn;
                    LAS unsigned char* B = SB + q * BUFB;
                    const int dt_ = w >> 1;
                    if (nn == dt_) attn_tile<true>(B, kf_off, vf_off, qf, O0, O1, mrun, lrun, true, kpos0, qpos, hh);
                    else if (nn < dt_) attn_tile<false>(B, kf_off, vf_off, qf, O0, O1, mrun, lrun, true, kpos0, qpos, hh);
                }
            }
            if (n + 2 < ntile) { LAS unsigned char* Bn = lds + (((n >> 1) + 1) & 1) * (2 * BUFB);
#pragma unroll
                for (int q = 0; q < 2; ++q) { *(LAS u32x4*)(Bn + q * BUFB + st_off) = kreg[q]; *(LAS u32x4*)(Bn + q * BUFB + TILEB + st_off) = vreg[q]; } }
            __syncthreads();
        }
        const float inv = 1.f / lrun;
        const size_t row = (size_t)b * 2048 + qpos;
#pragma unroll
        for (int dt = 0; dt < 2; ++dt)
#pragma unroll
            for (int g4 = 0; g4 < 4; ++g4) {
                const int d0 = 32 * dt + 8 * g4 + 4 * hh;
                const u32x2 z2 = *(const u32x2*)(SZA + row * 512 + h * 64 + d0);
                float o0, o1, o2, o3;
                if (dt == 0) { o0 = O0[4 * g4]; o1 = O0[4 * g4 + 1]; o2 = O0[4 * g4 + 2]; o3 = O0[4 * g4 + 3]; }
                else { o0 = O1[4 * g4]; o1 = O1[4 * g4 + 1]; o2 = O1[4 * g4 + 2]; o3 = O1[4 * g4 + 3]; }
                o0 *= inv * bflo(z2[0]); o1 *= inv * bfhi(z2[0]); o2 *= inv * bflo(z2[1]); o3 *= inv * bfhi(z2[1]);
                *(u32x2*)(MIXED + row * 1024 + h * 64 + d0) = (u32x2){pk2(o0, o1), pk2(o2, o3)};
            }
    }
}

__device__ __forceinline__ void scan_unit(const Params& p, LAS unsigned char* lds, int L) {
    const int tid = threadIdx.x, lane = tid & 63, wave = __builtin_amdgcn_readfirstlane(tid >> 6);
    bf16_t* XU = (bf16_t*)(p.ws + WS_XU); const float* L16 = (const float*)(p.ws + WS_LAM16);
    LAS float* E = (LAS float*)(lds + LDS_SCANX);
    const int g = L >> 2;
    const float lr = L16[(g * 64 + lane) * 2], li = L16[(g * 64 + lane) * 2 + 1];
    float pr = lr, pi = li;
#pragma unroll
    for (int q = 0; q < 4; ++q) { const float nr = pr * pr - pi * pi, ni = 2.f * pr * pi; pr = nr; pi = ni; }
    for (int bb = 0; bb < 2; ++bb) {
        const size_t base = (size_t)256 * L + 128 * bb + 16 * wave;
        float sr[16], si[16];
#pragma unroll
        for (int c = 0; c < 16; ++c) { const LAS float* rowp = (const LAS float*)(lds + (128 * bb + 16 * wave + c) * LDS_SROW); sr[c] = rowp[lane]; si[c] = rowp[64 + lane]; }
        float er = 0.f, ei = 0.f;
#pragma unroll
        for (int c = 0; c < 16; ++c) { const float nr = lr * er - li * ei + sr[c], ni = lr * ei + li * er + si[c]; er = nr; ei = ni; }
        E[(wave * 2) * 64 + lane] = er; E[(wave * 2 + 1) * 64 + lane] = ei;
        __syncthreads();
        float Xr = 0.f, Xi = 0.f;
        for (int s2 = 0; s2 < wave; ++s2) { const float e_r = E[(s2 * 2) * 64 + lane], e_i = E[(s2 * 2 + 1) * 64 + lane]; const float nr = pr * Xr - pi * Xi + e_r, ni = pr * Xi + pi * Xr + e_i; Xr = nr; Xi = ni; }
#pragma unroll
        for (int c = 0; c < 16; ++c) {
            const size_t R = base + c;
            XU[R * 384 + lane] = (bf16_t)(pk2(Xr, 0.f) & 0xffffu); XU[R * 384 + 64 + lane] = (bf16_t)(pk2(Xi, 0.f) & 0xffffu);
            const float nr = lr * Xr - li * Xi + sr[c], ni = lr * Xi + li * Xr + si[c]; Xr = nr; Xi = ni;
        }
        __syncthreads();
    }
}

__device__ __forceinline__ void phase_norm(const Params& p) {
    const int tid = threadIdx.x, lane = tid & 63, wave = tid >> 6, G = gridDim.x;
    const float* SSQ = (const float*)(p.ws + WS_SSQ);
    f32x4 gn[4];
#pragma unroll
    for (int j = 0; j < 4; ++j) gn[j] = *((const f32x4*)p.final_gain + lane + 64 * j);
    for (int row = blockIdx.x * 8 + wave; row < NTOK; row += 8 * G) {
        float s = 0.f;
#pragma unroll
        for (int i = 0; i < 16; ++i) s += SSQ[row * 16 + i];
        const float rinv = 1.0f / sqrtf(s * (1.f / DM) + 1e-6f);
        f32x4* o = (f32x4*)(p.out + (size_t)row * DM) + lane;
#pragma unroll
        for (int j = 0; j < 4; ++j) { f32x4 v = o[64 * j]; v = v * rinv * gn[j]; o[64 * j] = v; }
    }
}

__global__ __launch_bounds__(512, 2) void hymba_fwd(Params p) {
    extern __shared__ __attribute__((aligned(16))) unsigned char shm_raw[];
    LAS unsigned char* lds = (LAS unsigned char*)shm_raw;
    cg::grid_group grid = cg::this_grid();
    constexpr int G = 256;
    const int bid = blockIdx.x;
    unsigned char* ws = p.ws;
#if N_LAUNCH == 1
    constexpr int lo = 0, hi = NPH;
#else
    const int lo = p.ph_lo, hi = p.ph_hi;
#endif
    if (threadIdx.x < 4) ((LAS unsigned*)(lds + LDS_CTL))[threadIdx.x] = 0u;
    __syncthreads();
    XcdBarrier xbar = xcd_barrier_post((unsigned*)(ws + WS_BAR), (volatile LAS unsigned*)(lds + LDS_CTL));
    if (hi > 1000) grid.sync();
#define IN(k) (PH_ON(k) && lo <= (k) && (k) < hi)
#define SEAM(k) do { if (lo <= (k) && (k) + 1 < hi) xcd_barrier(xbar); } while (0)
    if (IN(0)) { phase_prep(p, lds); }
    SEAM(0);
    if (IN(1)) {
        pg8::Gemm g{(const bf16_t*)(ws + WS_XB), (const bf16_t*)(ws + WS_WINT)};
        pg8::StaticOrder<NTOK, NPROJ> S{bid};
        EpiInProj E{(const float*)(ws + WS_RS), (const float*)(ws + WS_COS), (const float*)(ws + WS_SIN),
                    (bf16_t*)(ws + WS_Q), (bf16_t*)(ws + WS_K), (bf16_t*)(ws + WS_VT), (bf16_t*)(ws + WS_SZA), (bf16_t*)(ws + WS_SZS), (bf16_t*)(ws + WS_XU), (float*)(ws + WS_KSUM)};
        pg8::gemm_phase<DM, DM, DM>(lds, g, S, E);
    }
    SEAM(1);
    if (IN(2)) {
        unsigned* cnt = (unsigned*)(ws + WS_BAR) + XCD_BAR_WORDS;
        if (bid < 128) {
            const int L = bid;
            {
                pg8::Gemm g{(const bf16_t*)(ws + WS_XU) + 128, (const bf16_t*)(ws + WS_WST)};
                pg8::OneUnit S{L, L >> 2};
                EpiS E{lds};
                pg8::gemm_phase<384, 256, 256, true, false, false>(lds, g, S, E);
            }
            asm volatile("s_waitcnt vmcnt(0)" ::: "memory");
            __syncthreads();
            scan_unit(p, lds, L);
            asm volatile("s_waitcnt vmcnt(0)" ::: "memory");
            __syncthreads();
            {
                pg8::Gemm g{(const bf16_t*)(ws + WS_XU), (const bf16_t*)(ws + WS_WCAT)};
                pg8::OneUnit S{L, L >> 2};
                EpiY E{(bf16_t*)(ws + WS_YG)};
                pg8::gemm_phase<384, 384, 384, false, true, false>(lds, g, S, E);
            }
            asm volatile("s_waitcnt vmcnt(0)" ::: "memory");
            __syncthreads();
            if (threadIdx.x == 0) {
                __builtin_amdgcn_fence(__ATOMIC_RELEASE, "agent");
                asm volatile("s_waitcnt vmcnt(0)" ::: "memory");
                __hip_atomic_fetch_add(cnt + 64 * (L & 3), 1u, __ATOMIC_RELAXED, __HIP_MEMORY_SCOPE_AGENT);
            }
        }
        if (bid < 128) {
            const int U = bid;
            const int pm = U >> 1, pn = U & 1;
            if (threadIdx.x == 0) {
                unsigned sp = 0;
                while (__hip_atomic_load(cnt + 64 * (pm >> 4), __ATOMIC_RELAXED, __HIP_MEMORY_SCOPE_AGENT) < 32u) { __builtin_amdgcn_s_sleep(2); if (++sp > (1u << 22)) break; }
                __builtin_amdgcn_fence(__ATOMIC_ACQUIRE, "agent");
                asm volatile("s_waitcnt vmcnt(0)" ::: "memory");
            }
            __syncthreads();
            pg8::Gemm g{(const bf16_t*)(ws + WS_YG), (const bf16_t*)(ws + WS_WGLUT)};
            pg8::OneUnit S{pm, pn};
            EpiGlu E{(const bf16_t*)(ws + WS_YG), (const bf16_t*)(ws + WS_SZS), p.b_glu, (bf16_t*)(ws + WS_XB)};
            pg8::gemm_phase<512, 512, 512, false, true, false>(lds, g, S, E);
        }
        phase_attn(p, lds, cnt + 256);
    }
    SEAM(2);
    if (G == 256) {
        if (IN(6)) {
            pg8::Gemm g{(const bf16_t*)(ws + WS_XB), (const bf16_t*)(ws + WS_WOUTT)};
            pg8::StaticOrder<NTOK, DM> S{bid};
            EpiOutFused E{p.x, p.out, (float*)(ws + WS_SSQ), p.final_gain, xbar};
            pg8::gemm_phase<DM, DM, DM, true, true, true>(lds, g, S, E);
        }
    } else {
        if (IN(6)) {
            pg8::Gemm g{(const bf16_t*)(ws + WS_XB), (const bf16_t*)(ws + WS_WOUTT)};
            pg8::StaticOrder<NTOK, DM> S{bid};
            EpiOut E{p.x, p.out, (float*)(ws + WS_SSQ)};
            pg8::gemm_phase<DM, DM, DM>(lds, g, S, E);
        }
        SEAM(6);
        if (IN(7)) { phase_norm(p); }
    }
#undef IN
#undef SEAM
}

extern "C" void kernel_launch(void* const* d_in, const int* in_sizes, int n_in, void* d_out, int out_size, void* d_ws, size_t ws_size, hipStream_t stream) {
    static int grid = 0;
    if (grid == 0) {
        if (n_in != 15 || in_sizes[0] != NTOK * DM || out_size != NTOK * DM || ws_size < WS_END) { fprintf(stderr, "kernel_launch: unexpected shapes (n_in %d, in0 %d, out %d, ws %zu)\n", n_in, n_in > 0 ? in_sizes[0] : -1, out_size, ws_size); grid = -1; return; }
        int dev = 0, cus = 0, per_cu = 0;
        (void)hipGetDevice(&dev); (void)hipDeviceGetAttribute(&cus, hipDeviceAttributeMultiprocessorCount, dev);
        if (hipFuncSetAttribute((const void*)hymba_fwd, hipFuncAttributeMaxDynamicSharedMemorySize, LDS_BYTES) != hipSuccess) { fprintf(stderr, "kernel_launch: hipFuncSetAttribute failed\n"); grid = -1; return; }
        if (hipOccupancyMaxActiveBlocksPerMultiprocessor(&per_cu, (const void*)hymba_fwd, 512, LDS_BYTES) != hipSuccess || per_cu < 1) { fprintf(stderr, "kernel_launch: occupancy query says %d\n", per_cu); per_cu = 1; }
        (void)hipGetLastError();
        if (cus != 256) { fprintf(stderr, "kernel_launch: built for a 256-CU device (one workgroup per CU), found %d CUs; nothing launched\n", cus); grid = -1; return; }
        grid = 256;
    }
    if (grid < 0) return;
    if (hipMemsetAsync((char*)d_ws + WS_BAR, 0, (XCD_BAR_WORDS + 512) * 4, stream) != hipSuccess) { fprintf(stderr, "kernel_launch: memset of barrier words failed\n"); return; }
    Params p{};
    p.x = (const float*)d_in[0]; p.norm_gain = (const float*)d_in[1]; p.w_in = (const float*)d_in[2]; p.w_out = (const float*)d_in[3];
    p.lam_re = (const float*)d_in[4]; p.lam_im = (const float*)d_in[5]; p.b_re = (const float*)d_in[6]; p.b_im = (const float*)d_in[7];
    p.c_re = (const float*)d_in[8]; p.c_im = (const float*)d_in[9]; p.d_skip = (const float*)d_in[10]; p.log_dt = (const float*)d_in[11];
    p.w_glu = (const float*)d_in[12]; p.b_glu = (const float*)d_in[13]; p.final_gain = (const float*)d_in[14];
    p.out = (float*)d_out; p.ws = (unsigned char*)d_ws;
#if N_LAUNCH == 1
    p.ph_lo = 0; p.ph_hi = NPH;
    void* args[] = {&p};
    hipError_t e = hipLaunchCooperativeKernel((const void*)hymba_fwd, dim3(grid), dim3(512), args, LDS_BYTES, stream);
    if (e != hipSuccess) fprintf(stderr, "cooperative launch failed: %s (grid %d)\n", hipGetErrorString(e), grid);
#else
    for (int ph = 0; ph < NPH; ++ph) {
        p.ph_lo = ph; p.ph_hi = ph + 1;
        hipLaunchKernelGGL(hymba_fwd, dim3(grid), dim3(512), LDS_BYTES, stream, p);
    }
#endif
}
```

```cpp
#include <hip/hip_runtime.h>
#include <hip/hip_cooperative_groups.h>
#include <cstdio>
#include <cstdint>
namespace cg = cooperative_groups;

#ifndef ONLY_PH
#define ONLY_PH -1
#endif
#define PH_ON(x) (ONLY_PH < 0 || ONLY_PH == (x))
#ifndef N_LAUNCH
#define N_LAUNCH 1
#endif

#define LAS __attribute__((address_space(3)))
typedef unsigned short bf16_t;
typedef short bf16x8 __attribute__((ext_vector_type(8)));
typedef float f32x4 __attribute__((ext_vector_type(4)));
typedef float f32x16 __attribute__((ext_vector_type(16)));
typedef unsigned u32x2 __attribute__((ext_vector_type(2)));
typedef unsigned u32x4 __attribute__((ext_vector_type(4)));

constexpr int NTOK = 16384, DM = 1024, SEQ = 2048, NPROJ = 3072;
constexpr int NPH = 8;
constexpr size_t MBy = 1u << 20;
constexpr size_t WS_XB = 0;
constexpr size_t WS_WINT = 32 * MBy;
constexpr size_t WS_WOUTT = 38 * MBy;
constexpr size_t WS_WGLUT = 40 * MBy;
constexpr size_t WS_WST = 41 * MBy;
constexpr size_t WS_WCAT = 45 * MBy;
constexpr size_t WS_LAM16 = 51 * MBy;
constexpr size_t WS_RS = WS_LAM16 + 64 * 1024;
constexpr size_t WS_COS = WS_RS + 64 * 1024;
constexpr size_t WS_SIN = WS_COS + 256 * 1024;
constexpr size_t WS_KSUM = WS_SIN + 256 * 1024;
constexpr size_t WS_Q = 52 * MBy;
constexpr size_t WS_K = 68 * MBy;
constexpr size_t WS_VT = 84 * MBy;
constexpr size_t WS_SZA = 100 * MBy;
constexpr size_t WS_SZS = 116 * MBy;
constexpr size_t WS_XU = 132 * MBy;
constexpr size_t WS_SST = 156 * MBy;
constexpr size_t WS_YG = 172 * MBy;
constexpr size_t WS_SSQ = 188 * MBy;
constexpr size_t WS_BAR = 189 * MBy;
constexpr size_t WS_END = 190 * MBy;
constexpr int LDS_SROW = 528;
constexpr int LDS_SCANX = 256 * LDS_SROW;
constexpr int LDS_CTL = LDS_SCANX + 4096;
constexpr int LDS_BYTES = LDS_CTL + 16;

struct Params {
    const float *x, *norm_gain, *w_in, *w_out, *lam_re, *lam_im, *b_re, *b_im, *c_re, *c_im, *d_skip, *log_dt, *w_glu, *b_glu, *final_gain;
    float* out; unsigned char* ws;
    int ph_lo, ph_hi;
};

typedef float f32x2c_t __attribute__((ext_vector_type(2)));
typedef __bf16 bf16x2c_t __attribute__((ext_vector_type(2)));
__device__ __forceinline__ unsigned pk2(float lo, float hi) { const f32x2c_t v = {lo, hi}; return __builtin_bit_cast(unsigned, __builtin_convertvector(v, bf16x2c_t)); }
__device__ __forceinline__ float bf2f(unsigned short b) { return __uint_as_float(((unsigned)b) << 16); }
__device__ __forceinline__ float bflo(unsigned w) { return __uint_as_float(w << 16); }
__device__ __forceinline__ float bfhi(unsigned w) { return __uint_as_float(w & 0xffff0000u); }
__device__ __forceinline__ float wave_sum(float v) {
#pragma unroll
    for (int o = 1; o < 64; o <<= 1) v += __shfl_xor(v, o);
    return v;
}
__device__ __forceinline__ float sigmoidf_(float v) { return __builtin_amdgcn_rcpf(1.f + __expf(-v)); }
__device__ __forceinline__ float siluf_(float v) { return v * sigmoidf_(v); }
__device__ __forceinline__ float gelu_tanh(float y) { const float t = 1.5957691216f * (y + 0.044715f * y * y * y); return y * sigmoidf_(t); }


#define XB_TMO      128
#define XB_XCNT(j)  (256  + 64 * (j))
#define XB_XSUB(j)  (1280 + 64 * (j))
#define XB_XGEN(j)  (2304 + 64 * (j))
#define XB_TOP      3328
#define XB_TOPGEN   3392
#define XCD_BAR_WORDS 3456
#define XB_SPIN_CAP (1u << 18)
__device__ __forceinline__ unsigned xb_ld(unsigned* p)              { return __hip_atomic_load(p, __ATOMIC_RELAXED, __HIP_MEMORY_SCOPE_AGENT); }
__device__ __forceinline__ unsigned xb_add(unsigned* p, unsigned v) { return __hip_atomic_fetch_add(p, v, __ATOMIC_RELAXED, __HIP_MEMORY_SCOPE_AGENT); }
__device__ __forceinline__ unsigned xb_xcc_id() { return (unsigned)__builtin_amdgcn_s_getreg((3 << 11) | 20) & 0xFu; }
#define XB_SPIN(cond, bar) do { unsigned _sp = 0; while (cond) { __builtin_amdgcn_s_sleep(1); \
    if ((++_sp & 255u) == 0u) { if (xb_ld(&(bar)[XB_TMO])) break; if (_sp > XB_SPIN_CAP) { atomicAdd(&(bar)[XB_TMO], 1u); break; } } } } while (0)
struct XcdBarrier { unsigned* bar; unsigned x; volatile LAS unsigned* st; };
__device__ __forceinline__ XcdBarrier xcd_barrier_post(unsigned* bar, volatile LAS unsigned* st) {
    XcdBarrier b; b.bar = bar; b.x = xb_xcc_id(); b.st = st;
    if (threadIdx.x == 0) (void)xb_add(&bar[XB_XCNT(b.x)], 1u);
    return b;
}
__device__ __forceinline__ void xcd_barrier_complete(unsigned* bar, unsigned x, unsigned& nloc, unsigned& nx) {
    const unsigned G = 256u;
    unsigned sum, cnt, mine, sp = 0u;
    for (;;) {
        sum = 0u; cnt = 0u; mine = 0u;
#pragma unroll
        for (unsigned j = 0; j < 16; ++j) { const unsigned c = xb_ld(&bar[XB_XCNT(j)]); sum += c; cnt += (c > 0u) ? 1u : 0u; mine = (j == x) ? c : mine; }
        if (sum == G) break;
        __builtin_amdgcn_s_sleep(1);
        if ((++sp & 255u) == 0u) { if (xb_ld(&bar[XB_TMO])) break; if (sp > XB_SPIN_CAP) { atomicAdd(&bar[XB_TMO], 1u); break; } }
    }
    nloc = mine > 0u ? mine : 1u; nx = cnt > 0u ? cnt : 1u;
}
__device__ __forceinline__ void xcd_barrier(const XcdBarrier& b) {
    asm volatile("s_waitcnt vmcnt(0)" ::: "memory");
    __syncthreads();
    if (threadIdx.x == 0) {
        unsigned* bar = b.bar;
        __builtin_amdgcn_s_waitcnt(0);
        unsigned nloc = b.st[0], nx = b.st[1];
        if (nloc == 0u) { xcd_barrier_complete(bar, b.x, nloc, nx); b.st[0] = nloc; b.st[1] = nx; }
        const unsigned old = xb_add(&bar[XB_XSUB(b.x)], 1u);
        const unsigned gen = old / nloc;
        if (old + 1u == (gen + 1u) * nloc) {
            __builtin_amdgcn_fence(__ATOMIC_RELEASE, "agent");
            asm volatile("s_waitcnt vmcnt(0)" ::: "memory");
            const unsigned og = xb_add(&bar[XB_TOP], 1u);
            const unsigned tg = og / nx;
            if (og + 1u == (tg + 1u) * nx) xb_add(&bar[XB_TOPGEN], 1u);
            else XB_SPIN(xb_ld(&bar[XB_TOPGEN]) == tg, bar);
            __builtin_amdgcn_fence(__ATOMIC_ACQUIRE, "agent");
            xb_add(&bar[XB_XGEN(b.x)], 1u);
            asm volatile("s_waitcnt vmcnt(0)" ::: "memory");
        } else {
            XB_SPIN(xb_ld(&bar[XB_XGEN(b.x)]) == gen, bar);
            __builtin_amdgcn_fence(__ATOMIC_ACQUIRE, "agent");
            asm volatile("s_waitcnt vmcnt(0)" ::: "memory");
        }
    }
    __syncthreads();
}

namespace pg8 {
constexpr int BM = 256, BK = 64, HALF = 128, HTB = HALF * BK * 2, STAGE_BYTES = 8 * HTB, NXCD = 8, WGM = 8;
__device__ __forceinline__ int lds_byte(int r, int c) { const int st = (r >> 4) * 2 + (c >> 5), rr = r & 15, cc = c & 31, ob = rr * 64 + cc * 2; return st * 1024 + (ob ^ (((ob >> 9) & 1) << 5)); }
__device__ __forceinline__ void stage_rc(int b, int& R, int& C) { const int st = b / 1024, sb = b % 1024, swz = sb ^ (((sb >> 9) & 1) << 5); R = (st >> 1) * 16 + swz / 64; C = (st & 1) * 32 + (swz % 64) / 2; }
struct Unit { int pm, pn; };
struct Gemm { const bf16_t* A; const bf16_t* Bt; };

template <int M, int N>
struct StaticOrder {
    static constexpr int nM = M / BM, nN = N / BM, nwg = nM * nN, G = 256;
    int c;
    __device__ bool next(int i, Unit& u) const {
        const int L = i * G + c; if (L >= nwg) return false;
        int wgid = L; { constexpr int q = nwg / NXCD, r = nwg % NXCD; const int xcd = wgid % NXCD, off = wgid / NXCD; wgid = (xcd < r ? xcd * (q + 1) : r * (q + 1) + (xcd - r) * q) + off; }
        constexpr int nig = WGM * nN; const int gid = wgid / nig, fm = gid * WGM, gsz = (nM - fm) < WGM ? (nM - fm) : WGM;
        u.pm = fm + ((wgid % nig) % gsz); u.pn = (wgid % nig) / gsz; return true;
    }
};
struct GroupOrder {
    int G, c;
    __device__ bool next(int i, Unit& u) const { const int L = i * G + c; if (L >= 128) return false; u.pm = L; u.pn = L >> 2; return true; }
};

struct OneUnit {
    int pm, pn;
    __device__ bool next(int i, Unit& u) const { if (i) return false; u.pm = pm; u.pn = pn; return true; }
};

template <int LDA, int LDB, int KK, bool AFTER = false, bool ALIGN_EPI = true, bool SP2 = true, class Epi, class Sched>
__device__ __forceinline__ void gemm_phase(LAS unsigned char* lds, const Gemm g, const Sched& S, const Epi& E) {
    const int tid = threadIdx.x, wid = __builtin_amdgcn_readfirstlane(tid >> 6), lane = tid & 63, wr = wid >> 2, wc = wid & 3, fr = lane & 15, fq = lane >> 4;
    constexpr int K = KK, nt = K / BK;
    unsigned voffA[2], voffB[2];
#pragma unroll
    for (int i = 0; i < 2; ++i) { int R, C; stage_rc(tid * 16 + i * 8192, R, C); voffA[i] = (unsigned)(R * LDA + C) * 2u; voffB[i] = (unsigned)(R * LDB + C) * 2u; }
    constexpr size_t kstep = (size_t)(BK * 2);
    constexpr size_t hstepA = (size_t)HALF * LDA * 2, hstepB = (size_t)HALF * LDB * 2;
    constexpr size_t tstepA = 2 * hstepA, tstepB = 2 * hstepB;
    const unsigned ldsw = (unsigned)wid * 1024u;
    const int aoff = lds_byte(wr * 64 + fr, fq * 8), boff = lds_byte(wc * 32 + fr, fq * 8);
#define PG8_SA(b, h) (((b) * 2 + (h)) * HTB)
#define PG8_SB(b, h) ((4 + (b) * 2 + (h)) * HTB)
#define PG8_STAGE(bufoff, gbase, voff) do { _Pragma("unroll") for (int _i = 0; _i < 2; ++_i) \
        __builtin_amdgcn_global_load_lds((const unsigned*)((const char*)(gbase) + (voff)[_i]), (LAS unsigned*)(lds + (bufoff) + ldsw + _i * 8192), 16, 0, 0); } while (0)
#define PG8_LDA(dst, b, h) do { _Pragma("unroll") for (int m = 0; m < 4; ++m) _Pragma("unroll") for (int k = 0; k < 2; ++k) dst[m][k] = *(const LAS bf16x8*)(lds + PG8_SA(b, h) + aoff + m * 2048 + k * 1024); } while (0)
#define PG8_LDB(dst, b, h) do { _Pragma("unroll") for (int n = 0; n < 2; ++n) _Pragma("unroll") for (int k = 0; k < 2; ++k) dst[n][k] = *(const LAS bf16x8*)(lds + PG8_SB(b, h) + boff + n * 2048 + k * 1024); } while (0)
#define PG8_MMA(ai, bj, At, Bt) do { __builtin_amdgcn_s_setprio(1); _Pragma("unroll") for (int m = 0; m < 4; ++m) _Pragma("unroll") for (int n = 0; n < 2; ++n) _Pragma("unroll") for (int k = 0; k < 2; ++k) \
        acc[ai][bj][m][n] = __builtin_amdgcn_mfma_f32_16x16x32_bf16(Bt[n][k], At[m][k], acc[ai][bj][m][n], 0, 0, 0); __builtin_amdgcn_s_setprio(0); } while (0)
#define PG8_WAIT_V(n) asm volatile("s_waitcnt vmcnt(" #n ")" ::: "memory")
#define PG8_WAIT_L(n) asm volatile("s_waitcnt lgkmcnt(" #n ")" ::: "memory")
#define PG8_BAR __builtin_amdgcn_s_barrier()
#define PG8_SCHED __builtin_amdgcn_sched_barrier(0)
    Unit cur, nxt; int ui = 0;
    if (!S.next(0, cur)) return;
    f32x4 acc[2][2][4][2];
#pragma unroll
    for (int a = 0; a < 2; ++a)
#pragma unroll
        for (int b = 0; b < 2; ++b)
#pragma unroll
            for (int m = 0; m < 4; ++m)
#pragma unroll
                for (int n = 0; n < 2; ++n) acc[a][b][m][n] = (f32x4){0.f, 0.f, 0.f, 0.f};
    bf16x8 At[4][2], B0[2][2], B1[2][2];
    const char* cA = (const char*)g.A + (size_t)cur.pm * tstepA; const char* cB = (const char*)g.Bt + (size_t)cur.pn * tstepB;
    if constexpr (SP2) {
        PG8_STAGE(PG8_SB(0, 0), cB, voffB); PG8_STAGE(PG8_SB(0, 1), cB + hstepB, voffB); PG8_STAGE(PG8_SA(0, 0), cA, voffA); PG8_STAGE(PG8_SA(0, 1), cA + hstepA, voffA);
        if (wr == 1) PG8_BAR;
        PG8_WAIT_V(2); PG8_BAR;
        PG8_STAGE(PG8_SB(1, 0), cB + kstep, voffB); PG8_STAGE(PG8_SA(1, 0), cA + kstep, voffA); PG8_STAGE(PG8_SB(1, 1), cB + hstepB + kstep, voffB);
        PG8_WAIT_V(6); PG8_BAR;
    } else {
        PG8_STAGE(PG8_SB(0, 0), cB, voffB); PG8_STAGE(PG8_SA(0, 0), cA, voffA); PG8_STAGE(PG8_SB(0, 1), cB + hstepB, voffB); PG8_STAGE(PG8_SA(0, 1), cA + hstepA, voffA);
        if (wr == 1) PG8_BAR;
        PG8_WAIT_V(4); PG8_BAR;
        PG8_STAGE(PG8_SB(1, 0), cB + kstep, voffB); PG8_STAGE(PG8_SA(1, 0), cA + kstep, voffA); PG8_STAGE(PG8_SB(1, 1), cB + hstepB + kstep, voffB);
        PG8_WAIT_V(6); PG8_BAR;
    }
    for (;;) {
        const bool has_next = S.next(ui + 1, nxt);
        const char* nA = has_next ? (const char*)g.A + (size_t)nxt.pm * tstepA : cA; const char* nB = has_next ? (const char*)g.Bt + (size_t)nxt.pn * tstepB : cB;
        for (int t = 0; t < nt; t += 2) {
            const bool last = (t == nt - 2);
            const char* a1 = cA + (size_t)(t + 1) * kstep;
            const char* a2 = last ? nA : cA + (size_t)(t + 2) * kstep; const char* b2 = last ? nB : cB + (size_t)(t + 2) * kstep;
            const char* a3 = a2 + kstep; const char* b3 = b2 + kstep;
            if constexpr (SP2) {
            PG8_LDB(B0, 0, 0); PG8_LDB(B1, 0, 1); PG8_SCHED; PG8_LDA(At, 0, 0); PG8_STAGE(PG8_SA(1, 1), a1 + hstepA, voffA);
            PG8_WAIT_V(8); PG8_WAIT_L(0); PG8_BAR; PG8_MMA(0, 0, At, B0); PG8_MMA(0, 1, At, B1); PG8_BAR; PG8_SCHED;
            PG8_LDA(At, 0, 1); PG8_STAGE(PG8_SB(0, 0), b2, voffB); PG8_STAGE(PG8_SB(0, 1), b2 + hstepB, voffB); PG8_STAGE(PG8_SA(0, 0), a2, voffA);
            PG8_WAIT_V(8); PG8_WAIT_L(0); PG8_BAR; PG8_MMA(1, 0, At, B0); PG8_MMA(1, 1, At, B1); PG8_BAR; PG8_SCHED;
            PG8_LDB(B0, 1, 0); PG8_LDB(B1, 1, 1); PG8_SCHED; PG8_LDA(At, 1, 0); PG8_STAGE(PG8_SA(0, 1), a2 + hstepA, voffA);
            PG8_WAIT_V(8); PG8_WAIT_L(0); PG8_BAR; PG8_MMA(0, 0, At, B0); PG8_MMA(0, 1, At, B1); PG8_BAR; PG8_SCHED;
            PG8_LDA(At, 1, 1); PG8_STAGE(PG8_SB(1, 0), b3, voffB); PG8_STAGE(PG8_SB(1, 1), b3 + hstepB, voffB); PG8_STAGE(PG8_SA(1, 0), a3, voffA);
            PG8_WAIT_V(8); PG8_WAIT_L(0); PG8_BAR; PG8_MMA(1, 0, At, B0); PG8_MMA(1, 1, At, B1); PG8_BAR; PG8_SCHED;
            } else {
            PG8_LDB(B0, 0, 0); PG8_SCHED; PG8_LDA(At, 0, 0); PG8_STAGE(PG8_SA(1, 1), a1 + hstepA, voffA);
            PG8_WAIT_L(8); PG8_BAR; PG8_WAIT_L(0); PG8_MMA(0, 0, At, B0); PG8_BAR; PG8_SCHED;
            PG8_LDB(B1, 0, 1); PG8_STAGE(PG8_SB(0, 0), b2, voffB);
            PG8_BAR; PG8_WAIT_L(0); PG8_MMA(0, 1, At, B1); PG8_BAR;
            PG8_LDA(At, 0, 1); PG8_STAGE(PG8_SA(0, 0), a2, voffA);
            PG8_BAR; PG8_WAIT_L(0); PG8_MMA(1, 0, At, B0); PG8_BAR; PG8_SCHED;
            PG8_STAGE(PG8_SB(0, 1), b2 + hstepB, voffB);
            PG8_WAIT_V(6); PG8_BAR; PG8_MMA(1, 1, At, B1); PG8_BAR;
            PG8_LDB(B0, 1, 0); PG8_SCHED; PG8_LDA(At, 1, 0); PG8_STAGE(PG8_SA(0, 1), a2 + hstepA, voffA);
            PG8_WAIT_L(8); PG8_BAR; PG8_WAIT_L(0); PG8_MMA(0, 0, At, B0); PG8_BAR; PG8_SCHED;
            PG8_LDB(B1, 1, 1); PG8_STAGE(PG8_SB(1, 0), b3, voffB);
            PG8_BAR; PG8_WAIT_L(0); PG8_MMA(0, 1, At, B1); PG8_BAR;
            PG8_LDA(At, 1, 1); PG8_STAGE(PG8_SA(1, 0), a3, voffA);
            PG8_BAR; PG8_WAIT_L(0); PG8_MMA(1, 0, At, B0); PG8_BAR; PG8_SCHED;
            PG8_STAGE(PG8_SB(1, 1), b3 + hstepB, voffB);
            PG8_WAIT_V(6); PG8_BAR; PG8_MMA(1, 1, At, B1); PG8_BAR;
                    }
        }
        if constexpr (ALIGN_EPI) { if (wr == 0) PG8_BAR; }
        E(acc, cur, wr, wc, fr, fq);
        if (!has_next) break;
#pragma unroll
        for (int a = 0; a < 2; ++a)
#pragma unroll
            for (int b = 0; b < 2; ++b)
#pragma unroll
                for (int m = 0; m < 4; ++m)
#pragma unroll
                    for (int n = 0; n < 2; ++n) acc[a][b][m][n] = (f32x4){0.f, 0.f, 0.f, 0.f};
        cur = nxt; cA = nA; cB = nB; ++ui;
        if constexpr (ALIGN_EPI) { if (wr == 1) PG8_BAR; }
    }
    PG8_WAIT_V(0);
    if constexpr (!ALIGN_EPI) { if (wr == 0) PG8_BAR; }
    PG8_BAR;
    if constexpr (AFTER) E.after(acc, cur, wr, wc, fr, fq);
#undef PG8_SA
#undef PG8_SB
#undef PG8_STAGE
#undef PG8_LDA
#undef PG8_LDB
#undef PG8_MMA
#undef PG8_WAIT_V
#undef PG8_WAIT_L
#undef PG8_BAR
#undef PG8_SCHED
}
}
using pg8::Unit;


__device__ __forceinline__ int inproj_row(int e) {
    const int pn = e >> 8, o = e & 255;
    const int wc = o >> 6, bj = (o >> 5) & 1, fq = (o >> 3) & 3, n = (o >> 2) & 1, i = o & 3;
    return 256 * pn + 128 * bj + 32 * wc + 16 * n + 4 * fq + i;
}

struct EpiInProj {
    const float *rs, *cosT, *sinT;
    bf16_t *Q, *Kk, *VT, *SZA, *SZS, *XU; float* KSUM;
    __device__ __forceinline__ void operator()(const f32x4 (&acc)[2][2][4][2], const Unit& u, int wr, int wc, int fr, int fq) const {
        const int seg = u.pn >> 1, half = u.pn & 1;
        const int b = u.pm >> 3, blk = u.pm & 7;
        const int lbase = blk * 256 + wr * 64 + fr;
        if (seg <= 1) {
            bf16_t* dst = seg == 0 ? Q : Kk; const float qs = seg == 0 ? 0.18033688011112042f : 1.0f;
            const int head = 4 * half + wc;
            f32x4 cl[2], ch[2];
#pragma unroll
            for (int n = 0; n < 2; ++n) { cl[n] = (f32x4){0.f, 0.f, 0.f, 0.f}; ch[n] = (f32x4){0.f, 0.f, 0.f, 0.f}; }
            bf16_t* obase = dst + ((size_t)((b * 8 + head) * 2048)) * 64 + 8 * fq;
#pragma unroll
            for (int ai = 0; ai < 2; ++ai)
#pragma unroll
                for (int m = 0; m < 4; ++m) {
                    const int l = lbase + 128 * ai + 16 * m; const float rsv = rs[b * 2048 + l] * qs;
                    unsigned wl[4], wh[4];
#pragma unroll
                    for (int n = 0; n < 2; ++n) {
                        const f32x4 c4 = *(const f32x4*)(cosT + l * 32 + 8 * fq + 4 * n), s4 = *(const f32x4*)(sinT + l * 32 + 8 * fq + 4 * n);
                        const f32x4 t1 = acc[ai][0][m][n] * rsv, t2 = acc[ai][1][m][n] * rsv;
                        const f32x4 lo = t1 * c4 - t2 * s4, hi = t2 * c4 + t1 * s4;
                        wl[2 * n] = pk2(lo[0], lo[1]); wl[2 * n + 1] = pk2(lo[2], lo[3]); wh[2 * n] = pk2(hi[0], hi[1]); wh[2 * n + 1] = pk2(hi[2], hi[3]);
                        cl[n] += lo; ch[n] += hi;
                    }
                    bf16_t* o = obase + (unsigned)l * 64u;
                    *(u32x4*)o = (u32x4){wl[0], wl[1], wl[2], wl[3]};
                    *(u32x4*)(o + 32) = (u32x4){wh[0], wh[1], wh[2], wh[3]};
                }
            if (seg == 1) {
#pragma unroll
                for (int n = 0; n < 2; ++n)
#pragma unroll
                    for (int i = 0; i < 4; ++i) {
                        float v = cl[n][i], v2 = ch[n][i];
                        v += __shfl_xor(v, 1); v += __shfl_xor(v, 2); v += __shfl_xor(v, 4); v += __shfl_xor(v, 8);
                        v2 += __shfl_xor(v2, 1); v2 += __shfl_xor(v2, 2); v2 += __shfl_xor(v2, 4); v2 += __shfl_xor(v2, 8);
                        if (fr == 0) { float* kp = KSUM + ((b * 8 + head) * 8 + blk) * 64 + 8 * fq + 4 * n + i; atomicAdd(kp, v); atomicAdd(kp + 32, v2); }
                    }
            }
        } else if (seg == 2) {
            const int head = 4 * half + wc;
#pragma unroll
            for (int ai = 0; ai < 2; ++ai)
#pragma unroll
                for (int m = 0; m < 4; ++m) {
                    const int l = lbase + 128 * ai + 16 * m; const float rsv = rs[b * 2048 + l];
#pragma unroll
                    for (int bj = 0; bj < 2; ++bj)
#pragma unroll
                        for (int n = 0; n < 2; ++n) {
                            const int d0 = 32 * bj + 8 * fq + 4 * n;
                            const f32x4 v = acc[ai][bj][m][n] * rsv;
                            bf16_t* o = VT + ((size_t)((b * 8 + head) * 64 + d0)) * 2048 + l;
                            const unsigned p0 = pk2(v[0], v[1]), p1 = pk2(v[2], v[3]);
                            o[0] = (bf16_t)(p0 & 0xffffu); o[2048] = (bf16_t)(p0 >> 16); o[4096] = (bf16_t)(p1 & 0xffffu); o[6144] = (bf16_t)(p1 >> 16);
                        }
                }
        } else if (seg == 4) {
#pragma unroll
            for (int ai = 0; ai < 2; ++ai)
#pragma unroll
                for (int m = 0; m < 4; ++m) {
                    const int l = lbase + 128 * ai + 16 * m; const float rsv = rs[b * 2048 + l];
                    const int c = l >> 4, t = l & 15;
#pragma unroll
                    for (int bj = 0; bj < 2; ++bj) {
                        const int g = 16 * half + 4 * wc + 2 * bj + (fq >> 1);
                        const f32x4 v0 = acc[ai][bj][m][0] * rsv, v1 = acc[ai][bj][m][1] * rsv;
                        bf16_t* o = XU + ((size_t)(1024 * g + b * 128 + c)) * 384 + 128 + t * 16 + 8 * (fq & 1);
                        *(u32x4*)o = (u32x4){pk2(v0[0], v0[1]), pk2(v0[2], v0[3]), pk2(v1[0], v1[1]), pk2(v1[2], v1[3])};
                    }
                }
        } else {
            bf16_t* dst = seg == 3 ? SZA : SZS;
#pragma unroll
            for (int ai = 0; ai < 2; ++ai)
#pragma unroll
                for (int m = 0; m < 4; ++m) {
                    const int l = lbase + 128 * ai + 16 * m; const int row = b * 2048 + l; const float rsv = rs[row];
#pragma unroll
                    for (int bj = 0; bj < 2; ++bj) {
                        const int col = 256 * half + 64 * wc + 32 * bj + 8 * fq;
                        const f32x4 v0 = acc[ai][bj][m][0] * rsv, v1 = acc[ai][bj][m][1] * rsv;
                        *(u32x4*)(dst + (size_t)row * 512 + col) = (u32x4){pk2(siluf_(v0[0]), siluf_(v0[1])), pk2(siluf_(v0[2]), siluf_(v0[3])), pk2(siluf_(v1[0]), siluf_(v1[1])), pk2(siluf_(v1[2]), siluf_(v1[3]))};
                    }
                }
        }
    }
};

struct EpiS {
    LAS unsigned char* lds;
    __device__ __forceinline__ void operator()(const f32x4 (&acc)[2][2][4][2], const Unit& u, int wr, int wc, int fr, int fq) const {}
    __device__ __forceinline__ void after(const f32x4 (&acc)[2][2][4][2], const Unit& u, int wr, int wc, int fr, int fq) const {
#pragma unroll
        for (int ai = 0; ai < 2; ++ai)
#pragma unroll
            for (int m = 0; m < 4; ++m) {
                const int r = 128 * ai + 64 * wr + 16 * m + fr;
#pragma unroll
                for (int n = 0; n < 2; ++n) *(LAS f32x4*)(lds + r * LDS_SROW + (32 * wc + 16 * n + 4 * fq) * 4) = acc[ai][0][m][n];
            }
    }
};

struct EpiY {
    bf16_t* YG;
    __device__ __forceinline__ void operator()(const f32x4 (&acc)[2][2][4][2], const Unit& u, int wr, int wc, int fr, int fq) const {
        const int g = u.pn, t = 4 * wc + fq;
#pragma unroll
        for (int ai = 0; ai < 2; ++ai)
#pragma unroll
            for (int m = 0; m < 4; ++m) {
                const int rr = 256 * (u.pm & 3) + 128 * ai + 64 * wr + 16 * m + fr;
                const int b = rr >> 7, c = rr & 127; const int token = b * 2048 + 16 * c + t;
                bf16_t* ob = YG + (size_t)token * 512 + 16 * g;
#pragma unroll
                for (int bj = 0; bj < 2; ++bj) {
                    const f32x4 v0 = acc[ai][bj][m][0], v1 = acc[ai][bj][m][1];
                    *(u32x4*)(ob + 8 * bj) = (u32x4){pk2(gelu_tanh(v0[0]), gelu_tanh(v0[1])), pk2(gelu_tanh(v0[2]), gelu_tanh(v0[3])), pk2(gelu_tanh(v1[0]), gelu_tanh(v1[1])), pk2(gelu_tanh(v1[2]), gelu_tanh(v1[3]))};
                }
            }
    }
};

struct EpiGlu {
    const bf16_t *YG, *SZS; const float* bglu; bf16_t* MIXED;
    __device__ __forceinline__ void operator()(const f32x4 (&acc)[2][2][4][2], const Unit& u, int wr, int wc, int fr, int fq) const {
        f32x4 bias[2][2];
#pragma unroll
        for (int bj = 0; bj < 2; ++bj)
#pragma unroll
            for (int n = 0; n < 2; ++n) bias[bj][n] = *(const f32x4*)(bglu + 256 * u.pn + 64 * wc + 32 * bj + 8 * fq + 4 * n);
#pragma unroll
        for (int ai = 0; ai < 2; ++ai) {
            u32x4 y4[4][2], z4[4][2];
#pragma unroll
            for (int m = 0; m < 4; ++m) {
                const int row = 256 * u.pm + 128 * ai + 64 * wr + 16 * m + fr;
#pragma unroll
                for (int bj = 0; bj < 2; ++bj) {
                    const unsigned off = (unsigned)row * 512u + (unsigned)(256 * u.pn + 64 * wc + 32 * bj + 8 * fq);
                    y4[m][bj] = *(const u32x4*)(YG + off); z4[m][bj] = *(const u32x4*)(SZS + off);
                }
            }
#pragma unroll
            for (int m = 0; m < 4; ++m) {
                const int row = 256 * u.pm + 128 * ai + 64 * wr + 16 * m + fr;
#pragma unroll
                for (int bj = 0; bj < 2; ++bj) {
                    const int col = 256 * u.pn + 64 * wc + 32 * bj + 8 * fq;
                    unsigned w[4];
#pragma unroll
                    for (int n = 0; n < 2; ++n) {
                        const f32x4 a = acc[ai][bj][m][n] + bias[bj][n];
                        const unsigned ya = y4[m][bj][2 * n], yb = y4[m][bj][2 * n + 1], za = z4[m][bj][2 * n], zb = z4[m][bj][2 * n + 1];
                        const float o0 = bflo(ya) * sigmoidf_(a[0]) * bflo(za), o1 = bfhi(ya) * sigmoidf_(a[1]) * bfhi(za);
                        const float o2 = bflo(yb) * sigmoidf_(a[2]) * bflo(zb), o3 = bfhi(yb) * sigmoidf_(a[3]) * bfhi(zb);
                        w[2 * n] = pk2(o0, o1); w[2 * n + 1] = pk2(o2, o3);
                    }
                    *(u32x4*)(MIXED + (size_t)row * 1024 + 512 + col) = (u32x4){w[0], w[1], w[2], w[3]};
                }
            }
        }
    }
};

struct EpiOut {
    const float* x; float* out; float* SSQ;
    __device__ __forceinline__ void operator()(const f32x4 (&acc)[2][2][4][2], const Unit& u, int wr, int wc, int fr, int fq) const {
#pragma unroll
        for (int ai = 0; ai < 2; ++ai) {
            f32x4 xv[4][2][2];
#pragma unroll
            for (int m = 0; m < 4; ++m) {
                const int row = 256 * u.pm + 128 * ai + 64 * wr + 16 * m + fr;
#pragma unroll
                for (int bj = 0; bj < 2; ++bj)
#pragma unroll
                    for (int n = 0; n < 2; ++n) xv[m][bj][n] = __builtin_nontemporal_load((const f32x4*)(x + (size_t)row * 1024 + 256 * u.pn + 64 * wc + 32 * bj + 8 * fq + 4 * n));
            }
#pragma unroll
            for (int m = 0; m < 4; ++m) {
                const int row = 256 * u.pm + 128 * ai + 64 * wr + 16 * m + fr;
                float ss = 0.f;
#pragma unroll
                for (int bj = 0; bj < 2; ++bj)
#pragma unroll
                    for (int n = 0; n < 2; ++n) {
                        const int col = 256 * u.pn + 64 * wc + 32 * bj + 8 * fq + 4 * n;
                        const f32x4 v = acc[ai][bj][m][n] + xv[m][bj][n];
                        *(f32x4*)(out + (size_t)row * 1024 + col) = v;
                        ss += (v[0] * v[0] + v[1] * v[1]) + (v[2] * v[2] + v[3] * v[3]);
                    }
                ss += __shfl_xor(ss, 16); ss += __shfl_xor(ss, 32);
                if (fq == 0) SSQ[row * 16 + 4 * u.pn + wc] = ss;
            }
        }
    }
};

struct EpiOutFused {
    const float* x; float* out; float* SSQ; const float* gain; XcdBarrier xbar;
    __device__ __forceinline__ void operator()(f32x4 (&acc)[2][2][4][2], const Unit& u, int wr, int wc, int fr, int fq) const {
#pragma unroll
        for (int ai = 0; ai < 2; ++ai) {
            f32x4 xv[4][2][2];
#pragma unroll
            for (int m = 0; m < 4; ++m) {
                const int row = 256 * u.pm + 128 * ai + 64 * wr + 16 * m + fr;
#pragma unroll
                for (int bj = 0; bj < 2; ++bj)
#pragma unroll
                    for (int n = 0; n < 2; ++n) xv[m][bj][n] = __builtin_nontemporal_load((const f32x4*)(x + (size_t)row * 1024 + 256 * u.pn + 64 * wc + 32 * bj + 8 * fq + 4 * n));
            }
#pragma unroll
            for (int m = 0; m < 4; ++m) {
                const int row = 256 * u.pm + 128 * ai + 64 * wr + 16 * m + fr;
                float ss = 0.f;
#pragma unroll
                for (int bj = 0; bj < 2; ++bj)
#pragma unroll
                    for (int n = 0; n < 2; ++n) {
                        const f32x4 v = acc[ai][bj][m][n] + xv[m][bj][n];
                        acc[ai][bj][m][n] = v;
                        ss += (v[0] * v[0] + v[1] * v[1]) + (v[2] * v[2] + v[3] * v[3]);
                    }
                ss += __shfl_xor(ss, 16); ss += __shfl_xor(ss, 32);
                if (fq == 0) SSQ[row * 16 + 4 * u.pn + wc] = ss;
            }
        }
    }
    __device__ __forceinline__ void after(f32x4 (&acc)[2][2][4][2], const Unit& u, int wr, int wc, int fr, int fq) const {
        xcd_barrier(xbar);
        f32x4 gn[2][2];
#pragma unroll
        for (int bj = 0; bj < 2; ++bj)
#pragma unroll
            for (int n = 0; n < 2; ++n) gn[bj][n] = *(const f32x4*)(gain + 256 * u.pn + 64 * wc + 32 * bj + 8 * fq + 4 * n);
#pragma unroll
        for (int ai = 0; ai < 2; ++ai)
#pragma unroll
            for (int m = 0; m < 4; ++m) {
                const int row = 256 * u.pm + 128 * ai + 64 * wr + 16 * m + fr;
                const f32x4* sp = (const f32x4*)(SSQ + row * 16);
                const f32x4 s0 = sp[0], s1 = sp[1], s2 = sp[2], s3 = sp[3];
                const float tot = ((s0[0] + s0[1]) + (s0[2] + s0[3])) + ((s1[0] + s1[1]) + (s1[2] + s1[3])) + ((s2[0] + s2[1]) + (s2[2] + s2[3])) + ((s3[0] + s3[1]) + (s3[2] + s3[3]));
                const float rinv = 1.0f / sqrtf(tot * (1.f / DM) + 1e-6f);
#pragma unroll
                for (int bj = 0; bj < 2; ++bj)
#pragma unroll
                    for (int n = 0; n < 2; ++n) {
                        const int col = 256 * u.pn + 64 * wc + 32 * bj + 8 * fq + 4 * n;
                        *(f32x4*)(out + (size_t)row * 1024 + col) = acc[ai][bj][m][n] * rinv * gn[bj][n];
                    }
            }
    }
};

template <int MODE>
__device__ __forceinline__ void transpose_item(const float* W, int K, int N, bf16_t* WT, const float* gain, LAS float* scr, int item, int lane) {
    const int nblk = N / 32, kb = item / nblk, nb = item % nblk, k0 = 64 * kb, n0 = 32 * nb;
#pragma unroll 8
    for (int i = 0; i < 32; ++i) { const int kk = 2 * i + (lane >> 5); float w = W[(size_t)(k0 + kk) * N + n0 + (lane & 31)]; if (MODE == 0) w *= gain[k0 + kk]; scr[kk * 33 + (lane & 31)] = w; }
    const int c = lane & 7;
#pragma unroll
    for (int j = 0; j < 4; ++j) { const int n = (lane >> 3) + 8 * j; const LAS float* s = scr + (8 * c) * 33 + n;
        u32x4 o; o.x = pk2(s[0 * 33], s[1 * 33]); o.y = pk2(s[2 * 33], s[3 * 33]); o.z = pk2(s[4 * 33], s[5 * 33]); o.w = pk2(s[6 * 33], s[7 * 33]);
        const int drow = inproj_row(n0 + n);
        *(u32x4*)(WT + (size_t)drow * K + k0 + 8 * c) = o; }
}

__device__ __forceinline__ void ssm_group_prep(const Params& p, int item, LAS float* L) {
    LAS float* lkr = L; LAS float* lki = L + 1088; LAS float* bbr = L + 2176; LAS float* bbi = L + 3200; LAS float* cr = L + 4224; LAS float* ci = L + 5248; LAS float* Kt = L + 6272;
    const int tid = threadIdx.x, g = item >> 3, sub = item & 7;
    const float dt = expf(p.log_dt[g]);
    for (int t = tid; t < 17 * 64; t += 512) {
        const int pp = t & 63, k = t >> 6;
        const float a = p.lam_re[g * 64 + pp] * dt, th = p.lam_im[g * 64 + pp] * dt;
        const float mag = expf((float)k * a); float sn, cs; sincosf((float)k * th, &sn, &cs);
        lkr[k * 64 + pp] = mag * cs; lki[k * 64 + pp] = mag * sn;
    }
    for (int t = tid; t < 1024; t += 512) {
        const int pp = t >> 4, h = t & 15;
        const float lr = p.lam_re[g * 64 + pp], li = p.lam_im[g * 64 + pp];
        const float a = lr * dt, th = li * dt;
        float sn, cs; sincosf(th, &sn, &cs); const float sh = sinf(0.5f * th);
        const float em1 = expm1f(a), ea = em1 + 1.f;
        const float xr = em1 * cs - 2.f * sh * sh, xi = ea * sn;
        const float den = 1.f / (lr * lr + li * li);
        const float cfr = (xr * lr + xi * li) * den, cfi = (xi * lr - xr * li) * den;
        const float br = p.b_re[(g * 64 + pp) * 16 + h], bi = p.b_im[(g * 64 + pp) * 16 + h];
        bbr[pp * 16 + h] = cfr * br - cfi * bi; bbi[pp * 16 + h] = cfr * bi + cfi * br;
        cr[h * 64 + pp] = p.c_re[(g * 16 + h) * 64 + pp]; ci[h * 64 + pp] = p.c_im[(g * 16 + h) * 64 + pp];
    }
    __syncthreads();
    {
        const int k = tid >> 5, hl = (tid >> 4) & 1, h2 = tid & 15, h = 2 * sub + hl;
        float sacc = 0.f;
        for (int pp = 0; pp < 64; ++pp) {
            const float c_r = cr[h * 64 + pp], c_i = ci[h * 64 + pp], l_r = lkr[k * 64 + pp], l_i = lki[k * 64 + pp];
            const float er = c_r * l_r - c_i * l_i, ei = c_r * l_i + c_i * l_r;
            sacc += er * bbr[pp * 16 + h2] - ei * bbi[pp * 16 + h2];
        }
        if (k == 0 && h == h2) sacc += p.d_skip[g * 16 + h];
        Kt[tid] = sacc;
    }
    __syncthreads();
    bf16_t* WCAT = (bf16_t*)(p.ws + WS_WCAT) + (size_t)g * 256 * 384;
    bf16_t* WST = (bf16_t*)(p.ws + WS_WST) + (size_t)g * 256 * 256;
    for (int e = tid; e < 32 * 192; e += 512) {
        const int rl = e / 192, kk = (e - rl * 192) * 2;
        const int t = rl >> 1, hl = rl & 1, h = 2 * sub + hl;
        const int row = 128 * (h >> 3) + 32 * (t >> 2) + 16 * ((h >> 2) & 1) + 4 * (t & 3) + (h & 3);
        float v[2];
#pragma unroll
        for (int q = 0; q < 2; ++q) {
            const int k2 = kk + q;
            if (k2 < 128) { const int pp = k2 & 63; const float c_r = cr[h * 64 + pp], c_i = ci[h * 64 + pp], l_r = lkr[(t + 1) * 64 + pp], l_i = lki[(t + 1) * 64 + pp];
                v[q] = k2 < 64 ? (c_r * l_r - c_i * l_i) : -(c_r * l_i + c_i * l_r); }
            else { const int s2 = (k2 - 128) >> 4, h2 = (k2 - 128) & 15; v[q] = s2 <= t ? Kt[((t - s2) * 2 + hl) * 16 + h2] : 0.f; }
        }
        *(unsigned*)(WCAT + (size_t)row * 384 + kk) = pk2(v[0], v[1]);
    }
    for (int e = tid; e < 32 * 128; e += 512) {
        const int rl = e >> 7, kk = (e & 127) * 2;
        const int row = rl < 16 ? 16 * sub + rl : 128 + 16 * sub + (rl - 16);
        float v[2] = {0.f, 0.f};
        if (row < 128) {
            const int pp = row & 63;
#pragma unroll
            for (int q = 0; q < 2; ++q) { const int s2 = (kk + q) >> 4, h = (kk + q) & 15; const float l_r = lkr[(15 - s2) * 64 + pp], l_i = lki[(15 - s2) * 64 + pp], b_r = bbr[pp * 16 + h], b_i = bbi[pp * 16 + h];
                v[q] = row < 64 ? (l_r * b_r - l_i * b_i) : (l_r * b_i + l_i * b_r); }
        }
        *(unsigned*)(WST + (size_t)row * 256 + kk) = pk2(v[0], v[1]);
    }
    if (sub == 0 && tid < 64) { float* L16 = (float*)(p.ws + WS_LAM16) + (g * 64 + tid) * 2; L16[0] = lkr[16 * 64 + tid]; L16[1] = lki[16 * 64 + tid]; }
    __syncthreads();
}

__device__ __forceinline__ void phase_prep(const Params& p, LAS unsigned char* lds) {
    const int tid = threadIdx.x, lane = tid & 63, wave = tid >> 6, G = 256, bid = blockIdx.x;
    const int gw = bid * 8 + wave, NGW = G * 8;
    const bool tables_first = ((bid >> 3) & 1) != 0;
    if (tables_first) ssm_group_prep(p, bid, (LAS float*)lds);
    {
        bf16_t* XB = (bf16_t*)(p.ws + WS_XB); float* RS = (float*)(p.ws + WS_RS);
        for (int row = gw; row < NTOK; row += NGW) {
            const f32x4* xr = (const f32x4*)(p.x + (size_t)row * DM) + lane;
            f32x4 v[4]; float s = 0.f;
#pragma unroll
            for (int j = 0; j < 4; ++j) { v[j] = __builtin_nontemporal_load(xr + 64 * j); s += (v[j][0] * v[j][0] + v[j][1] * v[j][1]) + (v[j][2] * v[j][2] + v[j][3] * v[j][3]); }
            s = wave_sum(s);
            if (lane == 0) RS[row] = 1.0f / sqrtf(s * (1.f / DM) + 1e-6f);
            u32x2* o = (u32x2*)(XB + (size_t)row * DM) + lane;
#pragma unroll
            for (int j = 0; j < 4; ++j) o[64 * j] = (u32x2){pk2(v[j][0], v[j][1]), pk2(v[j][2], v[j][3])};
        }
    }
    {
        LAS float* scr = (LAS float*)(lds + 49152) + wave * (64 * 33);
        constexpr int I_IN = (DM / 64) * (NPROJ / 32), I_OUT = (DM / 64) * (DM / 32), I_GLU = (512 / 64) * (512 / 32);
        for (int it = gw; it < I_IN + I_OUT + I_GLU; it += NGW) {
            int r = it;
            if (r < I_IN) { transpose_item<0>(p.w_in, DM, NPROJ, (bf16_t*)(p.ws + WS_WINT), p.norm_gain, scr, r, lane); continue; } r -= I_IN;
            if (r < I_OUT) { transpose_item<1>(p.w_out, DM, DM, (bf16_t*)(p.ws + WS_WOUTT), nullptr, scr, r, lane); continue; } r -= I_OUT;
            transpose_item<1>(p.w_glu, 512, 512, (bf16_t*)(p.ws + WS_WGLUT), nullptr, scr, r, lane);
        }
    }
    {
        float* COS = (float*)(p.ws + WS_COS); float* SIN = (float*)(p.ws + WS_SIN); float* KSUM = (float*)(p.ws + WS_KSUM);
        for (int i = bid * 512 + tid; i < SEQ * 32; i += G * 512) {
            const int pos = i >> 5, f = i & 31;
            const float inv = 1.0f / powf(10000.0f, (float)f * (1.f / 32.f));
            const float ang = (float)pos * inv; float sn, cs; sincosf(ang, &sn, &cs);
            COS[i] = cs; SIN[i] = sn;
        }
        for (int i = bid * 512 + tid; i < 4096; i += G * 512) KSUM[i] = 0.f;
    }
    if (!tables_first) { __syncthreads(); ssm_group_prep(p, bid, (LAS float*)lds); }
}

__device__ __forceinline__ int swap23(int r) { return (r & ~12) | ((r & 4) << 1) | ((r & 8) >> 1); }

typedef float f32x2 __attribute__((ext_vector_type(2)));
__device__ __forceinline__ float max3f(float a, float b, float c) { float r; asm("v_max3_f32 %0, %1, %2, %3" : "=v"(r) : "v"(a), "v"(b), "v"(c)); return r; }
template <bool DIAG>
__device__ __forceinline__ void attn_tile(LAS unsigned char* B, unsigned kf_off, unsigned vf_off, const bf16x8 (&qf)[4], f32x16& O0, f32x16& O1, float& mrun, float& lrun,
                                          bool on, int kpos0, int qpos, int hh) {
    constexpr int ROWB = 144;
    const float cinit = on ? -mrun : -1e30f;
    f32x16 st0, st1;
#pragma unroll
    for (int i = 0; i < 16; ++i) { st0[i] = cinit; st1[i] = cinit; }
#pragma unroll
    for (int s = 0; s < 4; ++s) {
        const bf16x8 k0 = *(const LAS bf16x8*)(B + kf_off + s * 32), k1 = *(const LAS bf16x8*)(B + kf_off + 32 * ROWB + s * 32);
        st0 = __builtin_amdgcn_mfma_f32_32x32x16_bf16(k0, qf[s], st0, 0, 0, 0);
        st1 = __builtin_amdgcn_mfma_f32_32x32x16_bf16(k1, qf[s], st1, 0, 0, 0);
    }
    if (DIAG) {
#pragma unroll
        for (int i = 0; i < 16; ++i) {
            const int key = kpos0 + (i & 7) + 8 * hh + 16 * (i >> 3);
            if (key > qpos) st0[i] = -1e30f;
            if (key + 32 > qpos) st1[i] = -1e30f;
        }
    }
    float mx = max3f(st0[0], st0[1], st0[2]);
#pragma unroll
    for (int i = 3; i < 15; i += 2) mx = max3f(mx, st0[i], st0[i + 1]);
    mx = max3f(mx, st0[15], st1[0]);
#pragma unroll
    for (int i = 1; i < 15; i += 2) mx = max3f(mx, st1[i], st1[i + 1]);
    mx = fmaxf(mx, st1[15]);
    if (__ballot(on && (mx > 8.f)) != 0ull) {
        mx = fmaxf(mx, __shfl_xor(mx, 32));
        const bool grow = on && (mx > 8.f);
        const float d = grow ? mx : 0.f;
        const float alpha = __builtin_amdgcn_exp2f(-d);
        lrun *= alpha; mrun += d;
#pragma unroll
        for (int i = 0; i < 16; ++i) { O0[i] *= alpha; O1[i] *= alpha; st0[i] -= d; st1[i] -= d; }
    }
    float rsum = 0.f;
#pragma unroll
    for (int i = 0; i < 16; ++i) { const float p0 = __builtin_amdgcn_exp2f(st0[i]), p1 = __builtin_amdgcn_exp2f(st1[i]); st0[i] = p0; st1[i] = p1; rsum += p0; rsum += p1; }
    lrun += rsum;
#pragma unroll
    for (int s4 = 0; s4 < 4; ++s4) {
        u32x4 t4;
        if (s4 < 2) t4 = (u32x4){pk2(st0[8 * s4], st0[8 * s4 + 1]), pk2(st0[8 * s4 + 2], st0[8 * s4 + 3]), pk2(st0[8 * s4 + 4], st0[8 * s4 + 5]), pk2(st0[8 * s4 + 6], st0[8 * s4 + 7])};
        else { const int s = s4 - 2; t4 = (u32x4){pk2(st1[8 * s], st1[8 * s + 1]), pk2(st1[8 * s + 2], st1[8 * s + 3]), pk2(st1[8 * s + 4], st1[8 * s + 5]), pk2(st1[8 * s + 6], st1[8 * s + 7])}; }
        const bf16x8 pf = __builtin_bit_cast(bf16x8, t4);
        const bf16x8 v0 = *(const LAS bf16x8*)(B + vf_off + s4 * 32), v1 = *(const LAS bf16x8*)(B + vf_off + 32 * ROWB + s4 * 32);
        O0 = __builtin_amdgcn_mfma_f32_32x32x16_bf16(v0, pf, O0, 0, 0, 0);
        O1 = __builtin_amdgcn_mfma_f32_32x32x16_bf16(v1, pf, O1, 0, 0, 0);
    }
}

__device__ __forceinline__ void attn_tile2(LAS unsigned char* BA, LAS unsigned char* BB, unsigned kf_off, unsigned vf_off, const bf16x8 (&qf)[4], f32x16& O0, f32x16& O1, float& mrun, float& lrun, bool on) {
    constexpr int ROWB = 144;
    const float cinit = on ? -mrun : -1e30f;
    f32x16 sa0, sa1, sb0, sb1;
#pragma unroll
    for (int i = 0; i < 16; ++i) { sa0[i] = cinit; sa1[i] = cinit; sb0[i] = cinit; sb1[i] = cinit; }
#pragma unroll
    for (int s = 0; s < 4; ++s) {
        const bf16x8 k0 = *(const LAS bf16x8*)(BA + kf_off + s * 32), k1 = *(const LAS bf16x8*)(BA + kf_off + 32 * ROWB + s * 32);
        const bf16x8 k2 = *(const LAS bf16x8*)(BB + kf_off + s * 32), k3 = *(const LAS bf16x8*)(BB + kf_off + 32 * ROWB + s * 32);
        sa0 = __builtin_amdgcn_mfma_f32_32x32x16_bf16(k0, qf[s], sa0, 0, 0, 0);
        sa1 = __builtin_amdgcn_mfma_f32_32x32x16_bf16(k1, qf[s], sa1, 0, 0, 0);
        sb0 = __builtin_amdgcn_mfma_f32_32x32x16_bf16(k2, qf[s], sb0, 0, 0, 0);
        sb1 = __builtin_amdgcn_mfma_f32_32x32x16_bf16(k3, qf[s], sb1, 0, 0, 0);
    }
    float mx = max3f(sa0[0], sa0[1], sa0[2]), my = max3f(sb0[0], sb0[1], sb0[2]);
#pragma unroll
    for (int i = 3; i < 15; i += 2) { mx = max3f(mx, sa0[i], sa0[i + 1]); my = max3f(my, sb0[i], sb0[i + 1]); }
    mx = max3f(mx, sa0[15], sa1[0]); my = max3f(my, sb0[15], sb1[0]);
#pragma unroll
    for (int i = 1; i < 15; i += 2) { mx = max3f(mx, sa1[i], sa1[i + 1]); my = max3f(my, sb1[i], sb1[i + 1]); }
    mx = max3f(mx, sa1[15], fmaxf(my, sb1[15]));
    if (__ballot(on && (mx > 8.f)) != 0ull) {
        mx = fmaxf(mx, __shfl_xor(mx, 32));
        const bool grow = on && (mx > 8.f);
        const float d = grow ? mx : 0.f;
        const float alpha = __builtin_amdgcn_exp2f(-d);
        lrun *= alpha; mrun += d;
#pragma unroll
        for (int i = 0; i < 16; ++i) { O0[i] *= alpha; O1[i] *= alpha; sa0[i] -= d; sa1[i] -= d; sb0[i] -= d; sb1[i] -= d; }
    }
    float rsum = 0.f;
#define AT2_EXP(S0, S1) _Pragma("unroll") for (int i = 0; i < 16; ++i) { const float p0 = __builtin_amdgcn_exp2f(S0[i]), p1 = __builtin_amdgcn_exp2f(S1[i]); S0[i] = p0; S1[i] = p1; rsum += p0; rsum += p1; }
#define AT2_PV(S0, S1, BUF) _Pragma("unroll") for (int s4 = 0; s4 < 4; ++s4) { \
        u32x4 t4; \
        if (s4 < 2) t4 = (u32x4){pk2(S0[8 * s4], S0[8 * s4 + 1]), pk2(S0[8 * s4 + 2], S0[8 * s4 + 3]), pk2(S0[8 * s4 + 4], S0[8 * s4 + 5]), pk2(S0[8 * s4 + 6], S0[8 * s4 + 7])}; \
        else { const int s_ = s4 - 2; t4 = (u32x4){pk2(S1[8 * s_], S1[8 * s_ + 1]), pk2(S1[8 * s_ + 2], S1[8 * s_ + 3]), pk2(S1[8 * s_ + 4], S1[8 * s_ + 5]), pk2(S1[8 * s_ + 6], S1[8 * s_ + 7])}; } \
        const bf16x8 pf = __builtin_bit_cast(bf16x8, t4); \
        const bf16x8 v0 = *(const LAS bf16x8*)(BUF + vf_off + s4 * 32), v1 = *(const LAS bf16x8*)(BUF + vf_off + 32 * ROWB + s4 * 32); \
        O0 = __builtin_amdgcn_mfma_f32_32x32x16_bf16(v0, pf, O0, 0, 0, 0); \
        O1 = __builtin_amdgcn_mfma_f32_32x32x16_bf16(v1, pf, O1, 0, 0, 0); }
    AT2_EXP(sa0, sa1)
    AT2_PV(sa0, sa1, BA)
    AT2_EXP(sb0, sb1)
    AT2_PV(sb0, sb1, BB)
#undef AT2_EXP
#undef AT2_PV
    lrun += rsum;
}

__device__ __forceinline__ void phase_attn(const Params& p, LAS unsigned char* lds, unsigned* queue) {
    const int tid = threadIdx.x, lane = tid & 63, w = __builtin_amdgcn_readfirstlane(tid >> 6), r = lane & 31, hh = lane >> 5;
    const bf16_t* Qg = (const bf16_t*)(p.ws + WS_Q); const bf16_t* Kg = (const bf16_t*)(p.ws + WS_K); const bf16_t* VTg = (const bf16_t*)(p.ws + WS_VT);
    const bf16_t* SZA = (const bf16_t*)(p.ws + WS_SZA); const float* KSUM = (const float*)(p.ws + WS_KSUM);
    bf16_t* MIXED = (bf16_t*)(p.ws + WS_XB);
    constexpr int ROWB = 144, TILEB = 64 * ROWB, BUFB = 2 * TILEB;
    const int srow = tid >> 3, sch = tid & 7;
    const unsigned st_off = (unsigned)(srow * ROWB + sch * 16);
    const unsigned kf_off = (unsigned)(swap23(r) * ROWB + hh * 16);
    const unsigned vf_off = (unsigned)(TILEB + r * ROWB + hh * 16);
    volatile LAS unsigned* tick = (volatile LAS unsigned*)(lds + LDS_CTL + 8);
    for (;;) {
        if (tid == 0) *tick = __hip_atomic_fetch_add(queue, 1u, __ATOMIC_RELAXED, __HIP_MEMORY_SCOPE_AGENT);
        __syncthreads();
        const int idx = (int)*tick;
        if (idx >= 512) break;
        const int blk = 7 - (idx >> 6), bh = idx & 63, b = bh >> 3, h = bh & 7;
        const int qpos = blk * 256 + w * 32 + r;
        const bf16_t* Qp = Qg + ((size_t)bh * 2048 + qpos) * 64 + 8 * hh;
        bf16x8 qf[4];
#pragma unroll
        for (int s = 0; s < 4; ++s) qf[s] = *(const bf16x8*)(Qp + 16 * s);
        unsigned selmask;
        if (blk <= 3) selmask = (1u << blk) - 1u;
        else {
            float v1 = -3e38f, v2 = -3e38f, v3 = -3e38f; int i1 = 0, i2 = 0, i3 = 0;
#pragma unroll
            for (int j = 0; j < 7; ++j) {
                if (j < blk) {
                    const float* ks = KSUM + ((size_t)bh * 8 + j) * 64 + 8 * hh;
                    float gsum = 0.f;
#pragma unroll
                    for (int s = 0; s < 4; ++s) {
                        const f32x4 k0 = *(const f32x4*)(ks + 16 * s), k1 = *(const f32x4*)(ks + 16 * s + 4);
                        gsum += bf2f((unsigned short)qf[s][0]) * k0[0] + bf2f((unsigned short)qf[s][1]) * k0[1] + bf2f((unsigned short)qf[s][2]) * k0[2] + bf2f((unsigned short)qf[s][3]) * k0[3]
                              + bf2f((unsigned short)qf[s][4]) * k1[0] + bf2f((unsigned short)qf[s][5]) * k1[1] + bf2f((unsigned short)qf[s][6]) * k1[2] + bf2f((unsigned short)qf[s][7]) * k1[3];
                    }
                    gsum += __shfl_xor(gsum, 32);
                    if (gsum > v1) { v3 = v2; i3 = i2; v2 = v1; i2 = i1; v1 = gsum; i1 = j; }
                    else if (gsum > v2) { v3 = v2; i3 = i2; v2 = gsum; i2 = j; }
                    else if (gsum > v3) { v3 = gsum; i3 = j; }
                }
            }
            selmask = (1u << i1) | (1u << i2) | (1u << i3);
        }
        f32x16 O0, O1;
#pragma unroll
        for (int i = 0; i < 16; ++i) { O0[i] = 0.f; O1[i] = 0.f; }
        float mrun = 0.f, lrun = 0.f;
        const int ntile = 4 + 4 * blk;
        const bf16_t* Kst = Kg + ((size_t)bh * 2048 + srow) * 64 + sch * 8;
        const bf16_t* Vst = VTg + ((size_t)bh * 64 + srow) * 2048 + sch * 8;
        u32x4 kreg[2], vreg[2];
#pragma unroll
        for (int q = 0; q < 2; ++q) { const int kp = blk * 256 + 64 * q; kreg[q] = *(const u32x4*)(Kst + (size_t)kp * 64); vreg[q] = *(const u32x4*)(Vst + kp); }
#pragma unroll
        for (int q = 0; q < 2; ++q) { *(LAS u32x4*)(lds + q * BUFB + st_off) = kreg[q]; *(LAS u32x4*)(lds + q * BUFB + TILEB + st_off) = vreg[q]; }
        __syncthreads();
        for (int n = 0; n < ntile; n += 2) {
            if (n + 2 < ntile) {
#pragma unroll
                for (int q = 0; q < 2; ++q) { const int m = n + 2 + q; const int kp = m < 4 ? blk * 256 + 64 * m : ((m - 4) >> 2) * 256 + 64 * ((m - 4) & 3);
                    kreg[q] = *(const u32x4*)(Kst + (size_t)kp * 64); vreg[q] = *(const u32x4*)(Vst + kp); }
            }
            LAS unsigned char* SB = lds + ((n >> 1) & 1) * (2 * BUFB);
            if (n >= 4) {
                const bool on = (selmask >> ((n - 4) >> 2)) & 1u;
                if (__ballot(on) != 0ull) attn_tile2(SB, SB + BUFB, kf_off, vf_off, qf, O0, O1, mrun, lrun, on);
            } else {
#pragma unroll
                for (int q = 0; q < 2; ++q) {
                    const int nn = n + q;
                    const int kpos0 = blk * 256 + 64 * nn;
                    LAS unsigned char* B = SB + q * BUFB;
                    const int dt_ = w >> 1;
                    if (nn == dt_) attn_tile<true>(B, kf_off, vf_off, qf, O0, O1, mrun, lrun, true, kpos0, qpos, hh);
                    else if (nn < dt_) attn_tile<false>(B, kf_off, vf_off, qf, O0, O1, mrun, lrun, true, kpos0, qpos, hh);
                }
            }
            if (n + 2 < ntile) { LAS unsigned char* Bn = lds + (((n >> 1) + 1) & 1) * (2 * BUFB);
#pragma unroll
                for (int q = 0; q < 2; ++q) { *(LAS u32x4*)(Bn + q * BUFB + st_off) = kreg[q]; *(LAS u32x4*)(Bn + q * BUFB + TILEB + st_off) = vreg[q]; } }
            __syncthreads();
        }
        lrun += __shfl_xor(lrun, 32);
        const float inv = 1.f / lrun;
        const size_t row = (size_t)b * 2048 + qpos;
#pragma unroll
        for (int dt = 0; dt < 2; ++dt)
#pragma unroll
            for (int g4 = 0; g4 < 4; ++g4) {
                const int d0 = 32 * dt + 8 * g4 + 4 * hh;
                const u32x2 z2 = *(const u32x2*)(SZA + row * 512 + h * 64 + d0);
                float o0, o1, o2, o3;
                if (dt == 0) { o0 = O0[4 * g4]; o1 = O0[4 * g4 + 1]; o2 = O0[4 * g4 + 2]; o3 = O0[4 * g4 + 3]; }
                else { o0 = O1[4 * g4]; o1 = O1[4 * g4 + 1]; o2 = O1[4 * g4 + 2]; o3 = O1[4 * g4 + 3]; }
                o0 *= inv * bflo(z2[0]); o1 *= inv * bfhi(z2[0]); o2 *= inv * bflo(z2[1]); o3 *= inv * bfhi(z2[1]);
                *(u32x2*)(MIXED + row * 1024 + h * 64 + d0) = (u32x2){pk2(o0, o1), pk2(o2, o3)};
            }
    }
}

__device__ __forceinline__ void scan_unit(const Params& p, LAS unsigned char* lds, int L) {
    const int tid = threadIdx.x, lane = tid & 63, wave = __builtin_amdgcn_readfirstlane(tid >> 6);
    bf16_t* XU = (bf16_t*)(p.ws + WS_XU); const float* L16 = (const float*)(p.ws + WS_LAM16);
    LAS float* E = (LAS float*)(lds + LDS_SCANX);
    const int g = L >> 2;
    const float lr = L16[(g * 64 + lane) * 2], li = L16[(g * 64 + lane) * 2 + 1];
    float pr = lr, pi = li;
#pragma unroll
    for (int q = 0; q < 4; ++q) { const float nr = pr * pr - pi * pi, ni = 2.f * pr * pi; pr = nr; pi = ni; }
    for (int bb = 0; bb < 2; ++bb) {
        const size_t base = (size_t)256 * L + 128 * bb + 16 * wave;
        float sr[16], si[16];
#pragma unroll
        for (int c = 0; c < 16; ++c) { const LAS float* rowp = (const LAS float*)(lds + (128 * bb + 16 * wave + c) * LDS_SROW); sr[c] = rowp[lane]; si[c] = rowp[64 + lane]; }
        float er = 0.f, ei = 0.f;
#pragma unroll
        for (int c = 0; c < 16; ++c) { const float nr = lr * er - li * ei + sr[c], ni = lr * ei + li * er + si[c]; er = nr; ei = ni; }
        E[(wave * 2) * 64 + lane] = er; E[(wave * 2 + 1) * 64 + lane] = ei;
        __syncthreads();
        float Xr = 0.f, Xi = 0.f;
        for (int s2 = 0; s2 < wave; ++s2) { const float e_r = E[(s2 * 2) * 64 + lane], e_i = E[(s2 * 2 + 1) * 64 + lane]; const float nr = pr * Xr - pi * Xi + e_r, ni = pr * Xi + pi * Xr + e_i; Xr = nr; Xi = ni; }
#pragma unroll
        for (int c = 0; c < 16; ++c) {
            const size_t R = base + c;
            XU[R * 384 + lane] = (bf16_t)(pk2(Xr, 0.f) & 0xffffu); XU[R * 384 + 64 + lane] = (bf16_t)(pk2(Xi, 0.f) & 0xffffu);
            const float nr = lr * Xr - li * Xi + sr[c], ni = lr * Xi + li * Xr + si[c]; Xr = nr; Xi = ni;
        }
        __syncthreads();
    }
}

__device__ __forceinline__ void phase_norm(const Params& p) {
    const int tid = threadIdx.x, lane = tid & 63, wave = tid >> 6, G = gridDim.x;
    const float* SSQ = (const float*)(p.ws + WS_SSQ);
    f32x4 gn[4];
#pragma unroll
    for (int j = 0; j < 4; ++j) gn[j] = *((const f32x4*)p.final_gain + lane + 64 * j);
    for (int row = blockIdx.x * 8 + wave; row < NTOK; row += 8 * G) {
        float s = 0.f;
#pragma unroll
        for (int i = 0; i < 16; ++i) s += SSQ[row * 16 + i];
        const float rinv = 1.0f / sqrtf(s * (1.f / DM) + 1e-6f);
        f32x4* o = (f32x4*)(p.out + (size_t)row * DM) + lane;
#pragma unroll
        for (int j = 0; j < 4; ++j) { f32x4 v = o[64 * j]; v = v * rinv * gn[j]; o[64 * j] = v; }
    }
}

__global__ __launch_bounds__(512, 2) void hymba_fwd(Params p) {
    extern __shared__ __attribute__((aligned(16))) unsigned char shm_raw[];
    LAS unsigned char* lds = (LAS unsigned char*)shm_raw;
    cg::grid_group grid = cg::this_grid();
    constexpr int G = 256;
    const int bid = blockIdx.x;
    unsigned char* ws = p.ws;
#if N_LAUNCH == 1
    constexpr int lo = 0, hi = NPH;
#else
    const int lo = p.ph_lo, hi = p.ph_hi;
#endif
    if (threadIdx.x < 4) ((LAS unsigned*)(lds + LDS_CTL))[threadIdx.x] = 0u;
    __syncthreads();
    XcdBarrier xbar = xcd_barrier_post((unsigned*)(ws + WS_BAR), (volatile LAS unsigned*)(lds + LDS_CTL));
    if (hi > 1000) grid.sync();
#define IN(k) (PH_ON(k) && lo <= (k) && (k) < hi)
#define SEAM(k) do { if (lo <= (k) && (k) + 1 < hi) xcd_barrier(xbar); } while (0)
    if (IN(0)) { phase_prep(p, lds); }
    SEAM(0);
    if (IN(1)) {
        pg8::Gemm g{(const bf16_t*)(ws + WS_XB), (const bf16_t*)(ws + WS_WINT)};
        pg8::StaticOrder<NTOK, NPROJ> S{bid};
        EpiInProj E{(const float*)(ws + WS_RS), (const float*)(ws + WS_COS), (const float*)(ws + WS_SIN),
                    (bf16_t*)(ws + WS_Q), (bf16_t*)(ws + WS_K), (bf16_t*)(ws + WS_VT), (bf16_t*)(ws + WS_SZA), (bf16_t*)(ws + WS_SZS), (bf16_t*)(ws + WS_XU), (float*)(ws + WS_KSUM)};
        pg8::gemm_phase<DM, DM, DM>(lds, g, S, E);
    }
    SEAM(1);
    if (IN(2)) {
        unsigned* cnt = (unsigned*)(ws + WS_BAR) + XCD_BAR_WORDS;
        if (bid < 128) {
            const int L = bid;
            {
                pg8::Gemm g{(const bf16_t*)(ws + WS_XU) + 128, (const bf16_t*)(ws + WS_WST)};
                pg8::OneUnit S{L, L >> 2};
                EpiS E{lds};
                pg8::gemm_phase<384, 256, 256, true, false, false>(lds, g, S, E);
            }
            asm volatile("s_waitcnt vmcnt(0)" ::: "memory");
            __syncthreads();
            scan_unit(p, lds, L);
            asm volatile("s_waitcnt vmcnt(0)" ::: "memory");
            __syncthreads();
            {
                pg8::Gemm g{(const bf16_t*)(ws + WS_XU), (const bf16_t*)(ws + WS_WCAT)};
                pg8::OneUnit S{L, L >> 2};
                EpiY E{(bf16_t*)(ws + WS_YG)};
                pg8::gemm_phase<384, 384, 384, false, true, false>(lds, g, S, E);
            }
            asm volatile("s_waitcnt vmcnt(0)" ::: "memory");
            __syncthreads();
            if (threadIdx.x == 0) {
                __builtin_amdgcn_fence(__ATOMIC_RELEASE, "agent");
                asm volatile("s_waitcnt vmcnt(0)" ::: "memory");
                __hip_atomic_fetch_add(cnt + 64 * (L & 3), 1u, __ATOMIC_RELAXED, __HIP_MEMORY_SCOPE_AGENT);
            }
        }
        if (bid < 128) {
            const int U = bid;
            const int pm = U >> 1, pn = U & 1;
            if (threadIdx.x == 0) {
                unsigned sp = 0;
                while (__hip_atomic_load(cnt + 64 * (pm >> 4), __ATOMIC_RELAXED, __HIP_MEMORY_SCOPE_AGENT) < 32u) { __builtin_amdgcn_s_sleep(2); if (++sp > (1u << 22)) break; }
                __builtin_amdgcn_fence(__ATOMIC_ACQUIRE, "agent");
                asm volatile("s_waitcnt vmcnt(0)" ::: "memory");
            }
            __syncthreads();
            pg8::Gemm g{(const bf16_t*)(ws + WS_YG), (const bf16_t*)(ws + WS_WGLUT)};
            pg8::OneUnit S{pm, pn};
            EpiGlu E{(const bf16_t*)(ws + WS_YG), (const bf16_t*)(ws + WS_SZS), p.b_glu, (bf16_t*)(ws + WS_XB)};
            pg8::gemm_phase<512, 512, 512, false, true, false>(lds, g, S, E);
        }
        phase_attn(p, lds, cnt + 256);
    }
    SEAM(2);
    if (G == 256) {
        if (IN(6)) {
            pg8::Gemm g{(const bf16_t*)(ws + WS_XB), (const bf16_t*)(ws + WS_WOUTT)};
            pg8::StaticOrder<NTOK, DM> S{bid};
            EpiOutFused E{p.x, p.out, (float*)(ws + WS_SSQ), p.final_gain, xbar};
            pg8::gemm_phase<DM, DM, DM, true, true, true>(lds, g, S, E);
        }
    } else {
        if (IN(6)) {
            pg8::Gemm g{(const bf16_t*)(ws + WS_XB), (const bf16_t*)(ws + WS_WOUTT)};
            pg8::StaticOrder<NTOK, DM> S{bid};
            EpiOut E{p.x, p.out, (float*)(ws + WS_SSQ)};
            pg8::gemm_phase<DM, DM, DM>(lds, g, S, E);
        }
        SEAM(6);
        if (IN(7)) { phase_norm(p); }
    }
#undef IN
#undef SEAM
}

extern "C" void kernel_launch(void* const* d_in, const int* in_sizes, int n_in, void* d_out, int out_size, void* d_ws, size_t ws_size, hipStream_t stream) {
    static int grid = 0;
    if (grid == 0) {
        if (n_in != 15 || in_sizes[0] != NTOK * DM || out_size != NTOK * DM || ws_size < WS_END) { fprintf(stderr, "kernel_launch: unexpected shapes (n_in %d, in0 %d, out %d, ws %zu)\n", n_in, n_in > 0 ? in_sizes[0] : -1, out_size, ws_size); grid = -1; return; }
        int dev = 0, cus = 0, per_cu = 0;
        (void)hipGetDevice(&dev); (void)hipDeviceGetAttribute(&cus, hipDeviceAttributeMultiprocessorCount, dev);
        if (hipFuncSetAttribute((const void*)hymba_fwd, hipFuncAttributeMaxDynamicSharedMemorySize, LDS_BYTES) != hipSuccess) { fprintf(stderr, "kernel_launch: hipFuncSetAttribute failed\n"); grid = -1; return; }
        if (hipOccupancyMaxActiveBlocksPerMultiprocessor(&per_cu, (const void*)hymba_fwd, 512, LDS_BYTES) != hipSuccess || per_cu < 1) { fprintf(stderr, "kernel_launch: occupancy query says %d\n", per_cu); per_cu = 1; }
        (void)hipGetLastError();
        if (cus != 256) { fprintf(stderr, "kernel_launch: built for a 256-CU device (one workgroup per CU), found %d CUs; nothing launched\n", cus); grid = -1; return; }
        grid = 256;
    }
    if (grid < 0) return;
    if (hipMemsetAsync((char*)d_ws + WS_BAR, 0, (XCD_BAR_WORDS + 512) * 4, stream) != hipSuccess) { fprintf(stderr, "kernel_launch: memset of barrier words failed\n"); return; }
    Params p{};
    p.x = (const float*)d_in[0]; p.norm_gain = (const float*)d_in[1]; p.w_in = (const float*)d_in[2]; p.w_out = (const float*)d_in[3];
    p.lam_re = (const float*)d_in[4]; p.lam_im = (const float*)d_in[5]; p.b_re = (const float*)d_in[6]; p.b_im = (const float*)d_in[7];
    p.c_re = (const float*)d_in[8]; p.c_im = (const float*)d_in[9]; p.d_skip = (const float*)d_in[10]; p.log_dt = (const float*)d_in[11];
    p.w_glu = (const float*)d_in[12]; p.b_glu = (const float*)d_in[13]; p.final_gain = (const float*)d_in[14];
    p.out = (float*)d_out; p.ws = (unsigned char*)d_ws;
#if N_LAUNCH == 1
    p.ph_lo = 0; p.ph_hi = NPH;
    void* args[] = {&p};
    hipError_t e = hipLaunchCooperativeKernel((const void*)hymba_fwd, dim3(grid), dim3(512), args, LDS_BYTES, stream);
    if (e != hipSuccess) fprintf(stderr, "cooperative launch failed: %s (grid %d)\n", hipGetErrorString(e), grid);
#else
    for (int ph = 0; ph < NPH; ++ph) {
        p.ph_lo = ph; p.ph_hi = ph + 1;
        hipLaunchKernelGGL(hymba_fwd, dim3(grid), dim3(512), LDS_BYTES, stream, p);
    }
#endif
}
```
